# Optimizing an MI355X kernel written in HIP

```python
import math
import jax, jax.numpy as jnp
from jax import lax
import numpy as np

D_MODEL = 1024
BATCH = 4
SEQ = 4096
DEPTH = 1

CHUNK = 64
RNN_WIDTH = 1024
RNN_BLOCKS = 16
RNN_BLOCK_DIM = RNN_WIDTH // RNN_BLOCKS
CONV_WIDTH = 4
LRU_C = 8.0
FOX_HEADS = 16
FOX_HEAD_DIM = 64
FOX_WIDTH = FOX_HEADS * FOX_HEAD_DIM
QUERY_BLOCK = 128
N_BRANCHES = 2
IN_COLS = 2 * RNN_WIDTH + 3 * FOX_WIDTH + FOX_HEADS + N_BRANCHES * D_MODEL
N_EXPERTS = 32
TOP_K = 4
D_FF = 1024
SWIGLU_LIMIT = 7.0
SWIGLU_ALPHA = 1.702
RMS_EPS = 1e-6

kernel_name = "hybrid_rglru_fox_moe_block"


def rmsnorm(x, g):
    xf = x.astype(jnp.float32)
    y = xf * lax.rsqrt(jnp.mean(xf * xf, axis=-1, keepdims=True) + RMS_EPS)
    return (y * g.astype(jnp.float32)).astype(x.dtype)


def causal_depthwise_conv(x, w, b):
    c = x.shape[-1]
    y = lax.conv_general_dilated(
        x, w[:, None, :].astype(x.dtype), window_strides=(1,),
        padding=[(CONV_WIDTH - 1, 0)],
        dimension_numbers=("NWC", "WIO", "NWC"), feature_group_count=c)
    return y + b.astype(x.dtype)


def _lin_combine(left, right):
    a_l, b_l = left
    a_r, b_r = right
    return a_l * a_r, a_r * b_l + b_r


def rg_lru(xc, w_rg, b_rg, w_ig, b_ig, lru_lambda):
    bsz, s, r = xc.shape
    xb = xc.reshape(bsz, s, RNN_BLOCKS, RNN_BLOCK_DIM)
    gate_r = jnp.einsum('bshi,hij->bshj', xb, w_rg).reshape(bsz, s, r) + b_rg
    gate_i = jnp.einsum('bshi,hij->bshj', xb, w_ig).reshape(bsz, s, r) + b_ig
    rt = jax.nn.sigmoid(gate_r.astype(jnp.float32))
    it = jax.nn.sigmoid(gate_i.astype(jnp.float32))
    log_a = -LRU_C * rt * jax.nn.softplus(-lru_lambda.astype(jnp.float32))
    a = jnp.exp(log_a)
    mult = jnp.sqrt(-jnp.expm1(2.0 * log_a))
    bterm = mult * (it * xc.astype(jnp.float32))
    nc = s // CHUNK
    a_c = a.reshape(bsz, nc, CHUNK, r).transpose(1, 0, 2, 3)
    b_c = bterm.reshape(bsz, nc, CHUNK, r).transpose(1, 0, 2, 3)

    def step(h0, ab):
        ac, bc = ab
        acum, bcum = lax.associative_scan(_lin_combine, (ac, bc), axis=1)
        h = acum * h0[:, None, :] + bcum
        return h[:, -1, :], h

    h0 = jnp.zeros((bsz, r), jnp.float32)
    _, hs = lax.scan(step, h0, (a_c, b_c))
    return hs.transpose(1, 0, 2, 3).reshape(bsz, s, r)


def forgetting_attention(q, k, v, cum_logf):
    s = q.shape[2]
    scale = 1.0 / math.sqrt(FOX_HEAD_DIM)
    outs = []
    for i in range(s // QUERY_BLOCK):
        q0 = i * QUERY_BLOCK
        q1 = q0 + QUERY_BLOCK
        logits = jnp.einsum('bhqd,bhkd->bhqk', q[:, :, q0:q1].astype(jnp.float32),
                            k[:, :, :q1].astype(jnp.float32)) * scale
        logits = logits + (cum_logf[:, :, q0:q1, None] - cum_logf[:, :, None, :q1])
        qpos = jnp.arange(q0, q1)[:, None]
        kpos = jnp.arange(q1)[None, :]
        logits = jnp.where(kpos <= qpos, logits, -jnp.inf)
        p = jax.nn.softmax(logits, axis=-1).astype(v.dtype)
        outs.append(jnp.einsum('bhqk,bhkd->bhqd', p, v[:, :, :q1]))
    return jnp.concatenate(outs, axis=2)


def moe_ffn(h, w_router, b_router, w_gate_up, b_gate_up, w_down, b_down):
    bsz, s, d = h.shape
    t = h.reshape(bsz * s, d)
    logits = (t @ w_router).astype(jnp.float32) + b_router.astype(jnp.float32)
    top_v, top_i = lax.top_k(logits, TOP_K)
    top_w = jax.nn.softmax(top_v, axis=-1)
    combine = jnp.sum(jax.nn.one_hot(top_i, N_EXPERTS, dtype=jnp.float32) * top_w[..., None], axis=1)
    combine = combine.astype(h.dtype)
    out = jnp.zeros_like(t)
    for e in range(N_EXPERTS):
        gu = t @ w_gate_up[e] + b_gate_up[e]
        gate = jnp.minimum(gu[:, :D_FF], SWIGLU_LIMIT)
        up = jnp.clip(gu[:, D_FF:], -SWIGLU_LIMIT, SWIGLU_LIMIT)
        glu = gate * jax.nn.sigmoid(SWIGLU_ALPHA * gate)
        y = ((up + 1.0) * glu) @ w_down[e] + b_down[e]
        out = out + combine[:, e:e + 1] * y
    return out.reshape(bsz, s, d)


def setup_inputs(seed: int = 0) -> dict:
    key = jax.random.key(seed)
    ks = jax.random.split(key, 24)
    f32 = jnp.float32
    nrm = lambda k, shape, scale: jax.random.normal(k, shape, f32) * scale
    u = jax.random.uniform(ks[9], (RNN_WIDTH,), f32, 0.9, 0.999)
    sig_l = u ** (1.0 / LRU_C)
    lru_lambda = jnp.log(sig_l) - jnp.log1p(-sig_l)
    return {
        "x": nrm(ks[0], (BATCH, SEQ, D_MODEL), 1.0),
        "g_mix": 1.0 + nrm(ks[1], (D_MODEL,), 0.02),
        "w_in": nrm(ks[2], (D_MODEL, IN_COLS), D_MODEL ** -0.5),
        "conv_w": nrm(ks[3], (CONV_WIDTH, RNN_WIDTH), CONV_WIDTH ** -0.5),
        "conv_b": nrm(ks[4], (RNN_WIDTH,), 0.01),
        "w_rg": nrm(ks[5], (RNN_BLOCKS, RNN_BLOCK_DIM, RNN_BLOCK_DIM), RNN_BLOCK_DIM ** -0.5),
        "b_rg": nrm(ks[6], (RNN_WIDTH,), 0.01),
        "w_ig": nrm(ks[7], (RNN_BLOCKS, RNN_BLOCK_DIM, RNN_BLOCK_DIM), RNN_BLOCK_DIM ** -0.5),
        "b_ig": nrm(ks[8], (RNN_WIDTH,), 0.01),
        "lru_lambda": lru_lambda,
        "b_f": 2.0 + nrm(ks[10], (FOX_HEADS,), 0.1),
        "w_lru_out": nrm(ks[11], (RNN_WIDTH, D_MODEL), RNN_WIDTH ** -0.5),
        "w_fox_out": nrm(ks[12], (FOX_WIDTH, D_MODEL), FOX_WIDTH ** -0.5),
        "w_o": nrm(ks[13], (D_MODEL, D_MODEL), D_MODEL ** -0.5),
        "g_ffn": 1.0 + nrm(ks[14], (D_MODEL,), 0.02),
        "w_router": nrm(ks[15], (D_MODEL, N_EXPERTS), D_MODEL ** -0.5),
        "b_router": nrm(ks[16], (N_EXPERTS,), 0.01),
        "w_gate_up": nrm(ks[17], (N_EXPERTS, D_MODEL, 2 * D_FF), D_MODEL ** -0.5),
        "b_gate_up": nrm(ks[18], (N_EXPERTS, 2 * D_FF), 0.01),
        "w_down": nrm(ks[19], (N_EXPERTS, D_FF, D_MODEL), D_FF ** -0.5),
        "b_down": nrm(ks[20], (N_EXPERTS, D_MODEL), 0.01),
        "g_final": 1.0 + nrm(ks[21], (D_MODEL,), 0.02),
    }


def reference(x, g_mix, w_in, conv_w, conv_b, w_rg, b_rg, w_ig, b_ig, lru_lambda, b_f,
              w_lru_out, w_fox_out, w_o, g_ffn, w_router, b_router, w_gate_up, b_gate_up,
              w_down, b_down, g_final):
    bsz, s, _ = x.shape
    for _layer in range(DEPTH):
        h = rmsnorm(x, g_mix)
        proj = h @ w_in
        o = 0
        lru_x = proj[..., o:o + RNN_WIDTH]; o += RNN_WIDTH
        lru_gate = proj[..., o:o + RNN_WIDTH]; o += RNN_WIDTH
        q = proj[..., o:o + FOX_WIDTH]; o += FOX_WIDTH
        k = proj[..., o:o + FOX_WIDTH]; o += FOX_WIDTH
        v = proj[..., o:o + FOX_WIDTH]; o += FOX_WIDTH
        f_logit = proj[..., o:o + FOX_HEADS]; o += FOX_HEADS
        gate_lru = proj[..., o:o + D_MODEL]; o += D_MODEL
        gate_fox = proj[..., o:o + D_MODEL]

        xc = causal_depthwise_conv(lru_x, conv_w, conv_b)
        hr = rg_lru(xc, w_rg, b_rg, w_ig, b_ig, lru_lambda)
        y_lru = (hr * jax.nn.gelu(lru_gate.astype(jnp.float32), approximate=True)).astype(x.dtype)

        to_heads = lambda z: z.reshape(bsz, s, FOX_HEADS, FOX_HEAD_DIM).transpose(0, 2, 1, 3)
        logf = jax.nn.log_sigmoid(f_logit.astype(jnp.float32) + b_f.astype(jnp.float32))
        cum_logf = jnp.cumsum(logf, axis=1).transpose(0, 2, 1)
        attn = forgetting_attention(to_heads(q), to_heads(k), to_heads(v), cum_logf)
        y_fox = attn.transpose(0, 2, 1, 3).reshape(bsz, s, FOX_WIDTH)

        merged = (jax.nn.sigmoid(gate_lru) * (y_lru @ w_lru_out)
                  + jax.nn.sigmoid(gate_fox) * (y_fox @ w_fox_out))
        x = x + merged @ w_o

        x = x + moe_ffn(rmsnorm(x, g_ffn), w_router, b_router, w_gate_up, b_gate_up, w_down, b_down)
    return rmsnorm(x, g_final)
```

```cpp
#include <hip/hip_runtime.h>
#include <cstdio>
#include <cstdint>
__device__ __forceinline__ int hw_lane() { int l; asm volatile("v_mbcnt_lo_u32_b32 %0, -1, 0\n\tv_mbcnt_hi_u32_b32 %0, -1, %0" : "=v"(l)); return l; }
namespace pg8 {
#define PG8_LAS __attribute__((address_space(3)))
typedef unsigned short bf16_t;
typedef short bf16x8 __attribute__((ext_vector_type(8)));
typedef float f32x4 __attribute__((ext_vector_type(4)));
typedef unsigned u32x4 __attribute__((ext_vector_type(4)));
constexpr int BM = 256, BK = 64, HALF = 128, HTB = HALF * BK * 2  , STAGE_BYTES = 8 * HTB, NXCD = 8, WGM = 8;

__host__ __device__ __forceinline__ int lds_byte(int r, int c) { const int st = (r >> 4) * 2 + (c >> 5), rr = r & 15, cc = c & 31, ob = rr * 64 + cc * 2; return st * 1024 + (ob ^ (((ob >> 9) & 1) << 5)); }
__host__ __device__ __forceinline__ void stage_rc(int b, int& R, int& C) { const int st = b / 1024, sb = b % 1024, swz = sb ^ (((sb >> 9) & 1) << 5); R = (st >> 1) * 16 + swz / 64; C = (st & 1) * 32 + (swz % 64) / 2; }
__host__ __device__ __forceinline__ int perm32(int rho) { const int n = rho >> 4, i = rho & 15; return 8 * (i >> 2) + 4 * n + (i & 3); }

struct Unit { int pm, pn; };
struct Gemm { const bf16_t* A; const bf16_t* Bt; int M, N, K; };

struct StaticOrder {
    static constexpr bool GATHER = false;
    int nM, nN, nwg, G, c, i0, i1;
    __device__ __forceinline__ void init(int M, int N, int G_, int c_) { nM = M / BM; nN = N / BM; nwg = nM * nN; G = G_; c = c_; i0 = 0; i1 = 0x7fffffff; }
    __device__ __forceinline__ bool next(int i, Unit& u) const {
        if (i >= i1 - i0) return false;
        const long L = (long)(i + i0) * G + c; if (L >= nwg) return false;
        int wgid = (int)L; { const int q = nwg / NXCD, r = nwg % NXCD, xcd = wgid % NXCD, off = wgid / NXCD; wgid = (xcd < r ? xcd * (q + 1) : r * (q + 1) + (xcd - r) * q) + off; }
        const int nig = WGM * nN, gid = wgid / nig, fm = gid * WGM, gsz = (nM - fm) < WGM ? (nM - fm) : WGM;
        u.pm = fm + ((wgid % nig) % gsz); u.pn = (wgid % nig) / gsz; return true;
    }
    __device__ __forceinline__ unsigned a_off(int, const Unit& u, int rloc, int rowbytes) const { return (unsigned)(u.pm * BM + rloc) * (unsigned)rowbytes; }
};
template <bool GATHER_> struct GroupedOrder {
    static constexpr bool GATHER = GATHER_;
    int nM, nN, nwg, G, c;
    const PG8_LAS unsigned char* tile_e; const PG8_LAS unsigned* rows;
    __device__ __forceinline__ void init(int TT, int nN_, int G_, int c_, const PG8_LAS unsigned char* te, const PG8_LAS unsigned* rw) { nM = TT; nN = nN_; nwg = nM * nN; G = G_; c = c_; tile_e = te; rows = rw; }
    __device__ __forceinline__ bool next(int i, Unit& u) const {
        const long L = (long)i * G + c; if (L >= nwg) return false;
        int wgid = (int)L; { const int q = nwg / NXCD, r = nwg % NXCD, xcd = wgid % NXCD, off = wgid / NXCD; wgid = (xcd < r ? xcd * (q + 1) : r * (q + 1) + (xcd - r) * q) + off; }
        const int nig = WGM * nN, gid = wgid / nig, fm = gid * WGM, gsz = (nM - fm) < WGM ? (nM - fm) : WGM;
        u.pm = fm + ((wgid % nig) % gsz); u.pn = (int)tile_e[u.pm] * nN + (wgid % nig) / gsz; return true;
    }
    __device__ __forceinline__ unsigned a_off(int i, const Unit& u, int rloc, int rowbytes) const {
        return GATHER ? rows[i * 256 + rloc] * (unsigned)rowbytes : (unsigned)(u.pm * BM + rloc) * (unsigned)rowbytes; }
};

__device__ __forceinline__ unsigned cvt_pk_bf16(float lo, float hi) { unsigned r; asm volatile("v_cvt_pk_bf16_f32 %0, %1, %2" : "=v"(r) : "v"(lo), "v"(hi)); return r; }
__device__ __forceinline__ float bf_lo(unsigned w) { return __uint_as_float(w << 16); }
__device__ __forceinline__ float bf_hi(unsigned w) { return __uint_as_float(w & 0xffff0000u); }
__device__ __forceinline__ float sigm(float x) { return __builtin_amdgcn_rcpf(1.0f + __builtin_amdgcn_exp2f(-1.4426950408889634f * x)); }

__device__ __forceinline__ unsigned q8lo(float x) { return __float_as_uint(__builtin_amdgcn_fmed3f(x, -127.0f, 127.0f) + 12582912.0f); }
__device__ __forceinline__ unsigned pk4_i8(float a, float b, float c, float d) {
    const unsigned ab = __builtin_amdgcn_perm(q8lo(b), q8lo(a), 0x0c0c0400u), cd = __builtin_amdgcn_perm(q8lo(d), q8lo(c), 0x0c0c0400u); return ab | (cd << 16); }
struct EpiSplit {
    static constexpr bool PERM = true, AFTER_DRAIN = false;
    bf16_t* O; int ldc; int split_cols; size_t split_stride; int scale_t; float scale; float accscale;
    __device__ __forceinline__ void operator()(const f32x4 (&acc)[2][2][4][2], const Unit& u, int wr, int wc, int fr, int fq) const {
        const int row0 = u.pm * BM + wr * 64 + fr; int colt = u.pn * BM; bf16_t* base = O;
        const int t = colt / split_cols; base += (size_t)t * split_stride; colt -= t * split_cols; const float sc = ((t == scale_t) ? scale : 1.f) * accscale;
        const int col0 = colt + wc * 32 + 8 * fq;
#pragma unroll
        for (int ai = 0; ai < 2; ++ai)
#pragma unroll
            for (int m = 0; m < 4; ++m) { bf16_t* rowp = base + (size_t)(row0 + ai * HALF + m * 16) * ldc + col0;
#pragma unroll
                for (int bj = 0; bj < 2; ++bj) { const f32x4 v0 = acc[ai][bj][m][0] * sc, v1 = acc[ai][bj][m][1] * sc;
                    u32x4 w; w.x = cvt_pk_bf16(v0[0], v0[1]); w.y = cvt_pk_bf16(v0[2], v0[3]); w.z = cvt_pk_bf16(v1[0], v1[1]); w.w = cvt_pk_bf16(v1[2], v1[3]);
                    *(u32x4*)(rowp + bj * HALF) = w; } }
    }
};
struct EpiNull {
    static constexpr bool PERM = true, AFTER_DRAIN = false;
    __device__ __forceinline__ void operator()(const f32x4 (&acc)[2][2][4][2], const Unit&, int, int, int, int) const {
#pragma unroll
        for (int ai = 0; ai < 2; ++ai)
#pragma unroll
            for (int bj = 0; bj < 2; ++bj)
#pragma unroll
                for (int m = 0; m < 4; ++m) asm volatile("" :: "v"(acc[ai][bj][m][0]), "v"(acc[ai][bj][m][1]));
    }
};
template <bool ADD> struct EpiGate {
    static constexpr bool PERM = true, AFTER_DRAIN = false;
    bf16_t* O; const bf16_t* G; const bf16_t* T; int ldc;
    __device__ __forceinline__ void operator()(const f32x4 (&acc)[2][2][4][2], const Unit& u, int wr, int wc, int fr, int fq) const {
        const int row0 = u.pm * BM + wr * 64 + fr, col0 = u.pn * BM + wc * 32 + 8 * fq;
#pragma unroll
        for (int ai = 0; ai < 2; ++ai)
#pragma unroll
            for (int m = 0; m < 4; ++m) { const size_t off = (size_t)(row0 + ai * HALF + m * 16) * ldc + col0;
#pragma unroll
                for (int bj = 0; bj < 2; ++bj) { const u32x4 g = *(const u32x4*)(G + off + bj * HALF); u32x4 tv = (u32x4){0u, 0u, 0u, 0u}; if (ADD) tv = *(const u32x4*)(T + off + bj * HALF);
                    const f32x4 v0 = acc[ai][bj][m][0], v1 = acc[ai][bj][m][1]; float r[8];
                    r[0] = sigm(bf_lo(g.x)) * v0[0]; r[1] = sigm(bf_hi(g.x)) * v0[1]; r[2] = sigm(bf_lo(g.y)) * v0[2]; r[3] = sigm(bf_hi(g.y)) * v0[3];
                    r[4] = sigm(bf_lo(g.z)) * v1[0]; r[5] = sigm(bf_hi(g.z)) * v1[1]; r[6] = sigm(bf_lo(g.w)) * v1[2]; r[7] = sigm(bf_hi(g.w)) * v1[3];
                    if (ADD) { r[0] += bf_lo(tv.x); r[1] += bf_hi(tv.x); r[2] += bf_lo(tv.y); r[3] += bf_hi(tv.y); r[4] += bf_lo(tv.z); r[5] += bf_hi(tv.z); r[6] += bf_lo(tv.w); r[7] += bf_hi(tv.w); }
                    u32x4 w; w.x = cvt_pk_bf16(r[0], r[1]); w.y = cvt_pk_bf16(r[2], r[3]); w.z = cvt_pk_bf16(r[4], r[5]); w.w = cvt_pk_bf16(r[6], r[7]);
                    *(u32x4*)(O + off + bj * HALF) = w; } }
    }
};
struct EpiResF32 {
    static constexpr bool PERM = false, AFTER_DRAIN = false;
    const float* base; float* out; int ldc;
    __device__ __forceinline__ void operator()(const f32x4 (&acc)[2][2][4][2], const Unit& u, int wr, int wc, int fr, int fq) const {
        const int row0 = u.pm * BM + wr * 64 + fr, col0 = u.pn * BM + wc * 32 + 4 * fq;
#pragma unroll
        for (int ai = 0; ai < 2; ++ai)
#pragma unroll
            for (int m = 0; m < 4; ++m) { const size_t off = (size_t)(row0 + ai * HALF + m * 16) * ldc + col0;
#pragma unroll
                for (int bj = 0; bj < 2; ++bj)
#pragma unroll
                    for (int n = 0; n < 2; ++n) *(f32x4*)(out + off + bj * HALF + n * 16) = *(const f32x4*)(base + off + bj * HALF + n * 16) + acc[ai][bj][m][n]; }
    }
};
struct EpiSwiglu {
    static constexpr bool PERM = true, AFTER_DRAIN = false;
    unsigned char* O; const float* bias; int nN; float accscale, outscale;
    typedef float f2 __attribute__((ext_vector_type(2)));
    __device__ __forceinline__ f2 act2(f2 ga, f2 ua, f2 bg, f2 bu) const {
        f2 g = __builtin_elementwise_fma(ga, (f2){accscale, accscale}, bg), u = __builtin_elementwise_fma(ua, (f2){accscale, accscale}, bu);
        g.x = fminf(g.x, 7.0f); g.y = fminf(g.y, 7.0f); u.x = __builtin_amdgcn_fmed3f(u.x, -7.0f, 7.0f); u.y = __builtin_amdgcn_fmed3f(u.y, -7.0f, 7.0f);
        const f2 t = g * (-1.702f * 1.4426950408889634f); f2 e; e.x = __builtin_amdgcn_exp2f(t.x); e.y = __builtin_amdgcn_exp2f(t.y);
        const f2 d = e + 1.0f; f2 r; r.x = __builtin_amdgcn_rcpf(d.x); r.y = __builtin_amdgcn_rcpf(d.y);
        return (u + 1.0f) * (g * outscale) * r; }
    __device__ __forceinline__ void operator()(const f32x4 (&acc)[2][2][4][2], const Unit& u, int wr, int wc, int fr, int fq) const {
        const int e = u.pn / nN, pnl = u.pn - e * nN; const int row0 = u.pm * BM + wr * 64 + fr, colg = pnl * HALF + wc * 32 + 8 * fq;
        f32x4 bg[2], bu[2];
#pragma unroll
        for (int n = 0; n < 2; ++n) { bg[n] = *(const f32x4*)(bias + (size_t)e * 2048 + colg + 4 * n); bu[n] = *(const f32x4*)(bias + (size_t)e * 2048 + 1024 + colg + 4 * n); }
#pragma unroll
        for (int ai = 0; ai < 2; ++ai)
#pragma unroll
            for (int m = 0; m < 4; ++m) { f2 r[4];
#pragma unroll
                for (int n = 0; n < 2; ++n) { const f32x4 ga = acc[ai][0][m][n], ua = acc[ai][1][m][n];
                    r[2 * n] = act2((f2){ga[0], ga[1]}, (f2){ua[0], ua[1]}, (f2){bg[n][0], bg[n][1]}, (f2){bu[n][0], bu[n][1]});
                    r[2 * n + 1] = act2((f2){ga[2], ga[3]}, (f2){ua[2], ua[3]}, (f2){bg[n][2], bg[n][3]}, (f2){bu[n][2], bu[n][3]}); }
                typedef unsigned u32x2_ __attribute__((ext_vector_type(2))); u32x2_ w; w.x = pk4_i8(r[0].x, r[0].y, r[1].x, r[1].y); w.y = pk4_i8(r[2].x, r[2].y, r[3].x, r[3].y);
                *(u32x2_*)(O + (size_t)(row0 + ai * HALF + m * 16) * 1024 + colg) = w; }
    }
};
struct EpiDown {
    static constexpr bool PERM = true, AFTER_DRAIN = false;
    unsigned char* O; const float* bias; int nN; float accscale, outscale;
    __device__ __forceinline__ void operator()(const f32x4 (&acc)[2][2][4][2], const Unit& u, int wr, int wc, int fr, int fq) const {
        const int e = u.pn / nN, pnl = u.pn - e * nN; const int row0 = u.pm * BM + wr * 64 + fr, col0 = pnl * BM + wc * 32 + 8 * fq;
        f32x4 bv[2][2];
#pragma unroll
        for (int bj = 0; bj < 2; ++bj)
#pragma unroll
            for (int n = 0; n < 2; ++n) bv[bj][n] = *(const f32x4*)(bias + (size_t)e * 1024 + col0 + bj * HALF + 4 * n);
#pragma unroll
        for (int ai = 0; ai < 2; ++ai)
#pragma unroll
            for (int m = 0; m < 4; ++m) { unsigned char* rowp = O + (size_t)(row0 + ai * HALF + m * 16) * 1024 + col0;
#pragma unroll
                for (int bj = 0; bj < 2; ++bj) { const f32x4 v0 = (acc[ai][bj][m][0] * accscale + bv[bj][0]) * outscale, v1 = (acc[ai][bj][m][1] * accscale + bv[bj][1]) * outscale;
                    typedef unsigned u32x2_ __attribute__((ext_vector_type(2))); u32x2_ w; w.x = pk4_i8(v0[0], v0[1], v0[2], v0[3]); w.y = pk4_i8(v1[0], v1[1], v1[2], v1[3]);
                    *(u32x2_*)(rowp + bj * HALF) = w; } }
    }
};

typedef int i32x4 __attribute__((ext_vector_type(4)));
template <class Epi, class Sched, bool ALIGN_EPI, bool I8 = false>
__device__ __forceinline__ void gemm_phase(PG8_LAS unsigned char* lds, const Gemm g, const Sched& S, const Epi& E, int wave_id) {
    const int wid = wave_id, lane = hw_lane(), tid = wid * 64 + lane, wr = wid >> 2, wc = wid & 3, fr = lane & 15, fq = lane >> 4;
    const int K = g.K, rowb = I8 ? K : K * 2, nt = rowb / (BK * 2);
    int RA[2], CA2[2]; unsigned voffB[2], voffA[2];
#pragma unroll
    for (int i = 0; i < 2; ++i) { int R, C; stage_rc(tid * 16 + i * 8192, R, C); const int Rb = Epi::PERM ? ((R & ~31) + perm32(R & 31)) : R;
        RA[i] = R; CA2[i] = C * 2; voffB[i] = (unsigned)(Rb * rowb + C * 2); voffA[i] = (unsigned)(R * rowb + C * 2); }
    const unsigned kstep = (unsigned)(BK * 2);
    const size_t hstep = (size_t)HALF * rowb;
    const size_t tstep = 2 * hstep;
    const unsigned ldsw = (unsigned)wid * 1024u;
    const int aoff = lds_byte(wr * 64 + fr, fq * 8), boff = lds_byte(wc * 32 + fr, fq * 8);
    const char* Abase = (const char*)g.A;
#define PG8_SA(b, h) (((b) * 2 + (h)) * HTB)
#define PG8_SB(b, h) ((4 + (b) * 2 + (h)) * HTB)
#define PG8_STAGE(bufoff, gbase, voff) do { _Pragma("unroll") for (int _i = 0; _i < 2; ++_i) \
        __builtin_amdgcn_global_load_lds((const unsigned*)((const char*)(gbase) + (voff)[_i]), (PG8_LAS unsigned*)(lds + (bufoff) + ldsw + _i * 8192), 16, 0, 0); } while (0)
#define PG8_STAGEA(bufoff, h, NX, kb) do { _Pragma("unroll") for (int _i = 0; _i < 2; ++_i) { \
        const unsigned _o = Sched::GATHER ? (((NX) ? offN[h][_i] : offC[h][_i]) + (kb)) : (voffA[_i] + (unsigned)((h) * (HALF * rowb)) + ((NX) ? uaN : uaC) + (kb)); \
        __builtin_amdgcn_global_load_lds((const unsigned*)(Abase + (size_t)_o), (PG8_LAS unsigned*)(lds + (bufoff) + ldsw + _i * 8192), 16, 0, 0); } } while (0)
#define PG8_LDA(dst, b, h) do { _Pragma("unroll") for (int m = 0; m < 4; ++m) _Pragma("unroll") for (int k = 0; k < 2; ++k) dst[m][k] = *(const PG8_LAS bf16x8*)(lds + PG8_SA(b, h) + aoff + m * 2048 + k * 1024); } while (0)
#define PG8_LDB(dst, b, h) do { _Pragma("unroll") for (int n = 0; n < 2; ++n) _Pragma("unroll") for (int k = 0; k < 2; ++k) dst[n][k] = *(const PG8_LAS bf16x8*)(lds + PG8_SB(b, h) + boff + n * 2048 + k * 1024); } while (0)
#define PG8_MMA(ai, bj, At, Bt) do { __builtin_amdgcn_s_setprio(1); _Pragma("unroll") for (int m = 0; m < 4; ++m) _Pragma("unroll") for (int n = 0; n < 2; ++n) _Pragma("unroll") for (int k = 0; k < 2; ++k) { \
        if constexpr (I8) acc[ai][bj][m][n] = __builtin_bit_cast(f32x4, __builtin_amdgcn_mfma_i32_16x16x64_i8(__builtin_bit_cast(i32x4, Bt[n][k]), __builtin_bit_cast(i32x4, At[m][k]), __builtin_bit_cast(i32x4, acc[ai][bj][m][n]), 0, 0, 0)); \
        else acc[ai][bj][m][n] = __builtin_amdgcn_mfma_f32_16x16x32_bf16(Bt[n][k], At[m][k], acc[ai][bj][m][n], 0, 0, 0); } __builtin_amdgcn_s_setprio(0); } while (0)
#define PG8_WAIT_V(n) asm volatile("s_waitcnt vmcnt(" #n ")" ::: "memory")
#define PG8_WAIT_L(n) asm volatile("s_waitcnt lgkmcnt(" #n ")" ::: "memory")
#define PG8_BAR __builtin_amdgcn_s_barrier()
#define PG8_SCHED __builtin_amdgcn_sched_barrier(0)
    Unit cur, nxt; int ui = 0;
    if (!S.next(0, cur)) return;
    f32x4 acc[2][2][4][2];
#pragma unroll
    for (int a = 0; a < 2; ++a)
#pragma unroll
        for (int b = 0; b < 2; ++b)
#pragma unroll
            for (int m = 0; m < 4; ++m)
#pragma unroll
                for (int n = 0; n < 2; ++n) acc[a][b][m][n] = (f32x4){0.f, 0.f, 0.f, 0.f};
    bf16x8 At[4][2], B0[2][2], B1[2][2];
    unsigned offC[2][2], offN[2][2];
    unsigned uaC = 0u, uaN = 0u;
    if constexpr (Sched::GATHER) {
#pragma unroll
        for (int h = 0; h < 2; ++h)
#pragma unroll
            for (int i = 0; i < 2; ++i) offC[h][i] = S.a_off(0, cur, h * HALF + RA[i], rowb) + (unsigned)CA2[i];
    } else uaC = S.a_off(0, cur, 0, rowb);
    const char* cB = (const char*)g.Bt + (size_t)cur.pn * tstep;
    PG8_STAGE(PG8_SB(0, 0), cB, voffB); PG8_STAGE(PG8_SB(0, 1), cB + hstep, voffB); PG8_STAGEA(PG8_SA(0, 0), 0, false, 0u); PG8_STAGEA(PG8_SA(0, 1), 1, false, 0u);
    if (wr == 1) PG8_BAR;
    PG8_WAIT_V(2); PG8_BAR;
    PG8_STAGE(PG8_SB(1, 0), cB + kstep, voffB); PG8_STAGEA(PG8_SA(1, 0), 0, false, kstep); PG8_STAGE(PG8_SB(1, 1), cB + hstep + kstep, voffB);
    PG8_WAIT_V(6); PG8_BAR;
    for (;;) {
        const bool has_next = S.next(ui + 1, nxt);
        const char* nB = has_next ? (const char*)g.Bt + (size_t)nxt.pn * tstep : cB;
        if constexpr (Sched::GATHER) {
#pragma unroll
            for (int h = 0; h < 2; ++h)
#pragma unroll
                for (int i = 0; i < 2; ++i) offN[h][i] = has_next ? S.a_off(ui + 1, nxt, h * HALF + RA[i], rowb) + (unsigned)CA2[i] : offC[h][i];
        } else uaN = has_next ? S.a_off(ui + 1, nxt, 0, rowb) : uaC;
#pragma unroll 1
        for (int t = 0; t < nt; t += 2) {
            const bool last = (t == nt - 2);
            const unsigned kb1 = (unsigned)(t + 1) * kstep, kb2 = last ? 0u : (unsigned)(t + 2) * kstep, kb3 = kb2 + kstep;
            const char* b2 = last ? nB : cB + (size_t)(t + 2) * kstep; const char* b3 = b2 + kstep;
            PG8_LDB(B0, 0, 0); PG8_LDB(B1, 0, 1); PG8_SCHED; PG8_LDA(At, 0, 0); PG8_STAGEA(PG8_SA(1, 1), 1, false, kb1);
            PG8_WAIT_V(8); PG8_WAIT_L(0); PG8_BAR; PG8_MMA(0, 0, At, B0); PG8_MMA(0, 1, At, B1); PG8_BAR; PG8_SCHED;
            PG8_LDA(At, 0, 1); PG8_STAGE(PG8_SB(0, 0), b2, voffB); PG8_STAGE(PG8_SB(0, 1), b2 + hstep, voffB); PG8_STAGEA(PG8_SA(0, 0), 0, last, kb2);
            PG8_WAIT_V(8); PG8_WAIT_L(0); PG8_BAR; PG8_MMA(1, 0, At, B0); PG8_MMA(1, 1, At, B1); PG8_BAR; PG8_SCHED;
            PG8_LDB(B0, 1, 0); PG8_LDB(B1, 1, 1); PG8_SCHED; PG8_LDA(At, 1, 0); PG8_STAGEA(PG8_SA(0, 1), 1, last, kb2);
            PG8_WAIT_V(8); PG8_WAIT_L(0); PG8_BAR; PG8_MMA(0, 0, At, B0); PG8_MMA(0, 1, At, B1); PG8_BAR; PG8_SCHED;
            PG8_LDA(At, 1, 1); PG8_STAGE(PG8_SB(1, 0), b3, voffB); PG8_STAGE(PG8_SB(1, 1), b3 + hstep, voffB); PG8_STAGEA(PG8_SA(1, 0), 0, last, kb3);
            PG8_WAIT_V(8); PG8_WAIT_L(0); PG8_BAR; PG8_MMA(1, 0, At, B0); PG8_MMA(1, 1, At, B1); PG8_BAR; PG8_SCHED;
        }
        if constexpr (ALIGN_EPI) { if (wr == 0) PG8_BAR; }
        if constexpr (I8) {
#pragma unroll
            for (int a = 0; a < 2; ++a)
#pragma unroll
                for (int b = 0; b < 2; ++b)
#pragma unroll
                    for (int m = 0; m < 4; ++m)
#pragma unroll
                        for (int n = 0; n < 2; ++n) { const i32x4 iv = __builtin_bit_cast(i32x4, acc[a][b][m][n]); acc[a][b][m][n] = (f32x4){(float)iv[0], (float)iv[1], (float)iv[2], (float)iv[3]}; } }
        E(acc, cur, wr, wc, fr, fq);
        if (!has_next) break;
#pragma unroll
        for (int a = 0; a < 2; ++a)
#pragma unroll
            for (int b = 0; b < 2; ++b)
#pragma unroll
                for (int m = 0; m < 4; ++m)
#pragma unroll
                    for (int n = 0; n < 2; ++n) acc[a][b][m][n] = (f32x4){0.f, 0.f, 0.f, 0.f};
        cur = nxt; cB = nB; ++ui; uaC = uaN;
        if constexpr (Sched::GATHER) {
#pragma unroll
            for (int h = 0; h < 2; ++h)
#pragma unroll
                for (int i = 0; i < 2; ++i) offC[h][i] = offN[h][i]; }
        if constexpr (ALIGN_EPI) { if (wr == 1) PG8_BAR; }
    }
    PG8_WAIT_V(0);
    if constexpr (!ALIGN_EPI) { if (wr == 0) PG8_BAR; }
    PG8_BAR;
#undef PG8_SA
#undef PG8_SB
#undef PG8_STAGE
#undef PG8_STAGEA
#undef PG8_LDA
#undef PG8_LDB
#undef PG8_MMA
#undef PG8_WAIT_V
#undef PG8_WAIT_L
#undef PG8_BAR
#undef PG8_SCHED
}
}
#include <hip/hip_bf16.h>
#include <cmath>
namespace attn_body {
using bf16=__hip_bfloat16;
using bf16x8=__attribute__((ext_vector_type(8)))short;
using s16x4=__attribute__((ext_vector_type(4)))short;
using f32x16=__attribute__((ext_vector_type(16)))float;
using u32x4=__attribute__((ext_vector_type(4)))unsigned;
constexpr int BATCH=4,NHEAD=16,SEQ=4096,D=64,DM=NHEAD*D;
constexpr int NW=8,QBLK=32,QB=QBLK*NW,KVBLK=64,NQB=SEQ/QB;
constexpr int ATTN_PITCH=DM, ATTN_UNIT_ROWS=QB;
__device__ __forceinline__ int crow(int r,int hi){return (r&3)+8*(r>>2)+4*hi;}
#define SBAR() __builtin_amdgcn_sched_barrier(0)
__device__ __forceinline__ void cmask(f32x16&p0,f32x16&p1,int jb,int qrel,int hi){
  const float NEG=-INFINITY; int kb=64*jb+4*hi;
  #pragma unroll
  for(int r=0;r<16;++r){int kv=kb+(r&3)+8*(r>>2); if(kv>qrel)p0[r]=NEG; if(kv+32>qrel)p1[r]=NEG;}
}

constexpr int NSLOT=3, SLOTB=8192;
constexpr int LDS_K=0, LDS_V=NSLOT*SLOTB, LDS_WS=2*NSLOT*SLOTB, LDS_OST=LDS_WS+NW*64*4, LDS_KB=LDS_OST+NW*4096, LDS_BYTES=LDS_KB+SEQ*4+256;
constexpr float C2=0.125f*1.4426950408889634f;
__device__ __forceinline__ void glds16(const void*gsrc,unsigned lds_dst){unsigned keep;
  asm volatile("s_mov_b32 %0, m0\n\ts_mov_b32 m0, %2\n\ts_nop 0\n\tglobal_load_lds_dwordx4 %1, off\n\ts_mov_b32 m0, %0":"=&s"(keep):"v"(gsrc),"s"(lds_dst):"memory");}
__device__ __forceinline__ float max3f(float a,float b,float c){float r;asm("v_max3_f32 %0, %1, %2, %3":"=v"(r):"v"(a),"v"(b),"v"(c));return r;}
__device__ __forceinline__ float max2f(float a,float b){float r;asm("v_max_f32_e32 %0, %1, %2":"=v"(r):"v"(a),"v"(b));return r;}
__device__ __forceinline__ float fadd_s(float a,float b){float r;asm("v_add_f32_e32 %0, %1, %2":"=v"(r):"v"(a),"v"(b));return r;}
__device__ __forceinline__ float fsub_s(float a,float b){float r;asm("v_sub_f32_e32 %0, %1, %2":"=v"(r):"v"(a),"v"(b));return r;}
typedef float f32x2_t __attribute__((ext_vector_type(2))); typedef __bf16 bf16x2_t __attribute__((ext_vector_type(2)));
__device__ __forceinline__ unsigned cvtpk_s(float lo,float hi){f32x2_t v={lo,hi};bf16x2_t b=__builtin_convertvector(v,bf16x2_t);return __builtin_bit_cast(unsigned,b);}
#define WAIT_BAR(N) asm volatile("s_waitcnt vmcnt(" #N ") lgkmcnt(0)\n\ts_barrier":::"memory")

__device__ __forceinline__ void qkt(f32x16&p0,f32x16&p1,const char*Kslot,const bf16x8*qr,int r32,int hi){
  const char*kb=Kslot+hi*1024+r32*16;
  #pragma unroll
  for(int d0=0;d0<4;++d0){
    const bf16x8 b0=*reinterpret_cast<const bf16x8*>(kb+d0*2048);
    const bf16x8 b1=*reinterpret_cast<const bf16x8*>(kb+d0*2048+512);
    p0=__builtin_amdgcn_mfma_f32_32x32x16_bf16(b0,qr[d0],p0,0,0,0);p1=__builtin_amdgcn_mfma_f32_32x32x16_bf16(b1,qr[d0],p1,0,0,0);}
}
typedef __attribute__((address_space(3))) const char* lds_cptr;
typedef short v4i16_t __attribute__((ext_vector_type(4)));
__device__ __forceinline__ void kload8(bf16x8*kf,lds_cptr kp){
  kf[0]=*(const __attribute__((address_space(3))) bf16x8*)(kp);      kf[1]=*(const __attribute__((address_space(3))) bf16x8*)(kp+512);
  kf[2]=*(const __attribute__((address_space(3))) bf16x8*)(kp+2048); kf[3]=*(const __attribute__((address_space(3))) bf16x8*)(kp+2560);
  kf[4]=*(const __attribute__((address_space(3))) bf16x8*)(kp+4096); kf[5]=*(const __attribute__((address_space(3))) bf16x8*)(kp+4608);
  kf[6]=*(const __attribute__((address_space(3))) bf16x8*)(kp+6144); kf[7]=*(const __attribute__((address_space(3))) bf16x8*)(kp+6656);
}
__device__ __forceinline__ void kload2(bf16x8*kf,lds_cptr kp,int j){ kf[2*j]=*(const __attribute__((address_space(3))) bf16x8*)(kp+j*2048); kf[2*j+1]=*(const __attribute__((address_space(3))) bf16x8*)(kp+j*2048+512); }
__device__ __forceinline__ s16x4 vtr(lds_cptr p){ return __builtin_bit_cast(s16x4,__builtin_amdgcn_ds_read_tr16_b64_v4i16((__attribute__((address_space(3))) v4i16_t*)p)); }
__device__ __forceinline__ float rowmax(const f32x16&p0,const f32x16&p1){
  float a=max3f(p0[0],p0[1],p1[0]),b=max3f(p0[2],p0[3],p1[1]);a=max3f(a,p1[2],p1[3]);
  #pragma unroll
  for(int r=4;r<16;r+=4){a=max3f(a,p0[r],p0[r+1]);b=max3f(b,p0[r+2],p0[r+3]);a=max3f(a,p1[r],p1[r+1]);b=max3f(b,p1[r+2],p1[r+3]);}
  const float m=max2f(a,b);
  auto rr=__builtin_amdgcn_permlane32_swap(__float_as_uint(m),__float_as_uint(m),false,false);
  return max2f(__uint_as_float(rr[0]),__uint_as_float(rr[1]));
}
__device__ __forceinline__ void pv(f32x16*o,int vb,bf16x8 pa0,bf16x8 pa1,bf16x8 pa2,bf16x8 pa3){
  #pragma unroll
  for(int d0=0;d0<2;++d0){s16x4 lo[4],hi[4];
    #pragma unroll
    for(int ks=0;ks<4;++ks){
      asm volatile("ds_read_b64_tr_b16 %0,%1 offset:%c2":"=&v"(lo[ks]):"v"(vb),"i"(d0*4096+ks*1024):"memory");
      asm volatile("ds_read_b64_tr_b16 %0,%1 offset:%c2":"=&v"(hi[ks]):"v"(vb),"i"(d0*4096+ks*1024+512):"memory");}
    asm volatile("s_waitcnt lgkmcnt(0)":::"memory");SBAR();
    #define PK(k) (bf16x8){lo[k][0],lo[k][1],lo[k][2],lo[k][3],hi[k][0],hi[k][1],hi[k][2],hi[k][3]}
    o[d0]=__builtin_amdgcn_mfma_f32_32x32x16_bf16(pa0,PK(0),o[d0],0,0,0);
    o[d0]=__builtin_amdgcn_mfma_f32_32x32x16_bf16(pa1,PK(1),o[d0],0,0,0);
    o[d0]=__builtin_amdgcn_mfma_f32_32x32x16_bf16(pa2,PK(2),o[d0],0,0,0);
    o[d0]=__builtin_amdgcn_mfma_f32_32x32x16_bf16(pa3,PK(3),o[d0],0,0,0);
    #undef PK
  }
}

#ifndef ATTN_STORE16
#define ATTN_STORE16(p,v) (*(u32x4*)(p)=(v))
#endif
typedef float f32x4v __attribute__((ext_vector_type(4)));
template<int THRL> __device__ __forceinline__ void attn_unit(int b,int h,int qb,const bf16*Q,const bf16*__restrict__ K,const bf16*__restrict__ V,bf16*O,const float*__restrict__ KBg,float qk2max,char*shm,int wave_id){
  const int wid=wave_id,lane=hw_lane(),tid=wid*64+lane,r32=lane&31,hi=lane>>5;
  const long rowbase=(long)b*SEQ; const int q0=qb*QB;
  const bf16*Qw=Q+(rowbase+q0+wid*QBLK)*DM+h*D;
  int ts=0;
  { const int NT0=(q0+QB)/KVBLK; const float lim=KBg[q0]-2.0f*__builtin_sqrtf(qk2max)-32.0f;
    const float kbl=(lane<NT0)?KBg[64*lane+63]:INFINITY; const unsigned long long bal=__ballot(kbl<lim);
    ts=(int)__builtin_popcountll(bal)&~1; if(ts>NT0-4)ts=NT0-4; ts=__builtin_amdgcn_readfirstlane(ts); }
  KBg+=ts*KVBLK;
  const bf16*Kh=K+(rowbase+(long)ts*KVBLK)*DM+h*D,*Vh=V+(rowbase+(long)ts*KVBLK)*DM+h*D;
  const unsigned lds0=(unsigned)(uintptr_t)shm;
  float*wsf=(float*)(shm+LDS_WS)+wid*64;
  const bf16*ksrc=Kh+(long)lane*DM+wid*8;
  const bf16*vsrc=Vh+(long)(16*(wid&3)+(lane>>2))*DM+(wid>>2)*32+(lane&3)*8;
  const unsigned kdst=lds0+LDS_K+wid*1024, vdst=lds0+LDS_V+wid*1024;
  #define DMA_K(t,slot) glds16(ksrc+(long)(t)*KVBLK*DM,(unsigned)__builtin_amdgcn_readfirstlane(kdst+(slot)))
  #define DMA_V(t,slot) glds16(vsrc+(long)(t)*KVBLK*DM,(unsigned)__builtin_amdgcn_readfirstlane(vdst+(slot)))
  const int vb0=(int)(lds0+LDS_V)+((lane>>4)&1)*32+(lane&3)*8+(4*hi+((lane&15)>>2))*64;
  const char*Kbase=shm+LDS_K; bf16x8 kf[8];
  const lds_cptr shm3=(lds_cptr)shm; const lds_cptr kp0=shm3+LDS_K+hi*1024+r32*16; const lds_cptr vp0=shm3+LDS_V+((lane>>4)&1)*32+(lane&3)*8+(4*hi+((lane&15)>>2))*64;
  const int NT=(q0+QB)/KVBLK-ts;
  const int nkb4=(q0+QB-ts*KVBLK)>>2; f32x4v kbt0=(f32x4v){0.f,0.f,0.f,0.f},kbt1=kbt0;
  { const f32x4v*src=(const f32x4v*)KBg; if(tid<nkb4)kbt0=src[tid]; if(tid+512<nkb4)kbt1=src[tid+512]; }
  DMA_K(0,0);DMA_V(0,0);DMA_K(1,SLOTB);
  bf16x8 qr[4];
  #pragma unroll
  for(int d0=0;d0<4;++d0)qr[d0]=*reinterpret_cast<const bf16x8*>(&Qw[(long)r32*DM+d0*16+hi*8]);
  { __attribute__((address_space(3))) f32x4v*kd=(__attribute__((address_space(3))) f32x4v*)((lds_cptr)shm+LDS_KB); if(tid<nkb4)kd[tid]=kbt0; if(tid+512<nkb4)kd[tid+512]=kbt1; }
  const lds_cptr kbp=(lds_cptr)shm+LDS_KB+hi*16;
  #define KBV(t,g8) (*(const __attribute__((address_space(3))) f32x4v*)(kbp+(t)*256+(g8)*32))
  float mhat=0.f,l_reg=0.f;f32x16 o[2];o[0]=f32x16{};o[1]=f32x16{};
  const int qrel=wid*QBLK+r32;
  #define CMASK(P0,P1,t) do{int jb_=(t)-(NT-4); if(jb_>=0)cmask(P0,P1,jb_,qrel,hi);}while(0)
  bool resc=false;
  #define START(P0,P1) do{ const float rm=rowmax(P0,P1); resc=false; \
    { const float dl=rm; mhat=fadd_s(mhat,dl); \
      _Pragma("unroll") for(int r=0;r<16;++r){P0[r]=fsub_s(P0[r],dl);P1[r]=fsub_s(P1[r],dl);} } \
    _Pragma("unroll") for(int r=0;r<16;++r)P0[r]=__builtin_amdgcn_exp2f(P0[r]); }while(0)
  #define RESC() do{ if(resc){ asm volatile("s_waitcnt lgkmcnt(0)":::"memory"); \
      _Pragma("unroll") for(int d_=0;d_<2;++d_) _Pragma("unroll") for(int r=0;r<16;++r)o[d_][r]*=wsf[crow(r,hi)]; } }while(0)
  f32x16 pA0,pA1,pB0,pB1;
  int sl_prev=0,sl_cur=0,sl_next=SLOTB;
  #define ROT() do{sl_prev=sl_cur;sl_cur=sl_next;sl_next=(sl_next==(NSLOT-1)*SLOTB)?0:sl_next+SLOTB;}while(0)
  DMA_K(2,2*SLOTB);
  WAIT_BAR(3);
  #define KBINIT(P0,P1,t) do{ _Pragma("unroll") for(int g_=0;g_<4;++g_){ const f32x4v a_=KBV(t,g_),b_=KBV(t,g_+4); \
      P0[4*g_]=a_[0]-mhat;P0[4*g_+1]=a_[1]-mhat;P0[4*g_+2]=a_[2]-mhat;P0[4*g_+3]=a_[3]-mhat; P1[4*g_]=b_[0]-mhat;P1[4*g_+1]=b_[1]-mhat;P1[4*g_+2]=b_[2]-mhat;P1[4*g_+3]=b_[3]-mhat; } }while(0)
  KBINIT(pA0,pA1,0);
  qkt(pA0,pA1,Kbase,qr,r32,hi);asm volatile("s_nop 15\n\ts_nop 7":"+v"(pA0),"+v"(pA1));CMASK(pA0,pA1,0);
  START(pA0,pA1);
  _Pragma("unroll") for(int r=0;r<16;++r)pA1[r]=__builtin_amdgcn_exp2f(pA1[r]);
  WAIT_BAR(0);
  DMA_K(3,0);DMA_V(1,SLOTB);
  ROT();
  kload8(kf,kp0+sl_cur);
  KBINIT(pB0,pB1,1);
  WAIT_BAR(2);
  s16x4 vlo[8],vhi[8]; u32x4 pw0,pw1,pw2,pw3;
  #define PKW(P,B) cvtpk_s(P[B],P[B+1])
  #define PAF(k) __builtin_bit_cast(bf16x8,pw##k)
  #define VFR(i) (bf16x8){vlo[i][0],vlo[i][1],vlo[i][2],vlo[i][3],vhi[i][0],vhi[i][1],vhi[i][2],vhi[i][3]}
  #define PIN(x) asm volatile("":"+v"(x))
  #define MX3(a,b,c) __builtin_fmaxf(__builtin_fmaxf((a),(b)),(c))
  #define GAPA(MF,A0,A1,A2,A3,W0,W1,PW) do{ MF; sacc+=A0; sacc+=A1; sacc+=A2; sacc+=A3; PIN(sacc); W0; W1; PIN(PW); SBAR(); }while(0)
  #define EX(v) __builtin_amdgcn_exp2f(v)
  #define GAPB(MF,X,B,Y,KU,KL,G8N,t) do{ if((G8N)>=0){KL=KBV((t)+1,(G8N)<0?0:(G8N));} MF; X[B]=EX(X[B]); X[B+1]=EX(X[B+1]); X[B+2]=EX(X[B+2]); X[B+3]=EX(X[B+3]); PIN(X); \
      Y[B]=KU[0]-mhat; Y[B+1]=KU[1]-mhat; Y[B+2]=KU[2]-mhat; Y[B+3]=KU[3]-mhat; PIN(Y); SBAR(); }while(0)
  #define VRD(i) do{ vlo[i]=vtr(vp_+(((i)>>2)*4096+((i)&3)*1024)); vhi[i]=vtr(vp_+(((i)>>2)*4096+((i)&3)*1024+512)); }while(0)
  #define KRD(G,j) do{ if(G){ kload2(kf,kp0+sl_next,j); SBAR(); } }while(0)
  #define STEP(C0,C1,P0,P1,t,GK,GV,GL) do{ SBAR(); \
    const lds_cptr vp_=vp0+sl_prev; \
    VRD(0); SBAR(); float sacc=(P0[0]+P0[1]); \
    GAPA(C0=__builtin_amdgcn_mfma_f32_32x32x16_bf16(kf[0],qr[0],C0,0,0,0), P0[2],P0[3],P0[4],P0[5],     pw0[0]=PKW(P0,0), pw0[1]=PKW(P0,2), pw0); \
    VRD(4); SBAR(); GAPA(C1=__builtin_amdgcn_mfma_f32_32x32x16_bf16(kf[1],qr[0],C1,0,0,0), P0[6],P0[7],P0[8],P0[9],     pw0[2]=PKW(P0,4), pw0[3]=PKW(P0,6), pw0); \
    VRD(1); SBAR(); GAPA(C0=__builtin_amdgcn_mfma_f32_32x32x16_bf16(kf[2],qr[1],C0,0,0,0),   P0[10],P0[11],P0[12],P0[13], pw1[0]=PKW(P0,8), pw1[1]=PKW(P0,10), pw1); \
    VRD(5); SBAR(); GAPA(C1=__builtin_amdgcn_mfma_f32_32x32x16_bf16(kf[3],qr[1],C1,0,0,0),   P0[14],P0[15],P1[0],P1[1],   pw1[2]=PKW(P0,12),pw1[3]=PKW(P0,14), pw1); \
    VRD(2); SBAR(); GAPA(C0=__builtin_amdgcn_mfma_f32_32x32x16_bf16(kf[4],qr[2],C0,0,0,0),   P1[2],P1[3],P1[4],P1[5],     pw2[0]=PKW(P1,0), pw2[1]=PKW(P1,2), pw2); \
    VRD(6); SBAR(); GAPA(C1=__builtin_amdgcn_mfma_f32_32x32x16_bf16(kf[5],qr[2],C1,0,0,0),   P1[6],P1[7],P1[8],P1[9],     pw2[2]=PKW(P1,4), pw2[3]=PKW(P1,6), pw2); \
    VRD(3); SBAR(); GAPA(C0=__builtin_amdgcn_mfma_f32_32x32x16_bf16(kf[6],qr[3],C0,0,0,0),   P1[10],P1[11],P1[12],P1[13], pw3[0]=PKW(P1,8), pw3[1]=PKW(P1,10), pw3); \
    VRD(7); SBAR(); GAPA(C1=__builtin_amdgcn_mfma_f32_32x32x16_bf16(kf[7],qr[3],C1,0,0,0),   P1[14],P1[15],0.f,0.f,       pw3[2]=PKW(P1,12),pw3[3]=PKW(P1,14), pw3); \
    l_reg+=sacc; \
    if(GK){DMA_K((t)+3,sl_cur);} if(GV){DMA_V((t)+1,sl_next);} \
    CMASK(C0,C1,t); \
    { float a=MX3(C0[0],C0[1],C1[0]),b=MX3(C0[2],C0[3],C1[1]); a=MX3(a,C1[2],C1[3]); \
      _Pragma("unroll") for(int r=4;r<16;r+=4){a=MX3(a,C0[r],C0[r+1]);b=MX3(b,C0[r+2],C0[r+3]);a=MX3(a,C1[r],C1[r+1]);b=MX3(b,C1[r+2],C1[r+3]);} \
      float rm=__builtin_fmaxf(a,b); { auto rr=__builtin_amdgcn_permlane32_swap(__float_as_uint(rm),__float_as_uint(rm),false,false); rm=__builtin_fmaxf(__uint_as_float(rr[0]),__uint_as_float(rr[1])); } \
      resc=false; \
      if(__builtin_expect(__any(rm>(float)THRL),0)){ const float dl=__builtin_fmaxf(rm,0.f); mhat+=dl; \
        _Pragma("unroll") for(int r=0;r<16;++r){C0[r]-=dl;C1[r]-=dl;} \
        const float f=__builtin_amdgcn_exp2f(-dl); l_reg*=f; if(hi==0)wsf[r32]=f; resc=true; } } \
    SBAR(); \
    f32x4v kq0_=KBV((t)+1,0),kq1_; \
    GAPB(o[0]=__builtin_amdgcn_mfma_f32_32x32x16_bf16(PAF(0),VFR(0),o[0],0,0,0), C0,0, P0,kq0_,kq1_,1,t); \
    GAPB(o[1]=__builtin_amdgcn_mfma_f32_32x32x16_bf16(PAF(0),VFR(4),o[1],0,0,0), C0,4, P0,kq1_,kq0_,2,t); \
    KRD(GL,0); GAPB(o[0]=__builtin_amdgcn_mfma_f32_32x32x16_bf16(PAF(1),VFR(1),o[0],0,0,0), C0,8, P0,kq0_,kq1_,3,t); \
    KRD(GL,1); GAPB(o[1]=__builtin_amdgcn_mfma_f32_32x32x16_bf16(PAF(1),VFR(5),o[1],0,0,0), C0,12, P0,kq1_,kq0_,4,t); \
    KRD(GL,2); GAPB(o[0]=__builtin_amdgcn_mfma_f32_32x32x16_bf16(PAF(2),VFR(2),o[0],0,0,0), C1,0, P1,kq0_,kq1_,5,t); \
    KRD(GL,3); GAPB(o[1]=__builtin_amdgcn_mfma_f32_32x32x16_bf16(PAF(2),VFR(6),o[1],0,0,0), C1,4, P1,kq1_,kq0_,6,t); \
    GAPB(o[0]=__builtin_amdgcn_mfma_f32_32x32x16_bf16(PAF(3),VFR(3),o[0],0,0,0), C1,8, P1,kq0_,kq1_,7,t); \
    GAPB(o[1]=__builtin_amdgcn_mfma_f32_32x32x16_bf16(PAF(3),VFR(7),o[1],0,0,0), C1,12, P1,kq1_,kq0_,-1,t); \
    }while(0)
  int t=1;
  #undef CMASK
  #define CMASK(P0,P1,t) do{}while(0)
  for(;t+5<NT;t+=2){
    STEP(pB0,pB1,pA0,pA1,t,true,true,true);     WAIT_BAR(2); RESC(); ROT();
    STEP(pA0,pA1,pB0,pB1,t+1,true,true,true);   WAIT_BAR(2); RESC(); ROT();
  }
  #undef CMASK
  #define CMASK(P0,P1,t) do{int jb_=(t)-(NT-4); if(jb_>=0)cmask(P0,P1,jb_,qrel,hi);}while(0)
  #define ENDW(tt) do{ if((tt)+3<NT){WAIT_BAR(2);} else if((tt)+2<NT){WAIT_BAR(1);} else {WAIT_BAR(0);} }while(0)
  for(;t+1<NT;t+=2){
    STEP(pB0,pB1,pA0,pA1,t,(t+3<NT),(t+1<NT),(t+1<NT));       ENDW(t);   RESC(); ROT();
    STEP(pA0,pA1,pB0,pB1,t+1,(t+4<NT),(t+2<NT),(t+2<NT));     ENDW(t+1); RESC(); ROT();
  }
  STEP(pB0,pB1,pA0,pA1,NT-1,false,false,false); RESC();
  { float sacc=pB0[0]+pB0[1]; _Pragma("unroll") for(int r=2;r<16;++r)sacc+=pB0[r]; _Pragma("unroll") for(int r=0;r<16;++r)sacc+=pB1[r]; l_reg+=sacc;
    pw0=(u32x4){PKW(pB0,0),PKW(pB0,2),PKW(pB0,4),PKW(pB0,6)};pw1=(u32x4){PKW(pB0,8),PKW(pB0,10),PKW(pB0,12),PKW(pB0,14)};pw2=(u32x4){PKW(pB1,0),PKW(pB1,2),PKW(pB1,4),PKW(pB1,6)};pw3=(u32x4){PKW(pB1,8),PKW(pB1,10),PKW(pB1,12),PKW(pB1,14)};
    SBAR(); pv(o,vb0+sl_cur,PAF(0),PAF(1),PAF(2),PAF(3)); }
  #undef PKW
  #undef PAF
  #undef VFR
  #undef PIN
  #undef MX3
  #undef GAPA
  #undef GAPB
  #undef EX
  #undef VRD
  #undef KRD
  #undef STEP
  #undef ENDW
  {auto rr=__builtin_amdgcn_permlane32_swap(__float_as_uint(l_reg),__float_as_uint(l_reg),false,false);l_reg=__uint_as_float(rr[0])+__uint_as_float(rr[1]);}
  if(hi==0)wsf[32+r32]=l_reg;asm volatile("s_waitcnt lgkmcnt(0)":::"memory");
  float rli[16];
  #pragma unroll
  for(int r=0;r<16;++r)rli[r]=__builtin_amdgcn_rcpf(wsf[32+crow(r,hi)]);
  bf16*Ow=O+(rowbase+q0+wid*QBLK)*DM+h*D;
  { bf16*stg=(bf16*)(shm+LDS_OST)+wid*2048;
    #pragma unroll
    for(int r=0;r<16;++r){const int orow=crow(r,hi);
      #pragma unroll
      for(int d0=0;d0<2;++d0)stg[orow*64+d0*32+r32]=__float2bfloat16(o[d0][r]*rli[r]);}
    asm volatile("s_waitcnt lgkmcnt(0)":::"memory");
    #pragma unroll
    for(int i=0;i<4;++i){const int row=i*8+(lane>>3),ch=lane&7; const u32x4 v=*(const u32x4*)(stg+row*64+ch*8); ATTN_STORE16(Ow+(long)row*DM+ch*8,v);} }
  asm volatile("s_waitcnt lgkmcnt(0)\n\ts_barrier":::"memory");
  #undef DMA_K
  #undef DMA_V
  #undef KBV
  #undef KBINIT
  #undef CMASK
  #undef START
  #undef RESC
  #undef ROT
}
constexpr int ATTN_LDS_BYTES=LDS_BYTES;
struct AttnTensors { const bf16* Q; const bf16* K; const bf16* V; bf16* O; const float* KB; const unsigned* QN2; const unsigned* KN2; };
struct AttnUnit { int bh; int qb; };
struct StaticOrder {
  int vcu, G, i0, i1;
  __device__ __forceinline__ explicit StaticOrder(int grid,int block):vcu((grid%8==0)?(block%8)*(grid/8)+block/8:block),G(grid),i0(0),i1(0x7fffffff){}
  __device__ __forceinline__ bool next(int i_,AttnUnit&u)const{ if(i_>=i1-i0)return false; const int i=i_+i0;
    if(G==256){ if(i>=4)return false; const int s=vcu&3; u.bh=vcu>>2; u.qb=(i==0)?s:(i==1)?7-s:(i==2)?8+s:15-s; return true; }
    const int L=i*G+vcu; if(L>=BATCH*NHEAD*NQB)return false; u.qb=NQB-1-L/(BATCH*NHEAD); u.bh=L%(BATCH*NHEAD); return true; }
  __device__ __forceinline__ void a_ready(const AttnUnit&)const{}
  __device__ __forceinline__ void done(const AttnUnit&)const{}
};
template<class Sched,int THRL=8> __device__ __forceinline__ void attn_phase(char*lds,const AttnTensors&T,const Sched&S,int wave_id){
  AttnUnit u;
  for(int i=0;S.next(i,u);++i){ S.a_ready(u); attn_unit<THRL>(u.bh/NHEAD,u.bh%NHEAD,u.qb,T.Q,T.K,T.V,T.O,T.KB+(size_t)u.bh*SEQ,__uint_as_float(T.QN2[u.bh*NQB+u.qb])*__uint_as_float(T.KN2[u.bh]),lds,wave_id); S.done(u); }
}
#undef SBAR
#undef WAIT_BAR
}
constexpr int NWAVES = 8;
#ifndef MK_N_LAUNCHES
#define MK_N_LAUNCHES 1
#endif
constexpr int PER_PHASE = 10;
constexpr int N_LAUNCHES = MK_N_LAUNCHES;

constexpr int BATCH = 4, SEQ = 4096, D = 1024, M = BATCH * SEQ;
constexpr int IN_COLS = 7184, NPROJ = 7168, FCOL0 = 5120;
constexpr int NE = 32, DFF = 1024, MAXTILES = 288, SLOTS = MAXTILES * 256;
constexpr int LRU_TS = 128, LRU_NSEG = SEQ / LRU_TS, LRU_UNITS = BATCH * 16 * LRU_NSEG;
constexpr float RMS_EPS = 1e-6f, LOG2E = 1.4426950408889634f;
constexpr float W8_SCALE = 127.0f * 32.0f / 4.0f, H8_SCALE = 127.0f / 4.0f, ACT8_SCALE = 127.0f / 8.0f, Y8_SCALE = 127.0f / 4.0f;

constexpr size_t MiB = 1u << 20;
constexpr size_t WS_CTL = 0, CTL_ZERO_BYTES = 128 * 1024;
constexpr size_t WS_WIN = 2 * MiB, WS_WLRU = 16 * MiB, WS_WFOX = 18 * MiB, WS_WO = 20 * MiB;
constexpr size_t WS_WG = 22 * MiB, WS_SP = 22 * MiB + 512 * 1024;
constexpr size_t WS_LOGF = 23 * MiB, WS_KB = 24 * MiB, WS_SEG = 25 * MiB, WS_ROUTE = 26 * MiB, WS_TOKMAP = 27 * MiB;
constexpr size_t WS_H2 = 960 * MiB;
constexpr size_t WS_H = 32 * MiB;
constexpr size_t WS_WGU = 64 * MiB, WS_WD = 192 * MiB;
constexpr size_t WS_PROJ = 256 * MiB, PROJ_STRIDE = 32 * MiB;
constexpr size_t WS_YLRU = 480 * MiB, WS_TMP = 512 * MiB, WS_MERGED = 544 * MiB, WS_X1 = 576 * MiB;
constexpr size_t WS_ACT = 640 * MiB, WS_Y = 784 * MiB, WS_YFOX = 928 * MiB, WS_END = 976 * MiB;
static_assert(WS_Y + (size_t)SLOTS * 1024 * 2 <= WS_YFOX && WS_ACT + (size_t)SLOTS * 1024 * 2 <= WS_Y, "d_ws map");
constexpr int CW_TMO = 0, CW_CODE = 1;
constexpr int CW_BAR = 4096;
constexpr int CW_CNT = 16384;
constexpr int CW_KN = 20480, CW_QN = 20544;                          static_assert((20544 + 64 * 16) * 4 <= 128 * 1024, "control words inside the memset region");
constexpr int CW_END_ = 0;

constexpr int RING_OFF = 0, RING_BYTES = 131072;
constexpr int LDSCTL_OFF = RING_BYTES, MISC_OFF = LDSCTL_OFF + 320, EXTRA_OFF = LDSCTL_OFF + 512;
constexpr int LDS_BYTES = 147456;
constexpr int EX_TILE_E = 0, EX_NCNT = 320, EX_TPRE = 448, EX_ROWS = 1024, EX_MAXU = 14;
static_assert(EXTRA_OFF + EX_ROWS + EX_MAXU * 1024 <= LDS_BYTES, "LDS map");

#define GAS __attribute__((address_space(1)))
#define LAS __attribute__((address_space(3)))
typedef unsigned short bf16;
typedef unsigned v4u __attribute__((ext_vector_type(4)));
typedef unsigned v2u __attribute__((ext_vector_type(2)));
typedef float f32x4 __attribute__((ext_vector_type(4)));
typedef float f32x2 __attribute__((ext_vector_type(2)));
typedef short bf16x8 __attribute__((ext_vector_type(8)));
typedef GAS unsigned gu32;
typedef GAS unsigned long long gu64;
#define RLX_AGENT __ATOMIC_RELAXED, __HIP_MEMORY_SCOPE_AGENT
#define LDS_WAIT() asm volatile("s_waitcnt lgkmcnt(0)" ::: "memory")
#define VM_WAIT() asm volatile("s_waitcnt vmcnt(0)" ::: "memory")
__device__ __forceinline__ unsigned pk2(float lo, float hi) { return pg8::cvt_pk_bf16(lo, hi); }
__device__ __forceinline__ float bflo(unsigned w) { return __uint_as_float(w << 16); }
__device__ __forceinline__ float bfhi(unsigned w) { return __uint_as_float(w & 0xffff0000u); }
__device__ __forceinline__ float sigm(float x) { return __builtin_amdgcn_rcpf(1.0f + __builtin_amdgcn_exp2f(-LOG2E * x)); }
__device__ __forceinline__ float gelu_tanh(float x) { const float u = 0.7978845608028654f * (x + 0.044715f * x * x * x); return x * sigm(2.0f * u); }

#define XB_TMO      128
#define XB_XCNT(j)  (256  + 64 * (j))
#define XB_XSUB(j)  (1280 + 64 * (j))
#define XB_XGEN(j)  (2304 + 64 * (j))
#define XB_TOP      3328
#define XB_TOPGEN   3392
#define XCD_BAR_WORDS 3456
#define XB_SPIN_CAP (1u << 18)

__device__ __forceinline__ unsigned xb_ld(unsigned* p)              { return __hip_atomic_load(p, __ATOMIC_RELAXED, __HIP_MEMORY_SCOPE_AGENT); }
__device__ __forceinline__ unsigned xb_add(unsigned* p, unsigned v) { return __hip_atomic_fetch_add(p, v, __ATOMIC_RELAXED, __HIP_MEMORY_SCOPE_AGENT); }
__device__ __forceinline__ unsigned xb_xcc_id() { return (unsigned)__builtin_amdgcn_s_getreg((3 << 11) | 20) & 0xFu; }
#define XB_SPIN(cond, bar) do { unsigned _sp = 0; while (cond) { __builtin_amdgcn_s_sleep(1); \
    if ((++_sp & 255u) == 0u) { if (xb_ld(&(bar)[XB_TMO])) break; if (_sp > XB_SPIN_CAP) { atomicAdd(&(bar)[XB_TMO], 1u); break; } } } } while (0)

struct XcdBarrier {
    unsigned* bar; unsigned x;
    volatile LAS unsigned* st;
};
__device__ __forceinline__ XcdBarrier xcd_barrier_post(unsigned* bar, volatile LAS unsigned* st) {
    XcdBarrier b; b.bar = bar; b.x = xb_xcc_id(); b.st = st;
    if (threadIdx.x == 0) (void)xb_add(&bar[XB_XCNT(b.x)], 1u);
    return b;
}
__device__ __forceinline__ void xcd_barrier_complete(unsigned* bar, unsigned x, unsigned& nloc, unsigned& nx) {
    const unsigned G = gridDim.x * gridDim.y * gridDim.z;
    unsigned sum, cnt, mine, sp = 0u;
    for (;;) {
        sum = 0u; cnt = 0u; mine = 0u;
#pragma unroll
        for (unsigned j = 0; j < 16; ++j) { const unsigned c = xb_ld(&bar[XB_XCNT(j)]); sum += c; cnt += (c > 0u) ? 1u : 0u; mine = (j == x) ? c : mine; }
        if (sum == G) break;
        __builtin_amdgcn_s_sleep(1);
        if ((++sp & 255u) == 0u) { if (xb_ld(&bar[XB_TMO])) break; if (sp > XB_SPIN_CAP) { atomicAdd(&bar[XB_TMO], 1u); break; } }
    }
    nloc = mine > 0u ? mine : 1u; nx = cnt > 0u ? cnt : 1u;
}
__device__ __forceinline__ void xcd_barrier(const XcdBarrier& b) {
    asm volatile("s_waitcnt vmcnt(0)" ::: "memory");
    __syncthreads();
    if (threadIdx.x == 0) {
        unsigned* bar = b.bar;
        __builtin_amdgcn_s_waitcnt(0);
        unsigned nloc = b.st[0], nx = b.st[1];
        if (nloc == 0u) { xcd_barrier_complete(bar, b.x, nloc, nx); b.st[0] = nloc; b.st[1] = nx; }
        const unsigned old = xb_add(&bar[XB_XSUB(b.x)], 1u);
        const unsigned gen = old / nloc;
        if (old + 1u == (gen + 1u) * nloc) {
            __builtin_amdgcn_fence(__ATOMIC_RELEASE, "agent");
            asm volatile("s_waitcnt vmcnt(0)" ::: "memory");
            const unsigned og = xb_add(&bar[XB_TOP], 1u);
            const unsigned tg = og / nx;
            if (og + 1u == (tg + 1u) * nx) xb_add(&bar[XB_TOPGEN], 1u);
            else XB_SPIN(xb_ld(&bar[XB_TOPGEN]) == tg, bar);
            __builtin_amdgcn_fence(__ATOMIC_ACQUIRE, "agent");
            xb_add(&bar[XB_XGEN(b.x)], 1u);
            asm volatile("s_waitcnt vmcnt(0)" ::: "memory");
        } else {
            XB_SPIN(xb_ld(&bar[XB_XGEN(b.x)]) == gen, bar);
            __builtin_amdgcn_fence(__ATOMIC_ACQUIRE, "agent");
            asm volatile("s_waitcnt vmcnt(0)" ::: "memory");
        }
    }
    __syncthreads();
}

struct Frame {
    LAS unsigned char* lds;
    volatile LAS unsigned* MISC;
    gu32* ctl;
    int wave;
    int vcu, G;
    const float* in[22];
    float* out;
    unsigned char* ws;
};
#define IN_X 0
#define IN_GMIX 1
#define IN_WIN 2
#define IN_CONVW 3
#define IN_CONVB 4
#define IN_WRG 5
#define IN_BRG 6
#define IN_WIG 7
#define IN_BIG 8
#define IN_LAMBDA 9
#define IN_BF 10
#define IN_WLRU 11
#define IN_WFOX 12
#define IN_WO 13
#define IN_GFFN 14
#define IN_WROUTER 15
#define IN_BROUTER 16
#define IN_WGU 17
#define IN_BGU 18
#define IN_WD 19
#define IN_BD 20
#define IN_GFINAL 21

__device__ __forceinline__ float wave_sum(float v) {
#pragma unroll
    for (int o = 1; o < 64; o <<= 1) v += __shfl_xor(v, o);
    return v;
}
__device__ __forceinline__ float wave_max(float v) {
#pragma unroll
    for (int o = 1; o < 64; o <<= 1) v = fmaxf(v, __shfl_xor(v, o));
    return v;
}
__device__ __forceinline__ float lane_sel(float a, float b, unsigned long long m) { float r; asm("v_cndmask_b32_e64 %0, %1, %2, %3" : "=v"(r) : "v"(a), "v"(b), "s"(m)); return r; }
template <int N> __device__ __forceinline__ void xreduce(float (&f)[N], int lane) {
    (void)lane;
    constexpr unsigned long long MASKS[6] = {0xFFFFFFFF00000000ull, 0xFFFF0000FFFF0000ull, 0xFF00FF00FF00FF00ull, 0xF0F0F0F0F0F0F0F0ull, 0xCCCCCCCCCCCCCCCCull, 0xAAAAAAAAAAAAAAAAull};
    int s = 32, k = 0;
#pragma unroll
    for (int half = N / 2; half >= 1; half >>= 1, s >>= 1, ++k) {
        const unsigned long long m = MASKS[k];
#pragma unroll
        for (int i = 0; i < half; ++i) { const float keep = lane_sel(f[i], f[i + half], m), send = lane_sel(f[i + half], f[i], m); f[i] = keep + __shfl_xor(send, s); }
    }
#pragma unroll
    for (int q = 0; q < 6; ++q) if ((32 >> q) <= s && (32 >> q) >= 1 && (32 >> q) < (64 / N) ) f[0] += __shfl_xor(f[0], 32 >> q);
}
#ifndef CV_LG
#define CV_LG 4
#endif
constexpr int CV_NL = 1 << CV_LG, CV_IK = 8 * (64 >> CV_LG), CV_IN = 4 << CV_LG, CV_KB = 1024 / CV_IK;
struct CvtItem { const float* src; unsigned char* dst; int ldw, K, k0, i8; };
__device__ __forceinline__ void cvt_load(const CvtItem& c, int lane, f32x4 (&v)[8]) {
#pragma unroll
    for (int i = 0; i < 8; ++i) v[i] = __builtin_nontemporal_load((const GAS f32x4*)(c.src + (size_t)(c.k0 + 8 * (lane >> CV_LG) + i) * c.ldw + 4 * (lane & (CV_NL - 1))));
}
__device__ __forceinline__ unsigned q8_low(float x, float scale) {
    const float lim = 127.0f / scale; const float c = __builtin_amdgcn_fmed3f(x, -lim, lim); return __float_as_uint(__builtin_fmaf(c, scale, 12582912.0f)); }
__device__ __forceinline__ unsigned lo4(unsigned a, unsigned b, unsigned c, unsigned d) {
    const unsigned ab = __builtin_amdgcn_perm(b, a, 0x0c0c0400u), cd = __builtin_amdgcn_perm(d, c, 0x0c0c0400u); return ab | (cd << 16); }
__device__ __forceinline__ void cvt_store(const CvtItem& c, int lane, const f32x4 (&v)[8]) {
    const int kg = lane >> CV_LG, ng = lane & (CV_NL - 1);
    if (c.i8) {
#pragma unroll
        for (int j = 0; j < 4; ++j) { unsigned q[8];
#pragma unroll
            for (int i = 0; i < 8; ++i) q[i] = q8_low(v[i][j], W8_SCALE);
            v2u o; o.x = lo4(q[0], q[1], q[2], q[3]); o.y = lo4(q[4], q[5], q[6], q[7]);
            *(GAS v2u*)(c.dst + (size_t)(4 * ng + j) * c.K + c.k0 + 8 * kg) = o; }
    } else {
#pragma unroll
        for (int j = 0; j < 4; ++j) { v4u o; o.x = pk2(v[0][j], v[1][j]); o.y = pk2(v[2][j], v[3][j]); o.z = pk2(v[4][j], v[5][j]); o.w = pk2(v[6][j], v[7][j]);
            *(GAS v4u*)(c.dst + ((size_t)(4 * ng + j) * c.K + c.k0 + 8 * kg) * 2) = o; }
    }
}
#define LANE_TID() const int lane_ = hw_lane(); const int tid_ = F.wave * 64 + lane_
__device__ __forceinline__ void p0_prologue(Frame& F) {
    LANE_TID();
    unsigned char* ws = F.ws;
    const int gw = F.vcu * NWAVES + F.wave, NGW = F.G * NWAVES;
    {
        constexpr int I_IN = (NPROJ / CV_IN) * CV_KB;
        CvtItem c0, c1; f32x4 v0[8], v1[8];
#define P0_DEC(c, it) do { const int cb = (it) / CV_KB, kb = (it) % CV_KB, drow = CV_IN * cb, scol = drow < FCOL0 ? drow : drow + 16; \
            c.src = F.in[IN_WIN] + scol; c.ldw = IN_COLS; c.K = D; c.k0 = CV_IK * kb; c.i8 = 1; c.dst = ws + WS_WIN + (size_t)drow * D; } while (0)
        int it = gw;
        if (it < I_IN) { P0_DEC(c0, it); cvt_load(c0, lane_, v0); }
        if (it + NGW < I_IN) { P0_DEC(c1, it + NGW); cvt_load(c1, lane_, v1); }
#pragma unroll 1
        for (; it < I_IN; it += 2 * NGW) {
            cvt_store(c0, lane_, v0); if (it + 2 * NGW < I_IN) { P0_DEC(c0, it + 2 * NGW); cvt_load(c0, lane_, v0); }
            if (it + NGW < I_IN) { cvt_store(c1, lane_, v1); if (it + 3 * NGW < I_IN) { P0_DEC(c1, it + 3 * NGW); cvt_load(c1, lane_, v1); } }
        }
#undef P0_DEC
    }
    {
        const int gt = F.vcu * (NWAVES * 64) + tid_, NGT = F.G * NWAVES * 64;
        bf16* WG = (bf16*)(ws + WS_WG); const float* const w_ig_p = F.in[IN_WIG]; const float* const w_rg_p = F.in[IN_WRG];
        for (int idx = gt; idx < 2 * 16 * 64 * 64; idx += NGT) { const int i = idx & 63, j = (idx >> 6) & 63, gate = (idx >> 12) & 1, blk = idx >> 13;
            const float w = (gate ? w_ig_p : w_rg_p)[(blk * 64 + i) * 64 + j];
            WG[idx] = (bf16)(pk2(w, 0.f) & 0xffffu); }
        float* SP = (float*)(ws + WS_SP);
        for (int c = gt; c < D; c += NGT) { const float z = -F.in[IN_LAMBDA][c]; const float sp = fmaxf(z, 0.f) + log1pf(expf(-fabsf(z))); SP[c] = 8.0f * sp * LOG2E; }
    }
    __syncthreads();
    {
        LAS float* WF = (LAS float*)(F.lds + RING_OFF);
        for (int idx = tid_; idx < 16 * D; idx += NWAVES * 64) { const int c = idx >> 4, hd = idx & 15; WF[hd * D + c] = F.in[IN_WIN][(size_t)c * IN_COLS + FCOL0 + hd] * F.in[IN_GMIX][c]; }
        __syncthreads();
        f32x4 gm[4];
#pragma unroll
        for (int j = 0; j < 4; ++j) gm[j] = *((const GAS f32x4*)F.in[IN_GMIX] + lane_ + 64 * j);
        const int hd = (lane_ >> 2) & 15; const float bfv = F.in[IN_BF][hd];
        bf16* H = (bf16*)(ws + WS_H); float* LOGF = (float*)(ws + WS_LOGF);
#pragma unroll 1
        for (int m = gw; m < M; m += NGW) {
            const GAS f32x4* xr = (const GAS f32x4*)(F.in[IN_X] + (size_t)m * D) + lane_;
            f32x4 v[4]; float s = 0.f;
#pragma unroll
            for (int j = 0; j < 4; ++j) { v[j] = xr[64 * j]; s += (v[j].x * v[j].x + v[j].y * v[j].y) + (v[j].z * v[j].z + v[j].w * v[j].w); }
            const float rstd = 1.0f / sqrtf(wave_sum(s) * (1.f / D) + RMS_EPS);
            GAS unsigned* o8 = (GAS unsigned*)((unsigned char*)H + (size_t)m * D) + lane_;
#pragma unroll
            for (int j = 0; j < 4; ++j) { const f32x4 y = v[j] * (rstd * H8_SCALE) * gm[j]; o8[64 * j] = pg8::pk4_i8(y.x, y.y, y.z, y.w); }
            float f[16];
#pragma unroll
            for (int h = 0; h < 16; ++h) { float a = 0.f; f32x2 a2 = (f32x2){0.f, 0.f};
#pragma unroll
                for (int j = 0; j < 4; ++j) { const f32x4 w = *((const LAS f32x4*)(WF + h * D) + lane_ + 64 * j);
                    a2 = __builtin_elementwise_fma((f32x2){v[j].x, v[j].y}, (f32x2){w.x, w.y}, a2); a2 = __builtin_elementwise_fma((f32x2){v[j].z, v[j].w}, (f32x2){w.z, w.w}, a2); }
                a = a2.x + a2.y; f[h] = a; if ((h & 3) == 3) __builtin_amdgcn_sched_barrier(0); }
            xreduce<16>(f, lane_);
            if ((lane_ & 3) == 0) { const float z = f[0] * rstd + bfv;
                const float lf = fminf(z, 0.f) - log1pf(expf(-fabsf(z)));
                const int b = m / SEQ, t = m % SEQ; LOGF[((size_t)(b * 16 + hd)) * SEQ + t] = lf; }
        }
    }
}

__device__ __forceinline__ void lru_decode(int u, int& b, int& blk, int& seg) { seg = u >> 6; b = (u >> 4) & 3; blk = u & 15; }
struct LruConst { f32x4 brg[4], big[4], spv[4]; float cw[4][8], cb[8]; };
constexpr int LRU_XR = 0, LRU_XC = 16896, LRU_AA = 35328, LRU_BB = 70144, LRU_SM = 104960, LRU_WG = 109056;
__device__ __forceinline__ void lru_load_const(Frame& F, int blk, int tid, int lane, LruConst& C) {
    const int fr = lane & 15, fq = lane >> 4, c0 = blk * 64, ch = tid & 7;
    const bf16* WG = (const bf16*)(F.ws + WS_WG) + (size_t)blk * 2 * 64 * 64; const float* SP = (const float*)(F.ws + WS_SP);
#pragma unroll
    for (int k = 0; k < 2; ++k) { const int it = tid + 512 * k, l = it & 63, fg = it >> 6, kt = fg & 1, nt = (fg >> 1) & 3, gt = fg >> 3;
        *(LAS bf16x8*)(F.lds + RING_OFF + LRU_WG + it * 16) = *(const GAS bf16x8*)(WG + ((gt * 64 + 16 * nt + (l & 15)) * 64 + 32 * kt + 8 * (l >> 4))); }
    (void)fr; (void)fq;
#pragma unroll
    for (int nt = 0; nt < 4; ++nt) { const int j0 = 16 * nt + 4 * fq;
        C.brg[nt] = *(const GAS f32x4*)(F.in[IN_BRG] + c0 + j0); C.big[nt] = *(const GAS f32x4*)(F.in[IN_BIG] + c0 + j0); C.spv[nt] = *(const GAS f32x4*)(SP + c0 + j0); }
#pragma unroll
    for (int k = 0; k < 4; ++k) { const f32x4 a = *(const GAS f32x4*)(F.in[IN_CONVW] + k * D + c0 + ch * 8), bq = *(const GAS f32x4*)(F.in[IN_CONVW] + k * D + c0 + ch * 8 + 4);
        C.cw[k][0] = a.x; C.cw[k][1] = a.y; C.cw[k][2] = a.z; C.cw[k][3] = a.w; C.cw[k][4] = bq.x; C.cw[k][5] = bq.y; C.cw[k][6] = bq.z; C.cw[k][7] = bq.w; }
    { const f32x4 a = *(const GAS f32x4*)(F.in[IN_CONVB] + c0 + ch * 8), bq = *(const GAS f32x4*)(F.in[IN_CONVB] + c0 + ch * 8 + 4);
        C.cb[0] = a.x; C.cb[1] = a.y; C.cb[2] = a.z; C.cb[3] = a.w; C.cb[4] = bq.x; C.cb[5] = bq.y; C.cb[6] = bq.z; C.cb[7] = bq.w; }
}
__device__ __forceinline__ void lru_raw_load(Frame& F, int b, int blk, int seg, int tid, v4u (&raw)[3]) {
    const bf16* LX = (const bf16*)(F.ws + WS_PROJ); const long row0 = (long)b * SEQ + seg * LRU_TS; const int c0 = blk * 64;
#pragma unroll
    for (int k = 0; k < 3; ++k) { const int idx = tid + 512 * k, r = idx >> 3, ch = idx & 7; raw[k] = (v4u){0u, 0u, 0u, 0u};
        if (idx < 131 * 8 && (seg > 0 || r >= 3)) raw[k] = *(const GAS v4u*)(LX + (row0 + r - 3) * D + c0 + ch * 8); }
}
__device__ __forceinline__ void lru_raw_store(Frame& F, int tid, const v4u (&raw)[3]) {
    LAS unsigned char* L = F.lds + RING_OFF;
#pragma unroll
    for (int k = 0; k < 3; ++k) { const int idx = tid + 512 * k, r = idx >> 3, ch = idx & 7; if (idx < 131 * 8) *(LAS v4u*)(L + LRU_XR + r * 128 + ch * 16) = raw[k]; }
}
template <int PASS>
__device__ __forceinline__ void lru_run(Frame& F) {
    LAS unsigned char* L = F.lds + RING_OFF;
    const int lane = hw_lane(), w = F.wave, tid = w * 64 + lane, fr = lane & 15, fq = lane >> 4;
    const bf16* LG = (const bf16*)(F.ws + WS_PROJ + PROJ_STRIDE);
    LAS float* HIN = (LAS float*)(F.lds + EXTRA_OFF);
    int nun = 0; for (int u = F.vcu; u < LRU_UNITS; u += F.G) ++nun;
    if (nun == 0) return;
    if (nun > 56) nun = 56;
    if (PASS == 1) {
        const f32x2* SEGp = (const f32x2*)(F.ws + WS_SEG);
        for (int i = tid >> 6; i < nun; i += NWAVES) { const int u = i * F.G + F.vcu, c = tid & 63; int b, blk, seg; lru_decode(u, b, blk, seg); float Hc = 0.f;
            const GAS f32x2* sp = (const GAS f32x2*)SEGp + (size_t)(b * LRU_NSEG) * D + blk * 64 + c;
            for (int s0 = 0; s0 < seg; s0 += 8) { f32x2 v[8];
#pragma unroll
                for (int k = 0; k < 8; ++k) { const int s = s0 + k; v[k] = sp[(size_t)(s < seg ? s : 0) * D]; if (s >= seg) v[k] = (f32x2){1.f, 0.f}; }
#pragma unroll
                for (int k = 0; k < 8; ++k) Hc = v[k].x * Hc + v[k].y; }
            HIN[i * 64 + c] = Hc; }
    }
    LruConst C; int cur_blk = -1;
    { int b, blk, seg; lru_decode(F.vcu, b, blk, seg); v4u raw[3]; lru_raw_load(F, b, blk, seg, tid, raw); lru_raw_store(F, tid, raw); }
#pragma unroll 1
    for (int i = 0; i < nun; ++i) {
        const int u = i * F.G + F.vcu; int b, blk, seg; lru_decode(u, b, blk, seg);
        const long row0 = (long)b * SEQ + seg * LRU_TS; const int c0 = blk * 64;
        if (blk != cur_blk) { lru_load_const(F, blk, tid, lane, C); cur_blk = blk; }
        v4u nraw[3];
        if (i + 1 < nun) { int b2, blk2, seg2; lru_decode(u + F.G, b2, blk2, seg2); lru_raw_load(F, b2, blk2, seg2, tid, nraw); }
        v4u gate8[2];
        if (PASS == 1) {
#pragma unroll
            for (int k = 0; k < 2; ++k) { const int t = (tid >> 3) + 64 * k, ch = tid & 7; gate8[k] = *(const GAS v4u*)(LG + (row0 + t) * D + c0 + ch * 8); }
        }
        __syncthreads();
        { const int ch = tid & 7;
#pragma unroll
            for (int k2 = 0; k2 < 2; ++k2) { const int t = (tid >> 3) + 64 * k2; float a[8];
#pragma unroll
                for (int e = 0; e < 8; ++e) a[e] = C.cb[e];
#pragma unroll
                for (int k = 0; k < 4; ++k) { const v4u xv = *(const LAS v4u*)(L + LRU_XR + (t + k) * 128 + ch * 16);
                    a[0] += C.cw[k][0] * bflo(xv.x); a[1] += C.cw[k][1] * bfhi(xv.x); a[2] += C.cw[k][2] * bflo(xv.y); a[3] += C.cw[k][3] * bfhi(xv.y);
                    a[4] += C.cw[k][4] * bflo(xv.z); a[5] += C.cw[k][5] * bfhi(xv.z); a[6] += C.cw[k][6] * bflo(xv.w); a[7] += C.cw[k][7] * bfhi(xv.w); }
                v4u o; o.x = pk2(a[0], a[1]); o.y = pk2(a[2], a[3]); o.z = pk2(a[4], a[5]); o.w = pk2(a[6], a[7]);
                *(LAS v4u*)(L + LRU_XC + t * 144 + ch * 16) = o; }
        }
        __syncthreads();
        { bf16x8 af[2];
#pragma unroll
            for (int kt = 0; kt < 2; ++kt) af[kt] = *(const LAS bf16x8*)(L + LRU_XC + (16 * w + fr) * 144 + (32 * kt + 8 * fq) * 2);
#pragma unroll
            for (int nt = 0; nt < 4; ++nt) { f32x4 gr = (f32x4){0.f, 0.f, 0.f, 0.f}, gi = (f32x4){0.f, 0.f, 0.f, 0.f};
#pragma unroll
                for (int kt = 0; kt < 2; ++kt) { const bf16x8 wr_ = *(const LAS bf16x8*)(L + LRU_WG + ((nt * 2 + kt) * 64 + lane) * 16), wi_ = *(const LAS bf16x8*)(L + LRU_WG + (((4 + nt) * 2 + kt) * 64 + lane) * 16);
                    gr = __builtin_amdgcn_mfma_f32_16x16x32_bf16(wr_, af[kt], gr, 0, 0, 0); gi = __builtin_amdgcn_mfma_f32_16x16x32_bf16(wi_, af[kt], gi, 0, 0, 0); }
                const int j0 = 16 * nt + 4 * fq;
                const v2u xw = *(const LAS v2u*)(L + LRU_XC + (16 * w + fr) * 144 + j0 * 2);
                const float xs[4] = {bflo(xw.x), bfhi(xw.x), bflo(xw.y), bfhi(xw.y)};
                f32x4 av, bv;
#pragma unroll
                for (int e = 0; e < 4; ++e) { const float rt = sigm(gr[e] + C.brg[nt][e]), it = sigm(gi[e] + C.big[nt][e]);
                    const float a = __builtin_amdgcn_exp2f(-rt * C.spv[nt][e]); const float mult = __builtin_amdgcn_sqrtf(fmaxf(1.0f - a * a, 0.f));
                    av[e] = a; bv[e] = mult * it * xs[e]; }
                *(LAS f32x4*)(L + LRU_AA + ((16 * w + fr) * 68 + j0) * 4) = av; *(LAS f32x4*)(L + LRU_BB + ((16 * w + fr) * 68 + j0) * 4) = bv; }
        }
        __syncthreads();
        const LAS float* Af = (const LAS float*)(L + LRU_AA); LAS float* Bf = (LAS float*)(L + LRU_BB);
        { float Aw = 1.f, Bw = 0.f;
#pragma unroll
            for (int s = 0; s < 16; ++s) { const int t = 16 * w + s; const float a = Af[t * 68 + lane], bb = Bf[t * 68 + lane]; Bw = a * Bw + bb; Aw *= a; }
            *(LAS f32x2*)(L + LRU_SM + (w * 64 + lane) * 8) = (f32x2){Aw, Bw}; }
        __syncthreads();
        if (PASS == 0) {
            if (w == 0) { float A = 1.f, Bq = 0.f;
#pragma unroll
                for (int ww = 0; ww < 8; ++ww) { const f32x2 v = *(const LAS f32x2*)(L + LRU_SM + (ww * 64 + lane) * 8); Bq = v.x * Bq + v.y; A *= v.x; }
                *(GAS f32x2*)((float*)(F.ws + WS_SEG) + ((size_t)(b * LRU_NSEG + seg) * D + c0 + lane) * 2) = (f32x2){A, Bq}; }
        } else {
            float Hc = HIN[i * 64 + lane];
#pragma unroll
            for (int ww = 0; ww < 7; ++ww) if (ww < w) { const f32x2 v = *(const LAS f32x2*)(L + LRU_SM + (ww * 64 + lane) * 8); Hc = v.x * Hc + v.y; }
#pragma unroll
            for (int s = 0; s < 16; ++s) { const int t = 16 * w + s; const float a = Af[t * 68 + lane], bb = Bf[t * 68 + lane]; Hc = a * Hc + bb; Bf[t * 68 + lane] = Hc; }
            __syncthreads();
            bf16* YL = (bf16*)(F.ws + WS_YLRU);
#pragma unroll
            for (int k = 0; k < 2; ++k) { const int t = (tid >> 3) + 64 * k, ch = tid & 7;
                const f32x4 h0 = *(const LAS f32x4*)(L + LRU_BB + (t * 68 + ch * 8) * 4), h1 = *(const LAS f32x4*)(L + LRU_BB + (t * 68 + ch * 8 + 4) * 4); const v4u g = gate8[k];
                v4u o; o.x = pk2(h0.x * gelu_tanh(bflo(g.x)), h0.y * gelu_tanh(bfhi(g.x))); o.y = pk2(h0.z * gelu_tanh(bflo(g.y)), h0.w * gelu_tanh(bfhi(g.y)));
                o.z = pk2(h1.x * gelu_tanh(bflo(g.z)), h1.y * gelu_tanh(bfhi(g.z))); o.w = pk2(h1.z * gelu_tanh(bflo(g.w)), h1.w * gelu_tanh(bfhi(g.w)));
                *(GAS v4u*)(YL + (row0 + t) * D + c0 + ch * 8) = o; }
        }
        if (i + 1 < nun) lru_raw_store(F, tid, nraw);
    }
    __syncthreads();
}

__device__ __forceinline__ void p2_phase(Frame& F) {
    LANE_TID();
    const int gw = F.vcu * NWAVES + F.wave, NGW = F.G * NWAVES;
    for (int bh = gw; bh < BATCH * 16; bh += NGW) {
        const float* src = (const float*)(F.ws + WS_LOGF) + (size_t)bh * SEQ + 64 * lane_; float* dst = (float*)(F.ws + WS_KB) + (size_t)bh * SEQ + 64 * lane_;
        f32x4 v[16]; float tot = 0.f;
#pragma unroll
        for (int i = 0; i < 16; ++i) { v[i] = *((const GAS f32x4*)src + i); tot += (v[i].x + v[i].y) + (v[i].z + v[i].w); }
        float incl = tot;
#pragma unroll
        for (int o = 1; o < 64; o <<= 1) { const float t = __shfl_up(incl, o); if (lane_ >= o) incl += t; }
        float run = incl - tot;
#pragma unroll
        for (int i = 0; i < 16; ++i) { f32x4 o; run += v[i].x; o.x = -LOG2E * run; run += v[i].y; o.y = -LOG2E * run; run += v[i].z; o.z = -LOG2E * run; run += v[i].w; o.w = -LOG2E * run;
            *((GAS f32x4*)dst + i) = o; }
    }
    {
        LAS unsigned* nrm = (LAS unsigned*)(F.lds + EXTRA_OFF);
        const bf16* Qp = (const bf16*)(F.ws + WS_PROJ + 2 * PROJ_STRIDE); const bf16* Kp = (const bf16*)(F.ws + WS_PROJ + 3 * PROJ_STRIDE);
        for (int chunk = F.vcu; chunk < M / 64; chunk += F.G) {
            if (tid_ < 32) nrm[tid_] = 0u;
            __syncthreads();
            float qm[2] = {0.f, 0.f}, km[2] = {0.f, 0.f};
#pragma unroll
            for (int r0 = 0; r0 < 8; r0 += 4) { v4u qv[4][2], kv[4][2];
#pragma unroll
                for (int r = 0; r < 4; ++r)
#pragma unroll
                    for (int hf = 0; hf < 2; ++hf) { const size_t off = (size_t)(chunk * 64 + F.wave * 8 + r0 + r) * D + hf * 512 + lane_ * 8; qv[r][hf] = *(const GAS v4u*)(Qp + off); kv[r][hf] = *(const GAS v4u*)(Kp + off); }
#pragma unroll
                for (int r = 0; r < 4; ++r)
#pragma unroll
                    for (int hf = 0; hf < 2; ++hf) { float sq = 0.f, sk = 0.f;
#pragma unroll
                        for (int e = 0; e < 4; ++e) { const float a = bflo(qv[r][hf][e]), b2 = bfhi(qv[r][hf][e]), c = bflo(kv[r][hf][e]), d = bfhi(kv[r][hf][e]); sq += a * a + b2 * b2; sk += c * c + d * d; }
                        sq += __shfl_xor(sq, 1); sq += __shfl_xor(sq, 2); sq += __shfl_xor(sq, 4); sk += __shfl_xor(sk, 1); sk += __shfl_xor(sk, 2); sk += __shfl_xor(sk, 4);
                        qm[hf] = fmaxf(qm[hf], sq); km[hf] = fmaxf(km[hf], sk); } }
            if ((lane_ & 7) == 0) {
#pragma unroll
                for (int hf = 0; hf < 2; ++hf) { const int h = hf * 8 + (lane_ >> 3);
                    __hip_atomic_fetch_max(nrm + h, __float_as_uint(qm[hf]), __ATOMIC_RELAXED, __HIP_MEMORY_SCOPE_WORKGROUP); __hip_atomic_fetch_max(nrm + 16 + h, __float_as_uint(km[hf]), __ATOMIC_RELAXED, __HIP_MEMORY_SCOPE_WORKGROUP); } }
            __syncthreads();
            if (tid_ < 32) { const int b = chunk / (SEQ / 64), qb = (chunk % (SEQ / 64)) / 4, h = tid_ & 15; const unsigned v = nrm[tid_];
                if (tid_ < 16) __hip_atomic_fetch_max(F.ctl + CW_QN + (b * 16 + h) * 16 + qb, v, RLX_AGENT); else __hip_atomic_fetch_max(F.ctl + CW_KN + b * 16 + h, v, RLX_AGENT); }
            __syncthreads();
        }
    }
    lru_run<0>(F);
}
__device__ __forceinline__ void p3_lru(Frame& F) { lru_run<1>(F); }

constexpr int P6_WRB = 0, P6_AT = 65536, P6_LOG = 65536 + 32768;
__device__ __forceinline__ void p6_route(Frame& F) {
    LANE_TID();
    LAS unsigned char* L = F.lds + RING_OFF;
    LAS unsigned* lcnt = (LAS unsigned*)(F.lds + EXTRA_OFF);
    LAS unsigned* gbase = lcnt + 32;
    LAS unsigned* stash = lcnt + 64;
    LAS float* rstd_t = (LAS float*)(lcnt + 64 + 768);
    LAS f32x2* sel = (LAS f32x2*)(lcnt + 64 + 768 + 64);
    {
        f32x4 wv[16]; float gv[16];
#pragma unroll
        for (int q = 0; q < 16; ++q) { const int i4 = tid_ + 512 * q; wv[q] = *((const GAS f32x4*)F.in[IN_WROUTER] + i4); gv[q] = F.in[IN_GFFN][i4 >> 3]; }
#pragma unroll
        for (int q = 0; q < 16; ++q) { const int i4 = tid_ + 512 * q, k = i4 >> 3, e0 = (i4 & 7) * 4, s = k >> 4, kh = (k >> 3) & 1, i = k & 7;
            LAS unsigned short* d = (LAS unsigned short*)(L + P6_WRB + (s * 64 + kh * 32 + e0) * 16 + i * 2);
            d[0] = (unsigned short)(pk2(wv[q].x * gv[q], 0.f) & 0xffffu); d[8] = (unsigned short)(pk2(wv[q].y * gv[q], 0.f) & 0xffffu);
            d[16] = (unsigned short)(pk2(wv[q].z * gv[q], 0.f) & 0xffffu); d[24] = (unsigned short)(pk2(wv[q].w * gv[q], 0.f) & 0xffffu); }
    }
    f32x4 gm[4];
#pragma unroll
    for (int j = 0; j < 4; ++j) gm[j] = *((const GAS f32x4*)F.in[IN_GFFN] + lane_ + 64 * j);
    const float* X1 = (const float*)(F.ws + WS_X1); unsigned char* H2 = (unsigned char*)(F.ws + WS_H2);
    unsigned* TOKMAP = (unsigned*)(F.ws + WS_TOKMAP); v4u* ROUTE = (v4u*)(F.ws + WS_ROUTE);
    typedef float f32x16 __attribute__((ext_vector_type(16)));
    for (int chunk = F.vcu; chunk < M / 64; chunk += F.G) {
        if (tid_ < 32) lcnt[tid_] = 0u;
        f32x4 v[4][4];
#pragma unroll
        for (int i = 0; i < 4; ++i)
#pragma unroll
            for (int j = 0; j < 4; ++j) v[i][j] = *((const GAS f32x4*)(X1 + (size_t)(chunk * 64 + 4 * F.wave + i) * D) + lane_ + 64 * j);
#pragma unroll 1
        for (int half = 0; half < 2; ++half) {
            {
#pragma unroll
              for (int i = 0; i < 4; ++i) { const int r = 4 * F.wave + i, m = chunk * 64 + half * 32 + r; float s = 0.f;
#pragma unroll
                  for (int j = 0; j < 4; ++j) s += (v[i][j].x * v[i][j].x + v[i][j].y * v[i][j].y) + (v[i][j].z * v[i][j].z + v[i][j].w * v[i][j].w);
                  const float rstd = 1.0f / sqrtf(wave_sum(s) * (1.f / D) + RMS_EPS);
                  if (lane_ == 0) rstd_t[half * 32 + r] = rstd;
                  GAS unsigned* o8 = (GAS unsigned*)(H2 + (size_t)m * D) + lane_;
#pragma unroll
                  for (int j = 0; j < 4; ++j) { const f32x4 y = v[i][j] * (rstd * H8_SCALE) * gm[j]; o8[64 * j] = pg8::pk4_i8(y.x, y.y, y.z, y.w);
                      const int c = (lane_ >> 1) + 32 * j, pc = (c & ~15) | ((c ^ r) & 15); v2u w; w.x = pk2(v[i][j].x, v[i][j].y); w.y = pk2(v[i][j].z, v[i][j].w);
                      *(LAS v2u*)(L + P6_AT + r * 2048 + pc * 16 + (lane_ & 1) * 8) = w; } }
              if (half == 0) {
#pragma unroll
                  for (int i = 0; i < 4; ++i)
#pragma unroll
                      for (int j = 0; j < 4; ++j) v[i][j] = *((const GAS f32x4*)(X1 + (size_t)(chunk * 64 + 32 + 4 * F.wave + i) * D) + lane_ + 64 * j); } }
            __syncthreads();
            f32x16 acc = {};
            { const int r = lane_ & 31, kh = lane_ >> 5;
#pragma unroll
              for (int q = 0; q < 8; ++q) { const int s = 8 * F.wave + q, c = 2 * s + kh, pc = (c & ~15) | ((c ^ r) & 15);
                  const bf16x8 a = *(const LAS bf16x8*)(L + P6_AT + r * 2048 + pc * 16), b = *(const LAS bf16x8*)(L + P6_WRB + (s * 64 + lane_) * 16);
                  acc = __builtin_amdgcn_mfma_f32_32x32x16_bf16(a, b, acc, 0, 0, 0); } }
            __syncthreads();
            { LAS float* P = (LAS float*)(L + P6_AT) + F.wave * 1024;
#pragma unroll
              for (int rg = 0; rg < 16; ++rg) P[((rg & 3) + 8 * (rg >> 2) + 4 * (lane_ >> 5)) * 32 + (lane_ & 31)] = acc[rg]; }
            __syncthreads();
            { const LAS float* P = (const LAS float*)(L + P6_AT); LAS float* LG = (LAS float*)(L + P6_LOG);
#pragma unroll
              for (int k = 0; k < 2; ++k) { const int idx = tid_ + 512 * k; float s = 0.f;
#pragma unroll
                  for (int w = 0; w < 8; ++w) s += P[w * 1024 + idx];
                  LG[idx] = s * rstd_t[half * 32 + (idx >> 5)] + F.in[IN_BROUTER][idx & 31]; } }
            __syncthreads();
            { const LAS float* LG = (const LAS float*)(L + P6_LOG);
#pragma unroll
              for (int k = 0; k < 2; ++k) { const int idx = tid_ + 512 * k, i = idx >> 5, j = idx & 31; const float v = LG[idx]; int rank = 0;
#pragma unroll
                  for (int q = 0; q < 8; ++q) { const f32x4 o = *(const LAS f32x4*)(LG + i * 32 + 4 * q);
                      rank += (o.x > v || (o.x == v && 4 * q + 0 < j)) ? 1 : 0; rank += (o.y > v || (o.y == v && 4 * q + 1 < j)) ? 1 : 0;
                      rank += (o.z > v || (o.z == v && 4 * q + 2 < j)) ? 1 : 0; rank += (o.w > v || (o.w == v && 4 * q + 3 < j)) ? 1 : 0; }
                  if (rank < 4) sel[(half * 32 + i) * 4 + rank] = (f32x2){__uint_as_float((unsigned)j), v}; } }
            __syncthreads();
            if (tid_ < 128) { const int rl = half * 32 + (tid_ >> 2), k = tid_ & 3; const f32x2 s0 = sel[rl * 4 + 0], s1 = sel[rl * 4 + 1], s2 = sel[rl * 4 + 2], s3 = sel[rl * 4 + 3];
                const float p1 = __expf(s1.y - s0.y), p2 = __expf(s2.y - s0.y), p3 = __expf(s3.y - s0.y), inv = 1.0f / (1.0f + p1 + p2 + p3);
                const unsigned e = __float_as_uint(k == 0 ? s0.x : k == 1 ? s1.x : k == 2 ? s2.x : s3.x) & 31u; const float wv = (k == 0 ? 1.0f : k == 1 ? p1 : k == 2 ? p2 : p3) * inv;
                const unsigned lp = __hip_atomic_fetch_add(lcnt + e, 1u, __ATOMIC_RELAXED, __HIP_MEMORY_SCOPE_WORKGROUP);
                LAS unsigned* st = stash + (rl * 4 + k) * 3; st[0] = e; st[1] = lp; st[2] = __float_as_uint(wv); }
            __syncthreads();
        }
        const int t2 = F.wave * 64 + hw_lane();
        if (t2 < 32) { const unsigned n = lcnt[t2]; gbase[t2] = n ? __hip_atomic_fetch_add(F.ctl + CW_CNT + 64 * t2, n, RLX_AGENT) : 0u; }
        __syncthreads();
        if (t2 < 256) { const LAS unsigned* st = stash + t2 * 3; const unsigned e = st[0], pos = gbase[e] + st[1]; const int m = chunk * 64 + (t2 >> 2);
            TOKMAP[(size_t)e * M + pos] = (unsigned)m; ROUTE[(size_t)m * 4 + (t2 & 3)] = (v4u){e, pos, st[2], 0u}; }
        __syncthreads();
    }
}
__device__ __forceinline__ int moe_tables(Frame& F) {
    LANE_TID();
    LAS unsigned char* EX = F.lds + EXTRA_OFF;
    LAS unsigned char* tile_e = EX + EX_TILE_E; LAS unsigned* ncnt = (LAS unsigned*)(EX + EX_NCNT); LAS unsigned* tpre = (LAS unsigned*)(EX + EX_TPRE);
    if (tid_ < 32) { unsigned n = __hip_atomic_load(F.ctl + CW_CNT + 64 * tid_, RLX_AGENT); if (n > (unsigned)M) n = (unsigned)M; ncnt[tid_] = n; }
    __syncthreads();
    if (tid_ == 0) { unsigned a = 0; for (int e = 0; e < 32; ++e) { tpre[e] = a; a += (ncnt[e] + 255u) >> 8; if (a > (unsigned)MAXTILES) a = (unsigned)MAXTILES; } tpre[32] = a; }
    __syncthreads();
    const int TT = (int)tpre[32];
    for (int t = tid_; t < TT; t += NWAVES * 64) { int e = 0;
#pragma unroll 1
        for (int k = 1; k < 32; ++k) if ((int)tpre[k] <= t) e = k;
        tile_e[t] = (unsigned char)e; }
    __syncthreads();
    return TT;
}

__device__ __forceinline__ void p9_final(Frame& F) {
    LANE_TID();
    const int gw = F.vcu * NWAVES + F.wave, NGW = F.G * NWAVES;
    unsigned tl = 0; if (lane_ < 32) { unsigned n = __hip_atomic_load(F.ctl + CW_CNT + 64 * lane_, RLX_AGENT); if (n > (unsigned)M) n = (unsigned)M; tl = (n + 255u) >> 8; }
    unsigned incl = tl;
#pragma unroll
    for (int o = 1; o < 32; o <<= 1) { const unsigned t = __shfl_up(incl, o); if (lane_ >= o) incl += t; }
    const unsigned excl = incl - tl;
    f32x4 gm[4];
#pragma unroll
    for (int j = 0; j < 4; ++j) gm[j] = *((const GAS f32x4*)F.in[IN_GFINAL] + lane_ + 64 * j);
    const float* X1 = (const float*)(F.ws + WS_X1); const signed char* Y = (const signed char*)(F.ws + WS_Y); const v4u* ROUTE = (const v4u*)(F.ws + WS_ROUTE);
#pragma unroll 1
    for (int m = gw; m < M; m += NGW) {
        const GAS f32x4* xr = (const GAS f32x4*)(X1 + (size_t)m * D) + lane_;
        f32x4 v[4];
#pragma unroll
        for (int j = 0; j < 4; ++j) v[j] = xr[64 * j];
#pragma unroll
        for (int k = 0; k < 4; ++k) { const v4u rt = *((const GAS v4u*)ROUTE + (size_t)m * 4 + k); const unsigned e = rt.x & 31u; const float wv = __uint_as_float(rt.z) * (1.0f / Y8_SCALE);
            unsigned slot = (unsigned)__shfl((int)excl, (int)e) * 256u + rt.y; if (slot >= (unsigned)SLOTS) slot = 0u;
            const GAS unsigned* yr = (const GAS unsigned*)(Y + (size_t)slot * D) + lane_;
#pragma unroll
            for (int j = 0; j < 4; ++j) { const unsigned yw = yr[64 * j];
                v[j].x += wv * (float)((int)(yw << 24) >> 24); v[j].y += wv * (float)((int)(yw << 16) >> 24); v[j].z += wv * (float)((int)(yw << 8) >> 24); v[j].w += wv * (float)((int)yw >> 24); } }
        float s = 0.f;
#pragma unroll
        for (int j = 0; j < 4; ++j) s += (v[j].x * v[j].x + v[j].y * v[j].y) + (v[j].z * v[j].z + v[j].w * v[j].w);
        const float rstd = 1.0f / sqrtf(wave_sum(s) * (1.f / D) + RMS_EPS);
        GAS f32x4* o = (GAS f32x4*)(F.out + (size_t)m * D) + lane_;
#pragma unroll
        for (int j = 0; j < 4; ++j) o[64 * j] = v[j] * rstd * gm[j];
    }
}


constexpr int CV_SQ = (D / CV_IN) * CV_KB, CV_GU = NE * (2 * DFF / CV_IN) * CV_KB, CV_D = NE * (D / CV_IN) * CV_KB, CV_N = 3 * CV_SQ + CV_GU + CV_D, CV_P1 = 3 * CV_SQ + CV_GU;
__device__ __forceinline__ void cvt_decode(Frame& F, int it, CvtItem& c) {
    unsigned char* ws = F.ws; int r = it;
    const float* const w_lru_p = F.in[IN_WLRU]; const float* const w_fox_p = F.in[IN_WFOX]; const float* const w_o_p = F.in[IN_WO];
    if (r < 3 * CV_SQ) { const int which = r / CV_SQ, rr = r % CV_SQ, cb = rr / CV_KB, kb = rr % CV_KB;
        c.src = (which == 0 ? w_lru_p : which == 1 ? w_fox_p : w_o_p) + CV_IN * cb; c.ldw = D; c.K = D; c.k0 = CV_IK * kb; c.i8 = 0;
        c.dst = ws + (which == 0 ? WS_WLRU : which == 1 ? WS_WFOX : WS_WO) + (size_t)(CV_IN * cb) * D * 2; return; }
    r -= 3 * CV_SQ;
    if (r < CV_GU) { const int cb = r / CV_KB, kb = r % CV_KB, cpe = 2 * DFF / CV_IN, e = cb / cpe, nn0 = CV_IN * (cb % cpe), pn = nn0 >> 8, bj = (nn0 >> 7) & 1, cp = nn0 & 127, scol = bj * DFF + 128 * pn + cp;
        c.src = F.in[IN_WGU] + (size_t)e * D * 2 * DFF + scol; c.ldw = 2 * DFF; c.K = D; c.k0 = CV_IK * kb; c.i8 = 1; c.dst = ws + WS_WGU + ((size_t)e * 2 * DFF + nn0) * D; return; }
    r -= CV_GU;
    { const int cb = r / CV_KB, kb = r % CV_KB, cpe = D / CV_IN, e = cb / cpe, n0 = CV_IN * (cb % cpe);
        c.src = F.in[IN_WD] + (size_t)e * DFF * D + n0; c.ldw = D; c.K = DFF; c.k0 = CV_IK * kb; c.i8 = 1; c.dst = ws + WS_WD + ((size_t)e * D + n0) * DFF; }
}
__device__ __forceinline__ void cvt_slice(Frame& F, int k_lo, int k_hi, int item_lo = 0, int item_hi = CV_N) {
    const int lane = hw_lane(); const int NGW = F.G * NWAVES, gw0 = item_lo + F.vcu * NWAVES + F.wave, gw = gw0 + k_lo * NGW;
    const int CV_END = (k_hi >= (CV_N + NGW - 1) / NGW) ? item_hi : ((gw0 + k_hi * NGW) < item_hi ? (gw0 + k_hi * NGW) : item_hi);
    CvtItem c0, c1, c2, c3; f32x4 v0[8], v1[8], v2[8], v3[8];
    int it = gw;
#define CV_LOAD(c, v, idx) do { if ((idx) < CV_END) { cvt_decode(F, (idx), c); cvt_load(c, lane, v); } } while (0)
    CV_LOAD(c0, v0, it); CV_LOAD(c1, v1, it + NGW); CV_LOAD(c2, v2, it + 2 * NGW); CV_LOAD(c3, v3, it + 3 * NGW);
#pragma unroll 1
    for (; it < CV_END; it += 4 * NGW) {
        cvt_store(c0, lane, v0); CV_LOAD(c0, v0, it + 4 * NGW);
        if (it + NGW < CV_END) { cvt_store(c1, lane, v1); CV_LOAD(c1, v1, it + 5 * NGW); }
        if (it + 2 * NGW < CV_END) { cvt_store(c2, lane, v2); CV_LOAD(c2, v2, it + 6 * NGW); }
        if (it + 3 * NGW < CV_END) { cvt_store(c3, lane, v3); CV_LOAD(c3, v3, it + 7 * NGW); }
    }
#undef CV_LOAD
}
__device__ __forceinline__ void ph1(Frame& F) {
    unsigned char* ws = F.ws;
    pg8::Gemm g{(const bf16*)(ws + WS_H), (const bf16*)(ws + WS_WIN), M, NPROJ, D}; pg8::StaticOrder S; S.init(M, NPROJ, F.G, (int)blockIdx.x);
    pg8::EpiSplit E{(bf16*)(ws + WS_PROJ), D, D, (size_t)PROJ_STRIDE / 2, 2, attn_body::C2, 1.0f / (W8_SCALE * H8_SCALE)};
    const int rounds = (S.nwg + F.G - 1) / F.G, slot = F.vcu % (rounds + 1);
    const int pre = 2 * ((F.vcu / (rounds + 1)) % 8);
    cvt_slice(F, 0, pre, 0, CV_P1);
    __syncthreads();
    S.i0 = 0; S.i1 = slot;
    pg8::gemm_phase<pg8::EpiSplit, pg8::StaticOrder, true, true>(F.lds + RING_OFF, g, S, E, F.wave);
    cvt_slice(F, pre, 0x7fffffff, 0, CV_P1);
    __syncthreads();
    S.i0 = slot; S.i1 = rounds;
    pg8::gemm_phase<pg8::EpiSplit, pg8::StaticOrder, true, true>(F.lds + RING_OFF, g, S, E, F.wave);
}
__device__ __forceinline__ void ph3(Frame& F, unsigned char* lds_generic) {
    unsigned char* ws = F.ws;
    const attn_body::AttnTensors AT{(const attn_body::bf16*)(ws + WS_PROJ + 2 * PROJ_STRIDE), (const attn_body::bf16*)(ws + WS_PROJ + 3 * PROJ_STRIDE), (const attn_body::bf16*)(ws + WS_PROJ + 4 * PROJ_STRIDE),
                                    (attn_body::bf16*)(ws + WS_YFOX), (const float*)(ws + WS_KB), (const unsigned*)(F.ctl + CW_QN), (const unsigned*)(F.ctl + CW_KN)};
    attn_body::StaticOrder S((int)F.G, (int)blockIdx.x);
    const int pos = F.vcu % 5;
    S.i0 = 0; S.i1 = pos;
    attn_body::attn_phase<attn_body::StaticOrder>((char*)lds_generic + RING_OFF, AT, S, F.wave);
    cvt_slice(F, 0, 0x7fffffff, CV_P1, CV_N);
    S.i0 = pos; S.i1 = 0x7fffffff;
    attn_body::attn_phase<attn_body::StaticOrder>((char*)lds_generic + RING_OFF, AT, S, F.wave);
    __syncthreads();
    p3_lru(F);
}
__device__ __forceinline__ void ph4(Frame& F) {
    unsigned char* ws = F.ws;
    { pg8::Gemm g{(const bf16*)(ws + WS_YLRU), (const bf16*)(ws + WS_WLRU), M, D, D}; pg8::StaticOrder S; S.init(M, D, F.G, (int)blockIdx.x);
      pg8::EpiGate<false> E{(bf16*)(ws + WS_TMP), (const bf16*)(ws + WS_PROJ + 5 * PROJ_STRIDE), nullptr, D};
      pg8::gemm_phase<pg8::EpiGate<false>, pg8::StaticOrder, true>(F.lds + RING_OFF, g, S, E, F.wave); }
    { pg8::Gemm g{(const bf16*)(ws + WS_YFOX), (const bf16*)(ws + WS_WFOX), M, D, D}; pg8::StaticOrder S; S.init(M, D, F.G, (int)blockIdx.x);
      pg8::EpiGate<true> E{(bf16*)(ws + WS_MERGED), (const bf16*)(ws + WS_PROJ + 6 * PROJ_STRIDE), (const bf16*)(ws + WS_TMP), D};
      pg8::gemm_phase<pg8::EpiGate<true>, pg8::StaticOrder, true>(F.lds + RING_OFF, g, S, E, F.wave); }
}
__device__ __forceinline__ void ph5(Frame& F) {
    unsigned char* ws = F.ws;
    pg8::Gemm g{(const bf16*)(ws + WS_MERGED), (const bf16*)(ws + WS_WO), M, D, D}; pg8::StaticOrder S; S.init(M, D, F.G, (int)blockIdx.x);
    pg8::EpiResF32 E{F.in[IN_X], (float*)(ws + WS_X1), D};
    pg8::gemm_phase<pg8::EpiResF32, pg8::StaticOrder, true>(F.lds + RING_OFF, g, S, E, F.wave);
}
__device__ __forceinline__ void ph7(Frame& F) {
    unsigned char* ws = F.ws;
    const int TT = moe_tables(F);
    LAS unsigned char* EX = F.lds + EXTRA_OFF; LAS unsigned* rows = (LAS unsigned*)(EX + EX_ROWS);
    const LAS unsigned* ncnt = (const LAS unsigned*)(EX + EX_NCNT); const LAS unsigned* tpre = (const LAS unsigned*)(EX + EX_TPRE);
    pg8::GroupedOrder<true> S; S.init(TT, 8, F.G, (int)blockIdx.x, EX + EX_TILE_E, rows);
    { const unsigned* TOKMAP = (const unsigned*)(ws + WS_TOKMAP); pg8::Unit u;
      const int tid_ = F.wave * 64 + hw_lane();
      for (int i = 0; i < EX_MAXU && S.next(i, u); ++i) if (tid_ < 256) { const int e = u.pn >> 3; const unsigned pos = (unsigned)(u.pm - (int)tpre[e]) * 256u + (unsigned)tid_;
          rows[i * 256 + tid_] = TOKMAP[(size_t)e * M + (pos < ncnt[e] ? pos : 0u)] & (unsigned)(M - 1); } }
    __syncthreads();
    pg8::Gemm g{(const bf16*)(ws + WS_H2), (const bf16*)(ws + WS_WGU), SLOTS, 2 * DFF, D};
    pg8::EpiSwiglu E{(unsigned char*)(ws + WS_ACT), F.in[IN_BGU], 8, 1.0f / (W8_SCALE * H8_SCALE), ACT8_SCALE};
    pg8::gemm_phase<pg8::EpiSwiglu, pg8::GroupedOrder<true>, true, true>(F.lds + RING_OFF, g, S, E, F.wave);
}
__device__ __forceinline__ void ph8(Frame& F) {
    unsigned char* ws = F.ws;
    const int TT = moe_tables(F);
    LAS unsigned char* EX = F.lds + EXTRA_OFF;
    pg8::GroupedOrder<false> S; S.init(TT, 4, F.G, (int)blockIdx.x, EX + EX_TILE_E, nullptr);
    pg8::Gemm g{(const bf16*)(ws + WS_ACT), (const bf16*)(ws + WS_WD), SLOTS, D, DFF};
    pg8::EpiDown E{(unsigned char*)(ws + WS_Y), F.in[IN_BD], 4, 1.0f / (W8_SCALE * ACT8_SCALE), Y8_SCALE};
    pg8::gemm_phase<pg8::EpiDown, pg8::GroupedOrder<false>, true, true>(F.lds + RING_OFF, g, S, E, F.wave);
}
struct Args { const float* in[22]; float* out; unsigned char* ws; int ph_lo, ph_hi, li, pad; };
__global__ void __launch_bounds__(NWAVES * 64, 2) mk_fwd(Args args) {
    extern __shared__ __attribute__((aligned(16))) unsigned char lds[];
    Frame F;
    F.lds = (LAS unsigned char*)lds;
    F.MISC = (volatile LAS unsigned*)(F.lds + MISC_OFF);
    F.wave = __builtin_amdgcn_readfirstlane((int)threadIdx.x >> 6);
    F.G = gridDim.x; { const int bx = blockIdx.x; F.vcu = (F.G % 8 == 0) ? (bx % 8) * (F.G / 8) + bx / 8 : bx; }
#pragma unroll
    for (int i = 0; i < 22; ++i) F.in[i] = args.in[i];
    F.out = args.out; F.ws = args.ws; F.ctl = (gu32*)(args.ws + WS_CTL);
    for (int u = threadIdx.x; u < (LDS_BYTES - LDSCTL_OFF) / 4; u += NWAVES * 64) ((LAS unsigned*)(F.lds + LDSCTL_OFF))[u] = 0u;
    __syncthreads();
    XcdBarrier bar; bar.bar = (unsigned*)(F.ctl + CW_BAR); bar.x = 0; bar.st = nullptr;
    if (N_LAUNCHES != PER_PHASE) bar = xcd_barrier_post((unsigned*)(F.ctl + CW_BAR), F.MISC + 8);
#define GRID_BAR(seam) do { if (N_LAUNCHES == PER_PHASE) { if (threadIdx.x == 0) __hip_atomic_store(F.ctl + CW_TMO, 0xBADBA0u | (unsigned)(seam), RLX_AGENT); } else { xcd_barrier(bar); } } while (0)
    const int lo = args.ph_lo, hi = args.ph_hi;
#define IN(k) (lo <= (k) && (k) < hi)
#define BOTH(k) (IN(k) && IN((k) + 1))

#ifndef PROBE_REPEAT
#define PROBE_REPEAT -1
#endif
#ifndef ONLY_PHASE
#define ONLY_PHASE -1
#endif
#define RUN(k, call) do { if ((ONLY_PHASE < 0 || ONLY_PHASE == (k)) && IN(k)) { call; if (PROBE_REPEAT == (k)) { GRID_BAR(k); call; } if (BOTH(k)) GRID_BAR(k); } } while (0)
    RUN(0, p0_prologue(F));
    RUN(1, ph1(F));
#if PROBE_REPEAT == 11
    if (IN(1)) { pg8::Gemm g{(const bf16*)(F.ws + WS_H), (const bf16*)(F.ws + WS_WIN), M, NPROJ, D}; pg8::StaticOrder S; S.init(M, NPROJ, F.G, (int)blockIdx.x); pg8::EpiNull E;
        pg8::gemm_phase<pg8::EpiNull, pg8::StaticOrder, true, true>(F.lds + RING_OFF, g, S, E, F.wave); GRID_BAR(1); }
#endif
#if PROBE_REPEAT == 12
    if (IN(1)) { pg8::Gemm g{(const bf16*)(F.ws + WS_H), (const bf16*)(F.ws + WS_WIN), M, NPROJ, D}; pg8::StaticOrder S; S.init(M, NPROJ, F.G, (int)blockIdx.x);
        pg8::EpiSplit E{(bf16*)(F.ws + WS_Y), 0, D, 0, 2, attn_body::C2, 1.0f / (W8_SCALE * H8_SCALE)};
        pg8::gemm_phase<pg8::EpiSplit, pg8::StaticOrder, true, true>(F.lds + RING_OFF, g, S, E, F.wave); GRID_BAR(1); }
#endif
    RUN(2, p2_phase(F));
    RUN(3, ph3(F, lds));
#if PROBE_REPEAT == 14
    if (IN(3)) { unsigned char* ws = F.ws; const attn_body::AttnTensors AT{(const attn_body::bf16*)(ws + WS_PROJ + 2 * PROJ_STRIDE), (const attn_body::bf16*)(ws + WS_PROJ + 3 * PROJ_STRIDE), (const attn_body::bf16*)(ws + WS_PROJ + 4 * PROJ_STRIDE),
                                    (attn_body::bf16*)(ws + WS_TMP), (const float*)(ws + WS_KB), (const unsigned*)(F.ctl + CW_QN), (const unsigned*)(F.ctl + CW_KN)};
        const attn_body::StaticOrder S((int)F.G, (int)blockIdx.x); attn_body::attn_phase<attn_body::StaticOrder>((char*)lds + RING_OFF, AT, S, F.wave, -1.0f); GRID_BAR(3); }
#endif
#if PROBE_REPEAT == 13
    if (IN(3)) { unsigned char* ws = F.ws; const attn_body::AttnTensors AT{(const attn_body::bf16*)(ws + WS_PROJ + 2 * PROJ_STRIDE), (const attn_body::bf16*)(ws + WS_PROJ + 3 * PROJ_STRIDE), (const attn_body::bf16*)(ws + WS_PROJ + 4 * PROJ_STRIDE),
                                    (attn_body::bf16*)(ws + WS_YFOX), (const float*)(ws + WS_KB), (const unsigned*)(F.ctl + CW_QN), (const unsigned*)(F.ctl + CW_KN)};
        const attn_body::StaticOrder S((int)F.G, (int)blockIdx.x); attn_body::attn_phase<attn_body::StaticOrder>((char*)lds + RING_OFF, AT, S, F.wave); GRID_BAR(3); }
#endif
    RUN(4, ph4(F));
    RUN(5, ph5(F));
    RUN(6, p6_route(F));
#if PROBE_REPEAT == 16
    if (IN(6)) { if (blockIdx.x == 0 && threadIdx.x < 32) __hip_atomic_store(F.ctl + CW_CNT + 64 * threadIdx.x, 0u, RLX_AGENT); GRID_BAR(6); p6_route(F); GRID_BAR(6); }
#endif
    RUN(7, ph7(F));
#if PROBE_REPEAT == 17
    if (IN(7)) { unsigned char* ws = F.ws; const int TT = moe_tables(F); LAS unsigned char* EX = F.lds + EXTRA_OFF; LAS unsigned* rows = (LAS unsigned*)(EX + EX_ROWS);
        pg8::GroupedOrder<true> S; S.init(TT, 8, F.G, (int)blockIdx.x, EX + EX_TILE_E, rows);
        pg8::Gemm g{(const bf16*)(ws + WS_H2), (const bf16*)(ws + WS_WGU), SLOTS, 2 * DFF, D}; pg8::EpiNull E;
        pg8::gemm_phase<pg8::EpiNull, pg8::GroupedOrder<true>, true, true>(F.lds + RING_OFF, g, S, E, F.wave); GRID_BAR(7); }
#endif
    RUN(8, ph8(F));
    RUN(9, p9_final(F));
#undef RUN
#undef IN
#undef BOTH
}

extern "C" void kernel_launch(void* const* d_in, const int* in_sizes, int n_in, void* d_out, int out_size, void* d_ws, size_t ws_size, hipStream_t stream) {
    static int grid = 0;
    if (grid == 0) {
        if (n_in != 22 || in_sizes[0] != M * D || out_size != M * D || ws_size < WS_END) { fprintf(stderr, "kernel_launch: unexpected problem: n_in %d in0 %d out %d ws %zu (need %zu)\n", n_in, n_in > 0 ? in_sizes[0] : -1, out_size, ws_size, (size_t)WS_END); grid = -1; return; }
        int dev = 0, cus = 0, per_cu = 0;
        if (hipGetDevice(&dev) != hipSuccess || hipDeviceGetAttribute(&cus, hipDeviceAttributeMultiprocessorCount, dev) != hipSuccess) { grid = -1; return; }
        if (hipFuncSetAttribute((const void*)mk_fwd, hipFuncAttributeMaxDynamicSharedMemorySize, LDS_BYTES) != hipSuccess) { fprintf(stderr, "kernel_launch: hipFuncSetAttribute failed\n"); grid = -1; return; }
        if (hipOccupancyMaxActiveBlocksPerMultiprocessor(&per_cu, (const void*)mk_fwd, NWAVES * 64, LDS_BYTES) != hipSuccess || per_cu < 1) { fprintf(stderr, "kernel_launch: occupancy query reports %d workgroups per CU\n", per_cu); }
        (void)hipGetLastError();
        grid = cus;
    }
    if (grid < 0) return;
    if (hipMemsetAsync((char*)d_ws + WS_CTL, 0, CTL_ZERO_BYTES, stream) != hipSuccess) return;
    Args a{};
    for (int i = 0; i < 22; ++i) a.in[i] = (const float*)d_in[i];
    a.out = (float*)d_out; a.ws = (unsigned char*)d_ws;
    for (int li = 0; li < N_LAUNCHES; ++li) {
        a.ph_lo = (N_LAUNCHES == PER_PHASE) ? li : 0; a.ph_hi = (N_LAUNCHES == PER_PHASE) ? li + 1 : PER_PHASE; a.li = li; a.pad = 0;
        hipLaunchKernelGGL(mk_fwd, dim3(grid), dim3(NWAVES * 64), LDS_BYTES, stream, a);
    }
}
```

```cpp
#include <hip/hip_runtime.h>
#include <cstdio>
#include <cstdint>
__device__ __forceinline__ int hw_lane() { int l; asm volatile("v_mbcnt_lo_u32_b32 %0, -1, 0\n\tv_mbcnt_hi_u32_b32 %0, -1, %0" : "=v"(l)); return l; }
namespace pg8 {
#define PG8_LAS __attribute__((address_space(3)))
typedef unsigned short bf16_t;
typedef short bf16x8 __attribute__((ext_vector_type(8)));
typedef float f32x4 __attribute__((ext_vector_type(4)));
typedef unsigned u32x4 __attribute__((ext_vector_type(4)));
constexpr int BM = 256, BK = 64, HALF = 128, HTB = HALF * BK * 2  , STAGE_BYTES = 8 * HTB, NXCD = 8, WGM = 8;

__host__ __device__ __forceinline__ int lds_byte(int r, int c) { const int st = (r >> 4) * 2 + (c >> 5), rr = r & 15, cc = c & 31, ob = rr * 64 + cc * 2; return st * 1024 + (ob ^ (((ob >> 9) & 1) << 5)); }
__host__ __device__ __forceinline__ void stage_rc(int b, int& R, int& C) { const int st = b / 1024, sb = b % 1024, swz = sb ^ (((sb >> 9) & 1) << 5); R = (st >> 1) * 16 + swz / 64; C = (st & 1) * 32 + (swz % 64) / 2; }
__host__ __device__ __forceinline__ int perm32(int rho) { const int n = rho >> 4, i = rho & 15; return 8 * (i >> 2) + 4 * n + (i & 3); }

struct Unit { int pm, pn; };
struct Gemm { const bf16_t* A; const bf16_t* Bt; int M, N, K; };

struct StaticOrder {
    static constexpr bool GATHER = false;
    int nM, nN, nwg, G, c, i0, i1;
    __device__ __forceinline__ void init(int M, int N, int G_, int c_) { nM = M / BM; nN = N / BM; nwg = nM * nN; G = G_; c = c_; i0 = 0; i1 = 0x7fffffff; }
    __device__ __forceinline__ bool next(int i, Unit& u) const {
        if (i >= i1 - i0) return false;
        const long L = (long)(i + i0) * G + c; if (L >= nwg) return false;
        int wgid = (int)L; { const int q = nwg / NXCD, r = nwg % NXCD, xcd = wgid % NXCD, off = wgid / NXCD; wgid = (xcd < r ? xcd * (q + 1) : r * (q + 1) + (xcd - r) * q) + off; }
        const int nig = WGM * nN, gid = wgid / nig, fm = gid * WGM, gsz = (nM - fm) < WGM ? (nM - fm) : WGM;
        u.pm = fm + ((wgid % nig) % gsz); u.pn = (wgid % nig) / gsz; return true;
    }
    __device__ __forceinline__ unsigned a_off(int, const Unit& u, int rloc, int rowbytes) const { return (unsigned)(u.pm * BM + rloc) * (unsigned)rowbytes; }
};
struct PairOrder : StaticOrder {
    unsigned abase[2];
    __device__ __forceinline__ bool next(int i, Unit& u) const { if (!StaticOrder::next(i >> 1, u)) return false; u.pn += (i & 1) * nN; return true; }
    __device__ __forceinline__ unsigned a_off(int, const Unit& u, int rloc, int rowbytes) const { return abase[u.pn >= nN ? 1 : 0] + (unsigned)(u.pm * BM + rloc) * (unsigned)rowbytes; }
};
template <bool GATHER_> struct GroupedOrder {
    static constexpr bool GATHER = GATHER_;
    int nM, nN, nwg, G, c;
    const PG8_LAS unsigned char* tile_e; const PG8_LAS unsigned* rows;
    __device__ __forceinline__ void init(int TT, int nN_, int G_, int c_, const PG8_LAS unsigned char* te, const PG8_LAS unsigned* rw) { nM = TT; nN = nN_; nwg = nM * nN; G = G_; c = c_; tile_e = te; rows = rw; }
    __device__ __forceinline__ bool next(int i, Unit& u) const {
        const long L = (long)i * G + c; if (L >= nwg) return false;
        int wgid = (int)L; { const int q = nwg / NXCD, r = nwg % NXCD, xcd = wgid % NXCD, off = wgid / NXCD; wgid = (xcd < r ? xcd * (q + 1) : r * (q + 1) + (xcd - r) * q) + off; }
        const int nig = WGM * nN, gid = wgid / nig, fm = gid * WGM, gsz = (nM - fm) < WGM ? (nM - fm) : WGM;
        u.pm = fm + ((wgid % nig) % gsz); u.pn = (int)tile_e[u.pm] * nN + (wgid % nig) / gsz; return true;
    }
    __device__ __forceinline__ unsigned a_off(int i, const Unit& u, int rloc, int rowbytes) const {
        return GATHER ? rows[i * 256 + rloc] * (unsigned)rowbytes : (unsigned)(u.pm * BM + rloc) * (unsigned)rowbytes; }
};

__device__ __forceinline__ unsigned cvt_pk_bf16(float lo, float hi) { unsigned r; asm volatile("v_cvt_pk_bf16_f32 %0, %1, %2" : "=v"(r) : "v"(lo), "v"(hi)); return r; }
__device__ __forceinline__ float bf_lo(unsigned w) { return __uint_as_float(w << 16); }
__device__ __forceinline__ float bf_hi(unsigned w) { return __uint_as_float(w & 0xffff0000u); }
__device__ __forceinline__ float sigm(float x) { return __builtin_amdgcn_rcpf(1.0f + __builtin_amdgcn_exp2f(-1.4426950408889634f * x)); }

__device__ __forceinline__ unsigned q8lo(float x) { return __float_as_uint(__builtin_amdgcn_fmed3f(x, -127.0f, 127.0f) + 12582912.0f); }
__device__ __forceinline__ unsigned pk4_i8(float a, float b, float c, float d) {
    const unsigned ab = __builtin_amdgcn_perm(q8lo(b), q8lo(a), 0x0c0c0400u), cd = __builtin_amdgcn_perm(q8lo(d), q8lo(c), 0x0c0c0400u); return ab | (cd << 16); }
struct EpiSplit {
    static constexpr bool PERM = true, AFTER_DRAIN = false;
    bf16_t* O; int ldc; int split_cols; size_t split_stride; int scale_t; float scale; float accscale;
    __device__ __forceinline__ void operator()(const f32x4 (&acc)[2][2][4][2], const Unit& u, int wr, int wc, int fr, int fq) const {
        const int row0 = u.pm * BM + wr * 64 + fr; int colt = u.pn * BM; bf16_t* base = O;
        const int t = colt / split_cols; base += (size_t)t * split_stride; colt -= t * split_cols; const float sc = ((t == scale_t) ? scale : 1.f) * accscale;
        const int col0 = colt + wc * 32 + 8 * fq;
#pragma unroll
        for (int ai = 0; ai < 2; ++ai)
#pragma unroll
            for (int m = 0; m < 4; ++m) { bf16_t* rowp = base + (size_t)(row0 + ai * HALF + m * 16) * ldc + col0;
#pragma unroll
                for (int bj = 0; bj < 2; ++bj) { const f32x4 v0 = acc[ai][bj][m][0] * sc, v1 = acc[ai][bj][m][1] * sc;
                    u32x4 w; w.x = cvt_pk_bf16(v0[0], v0[1]); w.y = cvt_pk_bf16(v0[2], v0[3]); w.z = cvt_pk_bf16(v1[0], v1[1]); w.w = cvt_pk_bf16(v1[2], v1[3]);
                    *(u32x4*)(rowp + bj * HALF) = w; } }
    }
};
struct EpiNull {
    static constexpr bool PERM = true, AFTER_DRAIN = false;
    __device__ __forceinline__ void operator()(const f32x4 (&acc)[2][2][4][2], const Unit&, int, int, int, int) const {
#pragma unroll
        for (int ai = 0; ai < 2; ++ai)
#pragma unroll
            for (int bj = 0; bj < 2; ++bj)
#pragma unroll
                for (int m = 0; m < 4; ++m) asm volatile("" :: "v"(acc[ai][bj][m][0]), "v"(acc[ai][bj][m][1]));
    }
};
template <bool ADD> struct EpiGate {
    static constexpr bool PERM = true, AFTER_DRAIN = false;
    bf16_t* O; const bf16_t* G; const bf16_t* T; int ldc;
    __device__ __forceinline__ void operator()(const f32x4 (&acc)[2][2][4][2], const Unit& u, int wr, int wc, int fr, int fq) const {
        const int row0 = u.pm * BM + wr * 64 + fr, col0 = u.pn * BM + wc * 32 + 8 * fq;
#pragma unroll
        for (int ai = 0; ai < 2; ++ai)
#pragma unroll
            for (int m = 0; m < 4; ++m) { const size_t off = (size_t)(row0 + ai * HALF + m * 16) * ldc + col0;
#pragma unroll
                for (int bj = 0; bj < 2; ++bj) { const u32x4 g = *(const u32x4*)(G + off + bj * HALF); u32x4 tv = (u32x4){0u, 0u, 0u, 0u}; if (ADD) tv = *(const u32x4*)(T + off + bj * HALF);
                    const f32x4 v0 = acc[ai][bj][m][0], v1 = acc[ai][bj][m][1]; float r[8];
                    r[0] = sigm(bf_lo(g.x)) * v0[0]; r[1] = sigm(bf_hi(g.x)) * v0[1]; r[2] = sigm(bf_lo(g.y)) * v0[2]; r[3] = sigm(bf_hi(g.y)) * v0[3];
                    r[4] = sigm(bf_lo(g.z)) * v1[0]; r[5] = sigm(bf_hi(g.z)) * v1[1]; r[6] = sigm(bf_lo(g.w)) * v1[2]; r[7] = sigm(bf_hi(g.w)) * v1[3];
                    if (ADD) { r[0] += bf_lo(tv.x); r[1] += bf_hi(tv.x); r[2] += bf_lo(tv.y); r[3] += bf_hi(tv.y); r[4] += bf_lo(tv.z); r[5] += bf_hi(tv.z); r[6] += bf_lo(tv.w); r[7] += bf_hi(tv.w); }
                    u32x4 w; w.x = cvt_pk_bf16(r[0], r[1]); w.y = cvt_pk_bf16(r[2], r[3]); w.z = cvt_pk_bf16(r[4], r[5]); w.w = cvt_pk_bf16(r[6], r[7]);
                    *(u32x4*)(O + off + bj * HALF) = w; } }
    }
};
struct EpiGatePair {
    static constexpr bool PERM = true, AFTER_DRAIN = false;
    EpiGate<false> e0; EpiGate<true> e1; int nN;
    __device__ __forceinline__ void operator()(const f32x4 (&acc)[2][2][4][2], const Unit& u, int wr, int wc, int fr, int fq) const {
        if (u.pn < nN) e0(acc, u, wr, wc, fr, fq); else { Unit v = u; v.pn -= nN; e1(acc, v, wr, wc, fr, fq); } }
};
struct EpiPlainBf16 {
    static constexpr bool PERM = true, AFTER_DRAIN = false;
    bf16_t* O; int ldc;
    __device__ __forceinline__ void operator()(const f32x4 (&acc)[2][2][4][2], const Unit& u, int wr, int wc, int fr, int fq) const {
        const int row0 = u.pm * BM + wr * 64 + fr, col0 = u.pn * BM + wc * 32 + 8 * fq;
#pragma unroll
        for (int ai = 0; ai < 2; ++ai)
#pragma unroll
            for (int m = 0; m < 4; ++m) { bf16_t* rowp = O + (size_t)(row0 + ai * HALF + m * 16) * ldc + col0;
#pragma unroll
                for (int bj = 0; bj < 2; ++bj) { const f32x4 v0 = acc[ai][bj][m][0], v1 = acc[ai][bj][m][1];
                    u32x4 w; w.x = cvt_pk_bf16(v0[0], v0[1]); w.y = cvt_pk_bf16(v0[2], v0[3]); w.z = cvt_pk_bf16(v1[0], v1[1]); w.w = cvt_pk_bf16(v1[2], v1[3]);
                    *(u32x4*)(rowp + bj * HALF) = w; } }
    }
};
struct EpiResF32 {
    static constexpr bool PERM = false, AFTER_DRAIN = false;
    const float* base; float* out; int ldc;
    __device__ __forceinline__ void operator()(const f32x4 (&acc)[2][2][4][2], const Unit& u, int wr, int wc, int fr, int fq) const {
        const int row0 = u.pm * BM + wr * 64 + fr, col0 = u.pn * BM + wc * 32 + 4 * fq;
#pragma unroll
        for (int ai = 0; ai < 2; ++ai)
#pragma unroll
            for (int m = 0; m < 4; ++m) { const size_t off = (size_t)(row0 + ai * HALF + m * 16) * ldc + col0;
#pragma unroll
                for (int bj = 0; bj < 2; ++bj)
#pragma unroll
                    for (int n = 0; n < 2; ++n) *(f32x4*)(out + off + bj * HALF + n * 16) = *(const f32x4*)(base + off + bj * HALF + n * 16) + acc[ai][bj][m][n]; }
    }
};
struct EpiSwiglu {
    static constexpr bool PERM = true, AFTER_DRAIN = false;
    unsigned char* O; const float* bias; int nN; float accscale, outscale;
    typedef float f2 __attribute__((ext_vector_type(2)));
    __device__ __forceinline__ f2 act2(f2 ga, f2 ua, f2 bg, f2 bu) const {
        f2 g = __builtin_elementwise_fma(ga, (f2){accscale, accscale}, bg), u = __builtin_elementwise_fma(ua, (f2){accscale, accscale}, bu);
        g.x = fminf(g.x, 7.0f); g.y = fminf(g.y, 7.0f); u.x = __builtin_amdgcn_fmed3f(u.x, -7.0f, 7.0f); u.y = __builtin_amdgcn_fmed3f(u.y, -7.0f, 7.0f);
        const f2 t = g * (-1.702f * 1.4426950408889634f); f2 e; e.x = __builtin_amdgcn_exp2f(t.x); e.y = __builtin_amdgcn_exp2f(t.y);
        const f2 d = e + 1.0f; f2 r; r.x = __builtin_amdgcn_rcpf(d.x); r.y = __builtin_amdgcn_rcpf(d.y);
        return (u + 1.0f) * (g * outscale) * r; }
    __device__ __forceinline__ void operator()(const f32x4 (&acc)[2][2][4][2], const Unit& u, int wr, int wc, int fr, int fq) const {
        const int e = u.pn / nN, pnl = u.pn - e * nN; const int row0 = u.pm * BM + wr * 64 + fr, colg = pnl * HALF + wc * 32 + 8 * fq;
        f32x4 bg[2], bu[2];
#pragma unroll
        for (int n = 0; n < 2; ++n) { bg[n] = *(const f32x4*)(bias + (size_t)e * 2048 + colg + 4 * n); bu[n] = *(const f32x4*)(bias + (size_t)e * 2048 + 1024 + colg + 4 * n); }
#pragma unroll
        for (int ai = 0; ai < 2; ++ai)
#pragma unroll
            for (int m = 0; m < 4; ++m) { f2 r[4];
#pragma unroll
                for (int n = 0; n < 2; ++n) { const f32x4 ga = acc[ai][0][m][n], ua = acc[ai][1][m][n];
                    r[2 * n] = act2((f2){ga[0], ga[1]}, (f2){ua[0], ua[1]}, (f2){bg[n][0], bg[n][1]}, (f2){bu[n][0], bu[n][1]});
                    r[2 * n + 1] = act2((f2){ga[2], ga[3]}, (f2){ua[2], ua[3]}, (f2){bg[n][2], bg[n][3]}, (f2){bu[n][2], bu[n][3]}); }
                typedef unsigned u32x2_ __attribute__((ext_vector_type(2))); u32x2_ w; w.x = pk4_i8(r[0].x, r[0].y, r[1].x, r[1].y); w.y = pk4_i8(r[2].x, r[2].y, r[3].x, r[3].y);
                *(u32x2_*)(O + (size_t)(row0 + ai * HALF + m * 16) * 1024 + colg) = w; }
    }
};
struct EpiDown {
    static constexpr bool PERM = true, AFTER_DRAIN = false;
    unsigned char* O; const float* bias; int nN; float accscale, outscale;
    __device__ __forceinline__ void operator()(const f32x4 (&acc)[2][2][4][2], const Unit& u, int wr, int wc, int fr, int fq) const {
        const int e = u.pn / nN, pnl = u.pn - e * nN; const int row0 = u.pm * BM + wr * 64 + fr, col0 = pnl * BM + wc * 32 + 8 * fq;
        f32x4 bv[2][2];
#pragma unroll
        for (int bj = 0; bj < 2; ++bj)
#pragma unroll
            for (int n = 0; n < 2; ++n) bv[bj][n] = *(const f32x4*)(bias + (size_t)e * 1024 + col0 + bj * HALF + 4 * n);
#pragma unroll
        for (int ai = 0; ai < 2; ++ai)
#pragma unroll
            for (int m = 0; m < 4; ++m) { unsigned char* rowp = O + (size_t)(row0 + ai * HALF + m * 16) * 1024 + col0;
#pragma unroll
                for (int bj = 0; bj < 2; ++bj) { const f32x4 v0 = (acc[ai][bj][m][0] * accscale + bv[bj][0]) * outscale, v1 = (acc[ai][bj][m][1] * accscale + bv[bj][1]) * outscale;
                    typedef unsigned u32x2_ __attribute__((ext_vector_type(2))); u32x2_ w; w.x = pk4_i8(v0[0], v0[1], v0[2], v0[3]); w.y = pk4_i8(v1[0], v1[1], v1[2], v1[3]);
                    *(u32x2_*)(rowp + bj * HALF) = w; } }
    }
};

typedef int i32x4 __attribute__((ext_vector_type(4)));
template <class Epi, class Sched, bool ALIGN_EPI, bool I8 = false>
__device__ __forceinline__ void gemm_phase(PG8_LAS unsigned char* lds, const Gemm g, const Sched& S, const Epi& E, int wave_id) {
    const int wid = wave_id, lane = hw_lane(), tid = wid * 64 + lane, wr = wid >> 2, wc = wid & 3, fr = lane & 15, fq = lane >> 4;
    const int K = g.K, rowb = I8 ? K : K * 2, nt = rowb / (BK * 2);
    int RA[2], CA2[2]; unsigned voffB[2], voffA[2];
#pragma unroll
    for (int i = 0; i < 2; ++i) { int R, C; stage_rc(tid * 16 + i * 8192, R, C); const int Rb = Epi::PERM ? ((R & ~31) + perm32(R & 31)) : R;
        RA[i] = R; CA2[i] = C * 2; voffB[i] = (unsigned)(Rb * rowb + C * 2); voffA[i] = (unsigned)(R * rowb + C * 2); }
    const unsigned kstep = (unsigned)(BK * 2);
    const size_t hstep = (size_t)HALF * rowb;
    const size_t tstep = 2 * hstep;
    const unsigned ldsw = (unsigned)wid * 1024u;
    const int aoff = lds_byte(wr * 64 + fr, fq * 8), boff = lds_byte(wc * 32 + fr, fq * 8);
    const char* Abase = (const char*)g.A;
#define PG8_SA(b, h) (((b) * 2 + (h)) * HTB)
#define PG8_SB(b, h) ((4 + (b) * 2 + (h)) * HTB)
#define PG8_STAGE(bufoff, gbase, voff) do { _Pragma("unroll") for (int _i = 0; _i < 2; ++_i) \
        __builtin_amdgcn_global_load_lds((const unsigned*)((const char*)(gbase) + (voff)[_i]), (PG8_LAS unsigned*)(lds + (bufoff) + ldsw + _i * 8192), 16, 0, 0); } while (0)
#define PG8_STAGEA(bufoff, h, NX, kb) do { _Pragma("unroll") for (int _i = 0; _i < 2; ++_i) { \
        const unsigned _o = Sched::GATHER ? (((NX) ? offN[h][_i] : offC[h][_i]) + (kb)) : (voffA[_i] + (unsigned)((h) * (HALF * rowb)) + ((NX) ? uaN : uaC) + (kb)); \
        __builtin_amdgcn_global_load_lds((const unsigned*)(Abase + (size_t)_o), (PG8_LAS unsigned*)(lds + (bufoff) + ldsw + _i * 8192), 16, 0, 0); } } while (0)
#define PG8_LDA(dst, b, h) do { _Pragma("unroll") for (int m = 0; m < 4; ++m) _Pragma("unroll") for (int k = 0; k < 2; ++k) dst[m][k] = *(const PG8_LAS bf16x8*)(lds + PG8_SA(b, h) + aoff + m * 2048 + k * 1024); } while (0)
#define PG8_LDB(dst, b, h) do { _Pragma("unroll") for (int n = 0; n < 2; ++n) _Pragma("unroll") for (int k = 0; k < 2; ++k) dst[n][k] = *(const PG8_LAS bf16x8*)(lds + PG8_SB(b, h) + boff + n * 2048 + k * 1024); } while (0)
#define PG8_MMA(ai, bj, At, Bt) do { __builtin_amdgcn_s_setprio(1); _Pragma("unroll") for (int m = 0; m < 4; ++m) _Pragma("unroll") for (int n = 0; n < 2; ++n) _Pragma("unroll") for (int k = 0; k < 2; ++k) { \
        if constexpr (I8) acc[ai][bj][m][n] = __builtin_bit_cast(f32x4, __builtin_amdgcn_mfma_i32_16x16x64_i8(__builtin_bit_cast(i32x4, Bt[n][k]), __builtin_bit_cast(i32x4, At[m][k]), __builtin_bit_cast(i32x4, acc[ai][bj][m][n]), 0, 0, 0)); \
        else acc[ai][bj][m][n] = __builtin_amdgcn_mfma_f32_16x16x32_bf16(Bt[n][k], At[m][k], acc[ai][bj][m][n], 0, 0, 0); } __builtin_amdgcn_s_setprio(0); } while (0)
#define PG8_WAIT_V(n) asm volatile("s_waitcnt vmcnt(" #n ")" ::: "memory")
#define PG8_WAIT_L(n) asm volatile("s_waitcnt lgkmcnt(" #n ")" ::: "memory")
#define PG8_BAR __builtin_amdgcn_s_barrier()
#define PG8_SCHED __builtin_amdgcn_sched_barrier(0)
    Unit cur, nxt; int ui = 0;
    if (!S.next(0, cur)) return;
    f32x4 acc[2][2][4][2];
#pragma unroll
    for (int a = 0; a < 2; ++a)
#pragma unroll
        for (int b = 0; b < 2; ++b)
#pragma unroll
            for (int m = 0; m < 4; ++m)
#pragma unroll
                for (int n = 0; n < 2; ++n) acc[a][b][m][n] = (f32x4){0.f, 0.f, 0.f, 0.f};
    bf16x8 At[4][2], B0[2][2], B1[2][2];
    unsigned offC[2][2], offN[2][2];
    unsigned uaC = 0u, uaN = 0u;
    if constexpr (Sched::GATHER) {
#pragma unroll
        for (int h = 0; h < 2; ++h)
#pragma unroll
            for (int i = 0; i < 2; ++i) offC[h][i] = S.a_off(0, cur, h * HALF + RA[i], rowb) + (unsigned)CA2[i];
    } else uaC = S.a_off(0, cur, 0, rowb);
    const char* cB = (const char*)g.Bt + (size_t)cur.pn * tstep;
    PG8_STAGE(PG8_SB(0, 0), cB, voffB); PG8_STAGE(PG8_SB(0, 1), cB + hstep, voffB); PG8_STAGEA(PG8_SA(0, 0), 0, false, 0u); PG8_STAGEA(PG8_SA(0, 1), 1, false, 0u);
    if (wr == 1) PG8_BAR;
    PG8_WAIT_V(2); PG8_BAR;
    PG8_STAGE(PG8_SB(1, 0), cB + kstep, voffB); PG8_STAGEA(PG8_SA(1, 0), 0, false, kstep); PG8_STAGE(PG8_SB(1, 1), cB + hstep + kstep, voffB);
    PG8_WAIT_V(6); PG8_BAR;
    for (;;) {
        const bool has_next = S.next(ui + 1, nxt);
        const char* nB = has_next ? (const char*)g.Bt + (size_t)nxt.pn * tstep : cB;
        if constexpr (Sched::GATHER) {
#pragma unroll
            for (int h = 0; h < 2; ++h)
#pragma unroll
                for (int i = 0; i < 2; ++i) offN[h][i] = has_next ? S.a_off(ui + 1, nxt, h * HALF + RA[i], rowb) + (unsigned)CA2[i] : offC[h][i];
        } else uaN = has_next ? S.a_off(ui + 1, nxt, 0, rowb) : uaC;
#pragma unroll 1
        for (int t = 0; t < nt; t += 2) {
            const bool last = (t == nt - 2);
            const unsigned kb1 = (unsigned)(t + 1) * kstep, kb2 = last ? 0u : (unsigned)(t + 2) * kstep, kb3 = kb2 + kstep;
            const char* b2 = last ? nB : cB + (size_t)(t + 2) * kstep; const char* b3 = b2 + kstep;
            PG8_LDB(B0, 0, 0); PG8_LDB(B1, 0, 1); PG8_SCHED; PG8_LDA(At, 0, 0); PG8_STAGEA(PG8_SA(1, 1), 1, false, kb1);
            PG8_WAIT_V(8); PG8_WAIT_L(0); PG8_BAR; PG8_MMA(0, 0, At, B0); PG8_MMA(0, 1, At, B1); PG8_BAR; PG8_SCHED;
            PG8_LDA(At, 0, 1); PG8_STAGE(PG8_SB(0, 0), b2, voffB); PG8_STAGE(PG8_SB(0, 1), b2 + hstep, voffB); PG8_STAGEA(PG8_SA(0, 0), 0, last, kb2);
            PG8_WAIT_V(8); PG8_WAIT_L(0); PG8_BAR; PG8_MMA(1, 0, At, B0); PG8_MMA(1, 1, At, B1); PG8_BAR; PG8_SCHED;
            PG8_LDB(B0, 1, 0); PG8_LDB(B1, 1, 1); PG8_SCHED; PG8_LDA(At, 1, 0); PG8_STAGEA(PG8_SA(0, 1), 1, last, kb2);
            PG8_WAIT_V(8); PG8_WAIT_L(0); PG8_BAR; PG8_MMA(0, 0, At, B0); PG8_MMA(0, 1, At, B1); PG8_BAR; PG8_SCHED;
            PG8_LDA(At, 1, 1); PG8_STAGE(PG8_SB(1, 0), b3, voffB); PG8_STAGE(PG8_SB(1, 1), b3 + hstep, voffB); PG8_STAGEA(PG8_SA(1, 0), 0, last, kb3);
            PG8_WAIT_V(8); PG8_WAIT_L(0); PG8_BAR; PG8_MMA(1, 0, At, B0); PG8_MMA(1, 1, At, B1); PG8_BAR; PG8_SCHED;
        }
        if constexpr (ALIGN_EPI) { if (wr == 0) PG8_BAR; }
        if constexpr (I8) {
#pragma unroll
            for (int a = 0; a < 2; ++a)
#pragma unroll
                for (int b = 0; b < 2; ++b)
#pragma unroll
                    for (int m = 0; m < 4; ++m)
#pragma unroll
                        for (int n = 0; n < 2; ++n) { const i32x4 iv = __builtin_bit_cast(i32x4, acc[a][b][m][n]); acc[a][b][m][n] = (f32x4){(float)iv[0], (float)iv[1], (float)iv[2], (float)iv[3]}; } }
        E(acc, cur, wr, wc, fr, fq);
        if (!has_next) break;
#pragma unroll
        for (int a = 0; a < 2; ++a)
#pragma unroll
            for (int b = 0; b < 2; ++b)
#pragma unroll
                for (int m = 0; m < 4; ++m)
#pragma unroll
                    for (int n = 0; n < 2; ++n) acc[a][b][m][n] = (f32x4){0.f, 0.f, 0.f, 0.f};
        cur = nxt; cB = nB; ++ui; uaC = uaN;
        if constexpr (Sched::GATHER) {
#pragma unroll
            for (int h = 0; h < 2; ++h)
#pragma unroll
                for (int i = 0; i < 2; ++i) offC[h][i] = offN[h][i]; }
        if constexpr (ALIGN_EPI) { if (wr == 1) PG8_BAR; }
    }
    PG8_WAIT_V(0);
    if constexpr (!ALIGN_EPI) { if (wr == 0) PG8_BAR; }
    PG8_BAR;
#undef PG8_SA
#undef PG8_SB
#undef PG8_STAGE
#undef PG8_STAGEA
#undef PG8_LDA
#undef PG8_LDB
#undef PG8_MMA
#undef PG8_WAIT_V
#undef PG8_WAIT_L
#undef PG8_BAR
#undef PG8_SCHED
}
}
#include <hip/hip_bf16.h>
#include <cmath>
namespace attn_body {
using bf16=__hip_bfloat16;
using bf16x8=__attribute__((ext_vector_type(8)))short;
using s16x4=__attribute__((ext_vector_type(4)))short;
using f32x16=__attribute__((ext_vector_type(16)))float;
using u32x4=__attribute__((ext_vector_type(4)))unsigned;
constexpr int BATCH=4,NHEAD=16,SEQ=4096,D=64,DM=NHEAD*D;
constexpr int NW=8,QBLK=32,QB=QBLK*NW,KVBLK=64,NQB=SEQ/QB;
constexpr int ATTN_PITCH=DM, ATTN_UNIT_ROWS=QB;
__device__ __forceinline__ int crow(int r,int hi){return (r&3)+8*(r>>2)+4*hi;}
#define SBAR() __builtin_amdgcn_sched_barrier(0)
__device__ __forceinline__ void cmask(f32x16&p0,f32x16&p1,int jb,int qrel,int hi){
  const float NEG=-INFINITY; int kb=64*jb+4*hi;
  #pragma unroll
  for(int r=0;r<16;++r){int kv=kb+(r&3)+8*(r>>2); if(kv>qrel)p0[r]=NEG; if(kv+32>qrel)p1[r]=NEG;}
}

constexpr int NSLOT=3, SLOTB=8192;
constexpr int LDS_K=0, LDS_V=NSLOT*SLOTB, LDS_WS=2*NSLOT*SLOTB, LDS_OST=LDS_WS+NW*64*4, LDS_KB=LDS_OST+NW*4096, LDS_BYTES=LDS_KB+SEQ*4+256;
constexpr float C2=0.125f*1.4426950408889634f;
__device__ __forceinline__ void glds16(const void*gsrc,unsigned lds_dst){unsigned keep;
  asm volatile("s_mov_b32 %0, m0\n\ts_mov_b32 m0, %2\n\ts_nop 0\n\tglobal_load_lds_dwordx4 %1, off\n\ts_mov_b32 m0, %0":"=&s"(keep):"v"(gsrc),"s"(lds_dst):"memory");}
__device__ __forceinline__ float max3f(float a,float b,float c){float r;asm("v_max3_f32 %0, %1, %2, %3":"=v"(r):"v"(a),"v"(b),"v"(c));return r;}
__device__ __forceinline__ float max2f(float a,float b){float r;asm("v_max_f32_e32 %0, %1, %2":"=v"(r):"v"(a),"v"(b));return r;}
__device__ __forceinline__ float fadd_s(float a,float b){float r;asm("v_add_f32_e32 %0, %1, %2":"=v"(r):"v"(a),"v"(b));return r;}
__device__ __forceinline__ float fsub_s(float a,float b){float r;asm("v_sub_f32_e32 %0, %1, %2":"=v"(r):"v"(a),"v"(b));return r;}
typedef float f32x2_t __attribute__((ext_vector_type(2))); typedef __bf16 bf16x2_t __attribute__((ext_vector_type(2)));
__device__ __forceinline__ unsigned cvtpk_s(float lo,float hi){f32x2_t v={lo,hi};bf16x2_t b=__builtin_convertvector(v,bf16x2_t);return __builtin_bit_cast(unsigned,b);}
#define WAIT_BAR(N) asm volatile("s_waitcnt vmcnt(" #N ") lgkmcnt(0)\n\ts_barrier":::"memory")

__device__ __forceinline__ void qkt(f32x16&p0,f32x16&p1,const char*Kslot,const bf16x8*qr,int r32,int hi){
  const char*kb=Kslot+hi*1024+r32*16;
  #pragma unroll
  for(int d0=0;d0<4;++d0){
    const bf16x8 b0=*reinterpret_cast<const bf16x8*>(kb+d0*2048);
    const bf16x8 b1=*reinterpret_cast<const bf16x8*>(kb+d0*2048+512);
    p0=__builtin_amdgcn_mfma_f32_32x32x16_bf16(b0,qr[d0],p0,0,0,0);p1=__builtin_amdgcn_mfma_f32_32x32x16_bf16(b1,qr[d0],p1,0,0,0);}
}
typedef __attribute__((address_space(3))) const char* lds_cptr;
typedef short v4i16_t __attribute__((ext_vector_type(4)));
__device__ __forceinline__ void kload8(bf16x8*kf,lds_cptr kp){
  kf[0]=*(const __attribute__((address_space(3))) bf16x8*)(kp);      kf[1]=*(const __attribute__((address_space(3))) bf16x8*)(kp+512);
  kf[2]=*(const __attribute__((address_space(3))) bf16x8*)(kp+2048); kf[3]=*(const __attribute__((address_space(3))) bf16x8*)(kp+2560);
  kf[4]=*(const __attribute__((address_space(3))) bf16x8*)(kp+4096); kf[5]=*(const __attribute__((address_space(3))) bf16x8*)(kp+4608);
  kf[6]=*(const __attribute__((address_space(3))) bf16x8*)(kp+6144); kf[7]=*(const __attribute__((address_space(3))) bf16x8*)(kp+6656);
}
__device__ __forceinline__ void kload2(bf16x8*kf,lds_cptr kp,int j){ kf[2*j]=*(const __attribute__((address_space(3))) bf16x8*)(kp+j*2048); kf[2*j+1]=*(const __attribute__((address_space(3))) bf16x8*)(kp+j*2048+512); }
__device__ __forceinline__ s16x4 vtr(lds_cptr p){ return __builtin_bit_cast(s16x4,__builtin_amdgcn_ds_read_tr16_b64_v4i16((__attribute__((address_space(3))) v4i16_t*)p)); }
__device__ __forceinline__ float rowmax(const f32x16&p0,const f32x16&p1){
  float a=max3f(p0[0],p0[1],p1[0]),b=max3f(p0[2],p0[3],p1[1]);a=max3f(a,p1[2],p1[3]);
  #pragma unroll
  for(int r=4;r<16;r+=4){a=max3f(a,p0[r],p0[r+1]);b=max3f(b,p0[r+2],p0[r+3]);a=max3f(a,p1[r],p1[r+1]);b=max3f(b,p1[r+2],p1[r+3]);}
  const float m=max2f(a,b);
  auto rr=__builtin_amdgcn_permlane32_swap(__float_as_uint(m),__float_as_uint(m),false,false);
  return max2f(__uint_as_float(rr[0]),__uint_as_float(rr[1]));
}
__device__ __forceinline__ void pv(f32x16*o,int vb,bf16x8 pa0,bf16x8 pa1,bf16x8 pa2,bf16x8 pa3){
  #pragma unroll
  for(int d0=0;d0<2;++d0){s16x4 lo[4],hi[4];
    #pragma unroll
    for(int ks=0;ks<4;++ks){
      asm volatile("ds_read_b64_tr_b16 %0,%1 offset:%c2":"=&v"(lo[ks]):"v"(vb),"i"(d0*4096+ks*1024):"memory");
      asm volatile("ds_read_b64_tr_b16 %0,%1 offset:%c2":"=&v"(hi[ks]):"v"(vb),"i"(d0*4096+ks*1024+512):"memory");}
    asm volatile("s_waitcnt lgkmcnt(0)":::"memory");SBAR();
    #define PK(k) (bf16x8){lo[k][0],lo[k][1],lo[k][2],lo[k][3],hi[k][0],hi[k][1],hi[k][2],hi[k][3]}
    o[d0]=__builtin_amdgcn_mfma_f32_32x32x16_bf16(pa0,PK(0),o[d0],0,0,0);
    o[d0]=__builtin_amdgcn_mfma_f32_32x32x16_bf16(pa1,PK(1),o[d0],0,0,0);
    o[d0]=__builtin_amdgcn_mfma_f32_32x32x16_bf16(pa2,PK(2),o[d0],0,0,0);
    o[d0]=__builtin_amdgcn_mfma_f32_32x32x16_bf16(pa3,PK(3),o[d0],0,0,0);
    #undef PK
  }
}

#ifndef ATTN_STORE16
#define ATTN_STORE16(p,v) (*(u32x4*)(p)=(v))
#endif
typedef float f32x4v __attribute__((ext_vector_type(4)));
template<int THRL> __device__ __forceinline__ void attn_unit(int b,int h,int qb,const bf16*Q,const bf16*__restrict__ K,const bf16*__restrict__ V,bf16*O,const float*__restrict__ KBg,float qk2max,char*shm,int wave_id){
  const int wid=wave_id,lane=hw_lane(),tid=wid*64+lane,r32=lane&31,hi=lane>>5;
  const long rowbase=(long)b*SEQ; const int q0=qb*QB;
  const bf16*Qw=Q+(rowbase+q0+wid*QBLK)*DM+h*D;
  int ts=0;
  { const int NT0=(q0+QB)/KVBLK; const float lim=KBg[q0]-2.0f*__builtin_sqrtf(qk2max)-32.0f;
    const float kbl=(lane<NT0)?KBg[64*lane+63]:INFINITY; const unsigned long long bal=__ballot(kbl<lim);
    ts=(int)__builtin_popcountll(bal)&~1; if(ts>NT0-4)ts=NT0-4; ts=__builtin_amdgcn_readfirstlane(ts); }
  KBg+=ts*KVBLK;
  const bf16*Kh=K+(rowbase+(long)ts*KVBLK)*DM+h*D,*Vh=V+(rowbase+(long)ts*KVBLK)*DM+h*D;
  const unsigned lds0=(unsigned)(uintptr_t)shm;
  float*wsf=(float*)(shm+LDS_WS)+wid*64;
  const bf16*ksrc=Kh+(long)lane*DM+wid*8;
  const bf16*vsrc=Vh+(long)(16*(wid&3)+(lane>>2))*DM+(wid>>2)*32+(lane&3)*8;
  const unsigned kdst=lds0+LDS_K+wid*1024, vdst=lds0+LDS_V+wid*1024;
  #define DMA_K(t,slot) glds16(ksrc+(long)(t)*KVBLK*DM,(unsigned)__builtin_amdgcn_readfirstlane(kdst+(slot)))
  #define DMA_V(t,slot) glds16(vsrc+(long)(t)*KVBLK*DM,(unsigned)__builtin_amdgcn_readfirstlane(vdst+(slot)))
  const int vb0=(int)(lds0+LDS_V)+((lane>>4)&1)*32+(lane&3)*8+(4*hi+((lane&15)>>2))*64;
  const char*Kbase=shm+LDS_K; bf16x8 kf[8];
  const lds_cptr shm3=(lds_cptr)shm; const lds_cptr kp0=shm3+LDS_K+hi*1024+r32*16; const lds_cptr vp0=shm3+LDS_V+((lane>>4)&1)*32+(lane&3)*8+(4*hi+((lane&15)>>2))*64;
  const int NT=(q0+QB)/KVBLK-ts;
  const int nkb4=(q0+QB-ts*KVBLK)>>2; f32x4v kbt0=(f32x4v){0.f,0.f,0.f,0.f},kbt1=kbt0;
  { const f32x4v*src=(const f32x4v*)KBg; if(tid<nkb4)kbt0=src[tid]; if(tid+512<nkb4)kbt1=src[tid+512]; }
  DMA_K(0,0);DMA_V(0,0);DMA_K(1,SLOTB);
  bf16x8 qr[4];
  #pragma unroll
  for(int d0=0;d0<4;++d0)qr[d0]=*reinterpret_cast<const bf16x8*>(&Qw[(long)r32*DM+d0*16+hi*8]);
  { __attribute__((address_space(3))) f32x4v*kd=(__attribute__((address_space(3))) f32x4v*)((lds_cptr)shm+LDS_KB); if(tid<nkb4)kd[tid]=kbt0; if(tid+512<nkb4)kd[tid+512]=kbt1; }
  const lds_cptr kbp=(lds_cptr)shm+LDS_KB+hi*16;
  #define KBV(t,g8) (*(const __attribute__((address_space(3))) f32x4v*)(kbp+(t)*256+(g8)*32))
  float mhat=0.f,l_reg=0.f;f32x16 o[2];o[0]=f32x16{};o[1]=f32x16{};
  const int qrel=wid*QBLK+r32;
  #define CMASK(P0,P1,t) do{int jb_=(t)-(NT-4); if(jb_>=0)cmask(P0,P1,jb_,qrel,hi);}while(0)
  bool resc=false;
  #define START(P0,P1) do{ const float rm=rowmax(P0,P1); resc=false; \
    { const float dl=rm; mhat=fadd_s(mhat,dl); \
      _Pragma("unroll") for(int r=0;r<16;++r){P0[r]=fsub_s(P0[r],dl);P1[r]=fsub_s(P1[r],dl);} } \
    _Pragma("unroll") for(int r=0;r<16;++r)P0[r]=__builtin_amdgcn_exp2f(P0[r]); }while(0)
  #define RESC() do{ if(resc){ asm volatile("s_waitcnt lgkmcnt(0)":::"memory"); \
      _Pragma("unroll") for(int d_=0;d_<2;++d_) _Pragma("unroll") for(int r=0;r<16;++r)o[d_][r]*=wsf[crow(r,hi)]; } }while(0)
  f32x16 pA0,pA1,pB0,pB1;
  int sl_prev=0,sl_cur=0,sl_next=SLOTB;
  #define ROT() do{sl_prev=sl_cur;sl_cur=sl_next;sl_next=(sl_next==(NSLOT-1)*SLOTB)?0:sl_next+SLOTB;}while(0)
  DMA_K(2,2*SLOTB);
  WAIT_BAR(3);
  #define KBINIT(P0,P1,t) do{ _Pragma("unroll") for(int g_=0;g_<4;++g_){ const f32x4v a_=KBV(t,g_),b_=KBV(t,g_+4); \
      P0[4*g_]=a_[0]-mhat;P0[4*g_+1]=a_[1]-mhat;P0[4*g_+2]=a_[2]-mhat;P0[4*g_+3]=a_[3]-mhat; P1[4*g_]=b_[0]-mhat;P1[4*g_+1]=b_[1]-mhat;P1[4*g_+2]=b_[2]-mhat;P1[4*g_+3]=b_[3]-mhat; } }while(0)
  KBINIT(pA0,pA1,0);
  qkt(pA0,pA1,Kbase,qr,r32,hi);asm volatile("s_nop 15\n\ts_nop 7":"+v"(pA0),"+v"(pA1));CMASK(pA0,pA1,0);
  START(pA0,pA1);
  _Pragma("unroll") for(int r=0;r<16;++r)pA1[r]=__builtin_amdgcn_exp2f(pA1[r]);
  WAIT_BAR(0);
  DMA_K(3,0);DMA_V(1,SLOTB);
  ROT();
  kload8(kf,kp0+sl_cur);
  KBINIT(pB0,pB1,1);
  WAIT_BAR(2);
  s16x4 vlo[8],vhi[8]; u32x4 pw0,pw1,pw2,pw3;
  #define PKW(P,B) cvtpk_s(P[B],P[B+1])
  #define PAF(k) __builtin_bit_cast(bf16x8,pw##k)
  #define VFR(i) (bf16x8){vlo[i][0],vlo[i][1],vlo[i][2],vlo[i][3],vhi[i][0],vhi[i][1],vhi[i][2],vhi[i][3]}
  #define PIN(x) asm volatile("":"+v"(x))
  #define MX3(a,b,c) __builtin_fmaxf(__builtin_fmaxf((a),(b)),(c))
  #define GAPA(MF,A0,A1,A2,A3,W0,W1,PW) do{ MF; sacc+=A0; sacc+=A1; sacc+=A2; sacc+=A3; PIN(sacc); W0; W1; PIN(PW); SBAR(); }while(0)
  #define EX(v) __builtin_amdgcn_exp2f(v)
  #define GAPB(MF,X,B,Y,KU,KL,G8N,t) do{ if((G8N)>=0){KL=KBV((t)+1,(G8N)<0?0:(G8N));} MF; X[B]=EX(X[B]); X[B+1]=EX(X[B+1]); X[B+2]=EX(X[B+2]); X[B+3]=EX(X[B+3]); PIN(X); \
      Y[B]=KU[0]-mhat; Y[B+1]=KU[1]-mhat; Y[B+2]=KU[2]-mhat; Y[B+3]=KU[3]-mhat; PIN(Y); SBAR(); }while(0)
  #define VRD(i) do{ vlo[i]=vtr(vp_+(((i)>>2)*4096+((i)&3)*1024)); vhi[i]=vtr(vp_+(((i)>>2)*4096+((i)&3)*1024+512)); }while(0)
  #define KRD(G,j) do{ if(G){ kload2(kf,kp0+sl_next,j); SBAR(); } }while(0)
  #define STEP(C0,C1,P0,P1,t,GK,GV,GL) do{ SBAR(); \
    const lds_cptr vp_=vp0+sl_prev; \
    VRD(0); SBAR(); float sacc=(P0[0]+P0[1]); \
    GAPA(C0=__builtin_amdgcn_mfma_f32_32x32x16_bf16(kf[0],qr[0],C0,0,0,0), P0[2],P0[3],P0[4],P0[5],     pw0[0]=PKW(P0,0), pw0[1]=PKW(P0,2), pw0); \
    VRD(4); SBAR(); GAPA(C1=__builtin_amdgcn_mfma_f32_32x32x16_bf16(kf[1],qr[0],C1,0,0,0), P0[6],P0[7],P0[8],P0[9],     pw0[2]=PKW(P0,4), pw0[3]=PKW(P0,6), pw0); \
    VRD(1); SBAR(); GAPA(C0=__builtin_amdgcn_mfma_f32_32x32x16_bf16(kf[2],qr[1],C0,0,0,0),   P0[10],P0[11],P0[12],P0[13], pw1[0]=PKW(P0,8), pw1[1]=PKW(P0,10), pw1); \
    VRD(5); SBAR(); GAPA(C1=__builtin_amdgcn_mfma_f32_32x32x16_bf16(kf[3],qr[1],C1,0,0,0),   P0[14],P0[15],P1[0],P1[1],   pw1[2]=PKW(P0,12),pw1[3]=PKW(P0,14), pw1); \
    VRD(2); SBAR(); GAPA(C0=__builtin_amdgcn_mfma_f32_32x32x16_bf16(kf[4],qr[2],C0,0,0,0),   P1[2],P1[3],P1[4],P1[5],     pw2[0]=PKW(P1,0), pw2[1]=PKW(P1,2), pw2); \
    VRD(6); SBAR(); GAPA(C1=__builtin_amdgcn_mfma_f32_32x32x16_bf16(kf[5],qr[2],C1,0,0,0),   P1[6],P1[7],P1[8],P1[9],     pw2[2]=PKW(P1,4), pw2[3]=PKW(P1,6), pw2); \
    VRD(3); SBAR(); GAPA(C0=__builtin_amdgcn_mfma_f32_32x32x16_bf16(kf[6],qr[3],C0,0,0,0),   P1[10],P1[11],P1[12],P1[13], pw3[0]=PKW(P1,8), pw3[1]=PKW(P1,10), pw3); \
    VRD(7); SBAR(); GAPA(C1=__builtin_amdgcn_mfma_f32_32x32x16_bf16(kf[7],qr[3],C1,0,0,0),   P1[14],P1[15],0.f,0.f,       pw3[2]=PKW(P1,12),pw3[3]=PKW(P1,14), pw3); \
    l_reg+=sacc; \
    if(GK){DMA_K((t)+3,sl_cur);} if(GV){DMA_V((t)+1,sl_next);} \
    CMASK(C0,C1,t); \
    { float a=MX3(C0[0],C0[1],C1[0]),b=MX3(C0[2],C0[3],C1[1]); a=MX3(a,C1[2],C1[3]); \
      _Pragma("unroll") for(int r=4;r<16;r+=4){a=MX3(a,C0[r],C0[r+1]);b=MX3(b,C0[r+2],C0[r+3]);a=MX3(a,C1[r],C1[r+1]);b=MX3(b,C1[r+2],C1[r+3]);} \
      float rm=__builtin_fmaxf(a,b); { auto rr=__builtin_amdgcn_permlane32_swap(__float_as_uint(rm),__float_as_uint(rm),false,false); rm=__builtin_fmaxf(__uint_as_float(rr[0]),__uint_as_float(rr[1])); } \
      resc=false; \
      if(__builtin_expect(__any(rm>(float)THRL),0)){ const float dl=__builtin_fmaxf(rm,0.f); mhat+=dl; \
        _Pragma("unroll") for(int r=0;r<16;++r){C0[r]-=dl;C1[r]-=dl;} \
        const float f=__builtin_amdgcn_exp2f(-dl); l_reg*=f; if(hi==0)wsf[r32]=f; resc=true; } } \
    SBAR(); \
    f32x4v kq0_=KBV((t)+1,0),kq1_; \
    GAPB(o[0]=__builtin_amdgcn_mfma_f32_32x32x16_bf16(PAF(0),VFR(0),o[0],0,0,0), C0,0, P0,kq0_,kq1_,1,t); \
    GAPB(o[1]=__builtin_amdgcn_mfma_f32_32x32x16_bf16(PAF(0),VFR(4),o[1],0,0,0), C0,4, P0,kq1_,kq0_,2,t); \
    KRD(GL,0); GAPB(o[0]=__builtin_amdgcn_mfma_f32_32x32x16_bf16(PAF(1),VFR(1),o[0],0,0,0), C0,8, P0,kq0_,kq1_,3,t); \
    KRD(GL,1); GAPB(o[1]=__builtin_amdgcn_mfma_f32_32x32x16_bf16(PAF(1),VFR(5),o[1],0,0,0), C0,12, P0,kq1_,kq0_,4,t); \
    KRD(GL,2); GAPB(o[0]=__builtin_amdgcn_mfma_f32_32x32x16_bf16(PAF(2),VFR(2),o[0],0,0,0), C1,0, P1,kq0_,kq1_,5,t); \
    KRD(GL,3); GAPB(o[1]=__builtin_amdgcn_mfma_f32_32x32x16_bf16(PAF(2),VFR(6),o[1],0,0,0), C1,4, P1,kq1_,kq0_,6,t); \
    GAPB(o[0]=__builtin_amdgcn_mfma_f32_32x32x16_bf16(PAF(3),VFR(3),o[0],0,0,0), C1,8, P1,kq0_,kq1_,7,t); \
    GAPB(o[1]=__builtin_amdgcn_mfma_f32_32x32x16_bf16(PAF(3),VFR(7),o[1],0,0,0), C1,12, P1,kq1_,kq0_,-1,t); \
    }while(0)
  int t=1;
  #undef CMASK
  #define CMASK(P0,P1,t) do{}while(0)
  for(;t+5<NT;t+=2){
    STEP(pB0,pB1,pA0,pA1,t,true,true,true);     WAIT_BAR(2); RESC(); ROT();
    STEP(pA0,pA1,pB0,pB1,t+1,true,true,true);   WAIT_BAR(2); RESC(); ROT();
  }
  #undef CMASK
  #define CMASK(P0,P1,t) do{int jb_=(t)-(NT-4); if(jb_>=0)cmask(P0,P1,jb_,qrel,hi);}while(0)
  #define ENDW(tt) do{ if((tt)+3<NT){WAIT_BAR(2);} else if((tt)+2<NT){WAIT_BAR(1);} else {WAIT_BAR(0);} }while(0)
  for(;t+1<NT;t+=2){
    STEP(pB0,pB1,pA0,pA1,t,(t+3<NT),(t+1<NT),(t+1<NT));       ENDW(t);   RESC(); ROT();
    STEP(pA0,pA1,pB0,pB1,t+1,(t+4<NT),(t+2<NT),(t+2<NT));     ENDW(t+1); RESC(); ROT();
  }
  STEP(pB0,pB1,pA0,pA1,NT-1,false,false,false); RESC();
  { float sacc=pB0[0]+pB0[1]; _Pragma("unroll") for(int r=2;r<16;++r)sacc+=pB0[r]; _Pragma("unroll") for(int r=0;r<16;++r)sacc+=pB1[r]; l_reg+=sacc;
    pw0=(u32x4){PKW(pB0,0),PKW(pB0,2),PKW(pB0,4),PKW(pB0,6)};pw1=(u32x4){PKW(pB0,8),PKW(pB0,10),PKW(pB0,12),PKW(pB0,14)};pw2=(u32x4){PKW(pB1,0),PKW(pB1,2),PKW(pB1,4),PKW(pB1,6)};pw3=(u32x4){PKW(pB1,8),PKW(pB1,10),PKW(pB1,12),PKW(pB1,14)};
    SBAR(); pv(o,vb0+sl_cur,PAF(0),PAF(1),PAF(2),PAF(3)); }
  #undef PKW
  #undef PAF
  #undef VFR
  #undef PIN
  #undef MX3
  #undef GAPA
  #undef GAPB
  #undef EX
  #undef VRD
  #undef KRD
  #undef STEP
  #undef ENDW
  {auto rr=__builtin_amdgcn_permlane32_swap(__float_as_uint(l_reg),__float_as_uint(l_reg),false,false);l_reg=__uint_as_float(rr[0])+__uint_as_float(rr[1]);}
  if(hi==0)wsf[32+r32]=l_reg;asm volatile("s_waitcnt lgkmcnt(0)":::"memory");
  float rli[16];
  #pragma unroll
  for(int r=0;r<16;++r)rli[r]=__builtin_amdgcn_rcpf(wsf[32+crow(r,hi)]);
  bf16*Ow=O+(rowbase+q0+wid*QBLK)*DM+h*D;
  { bf16*stg=(bf16*)(shm+LDS_OST)+wid*2048;
    #pragma unroll
    for(int r=0;r<16;++r){const int orow=crow(r,hi);
      #pragma unroll
      for(int d0=0;d0<2;++d0)stg[orow*64+d0*32+r32]=__float2bfloat16(o[d0][r]*rli[r]);}
    asm volatile("s_waitcnt lgkmcnt(0)":::"memory");
    #pragma unroll
    for(int i=0;i<4;++i){const int row=i*8+(lane>>3),ch=lane&7; const u32x4 v=*(const u32x4*)(stg+row*64+ch*8); ATTN_STORE16(Ow+(long)row*DM+ch*8,v);} }
  asm volatile("s_waitcnt lgkmcnt(0)\n\ts_barrier":::"memory");
  #undef DMA_K
  #undef DMA_V
  #undef KBV
  #undef KBINIT
  #undef CMASK
  #undef START
  #undef RESC
  #undef ROT
}
constexpr int ATTN_LDS_BYTES=LDS_BYTES;
struct AttnTensors { const bf16* Q; const bf16* K; const bf16* V; bf16* O; const float* KB; const unsigned* QN2; const unsigned* KN2; };
struct AttnUnit { int bh; int qb; };
struct StaticOrder {
  int vcu, G, i0, i1;
  __device__ __forceinline__ explicit StaticOrder(int grid,int block):vcu((grid%8==0)?(block%8)*(grid/8)+block/8:block),G(grid),i0(0),i1(0x7fffffff){}
  __device__ __forceinline__ bool next(int i_,AttnUnit&u)const{ if(i_>=i1-i0)return false; const int i=i_+i0;
    if(G==256){ if(i>=4)return false; const int s=vcu&3; u.bh=vcu>>2; u.qb=(i==0)?s:(i==1)?7-s:(i==2)?8+s:15-s; return true; }
    const int L=i*G+vcu; if(L>=BATCH*NHEAD*NQB)return false; u.qb=NQB-1-L/(BATCH*NHEAD); u.bh=L%(BATCH*NHEAD); return true; }
  __device__ __forceinline__ void a_ready(const AttnUnit&)const{}
  __device__ __forceinline__ void done(const AttnUnit&)const{}
};
template<class Sched,int THRL=8> __device__ __forceinline__ void attn_phase(char*lds,const AttnTensors&T,const Sched&S,int wave_id){
  AttnUnit u;
  for(int i=0;S.next(i,u);++i){ S.a_ready(u); attn_unit<THRL>(u.bh/NHEAD,u.bh%NHEAD,u.qb,T.Q,T.K,T.V,T.O,T.KB+(size_t)u.bh*SEQ,__uint_as_float(T.QN2[u.bh*NQB+u.qb])*__uint_as_float(T.KN2[u.bh]),lds,wave_id); S.done(u); }
}
#undef SBAR
#undef WAIT_BAR
}
constexpr int NWAVES = 8;
#ifndef MK_N_LAUNCHES
#define MK_N_LAUNCHES 1
#endif
constexpr int PER_PHASE = 10;
constexpr int N_LAUNCHES = MK_N_LAUNCHES;

constexpr int BATCH = 4, SEQ = 4096, D = 1024, M = BATCH * SEQ;
constexpr int IN_COLS = 7184, NPROJ = 7168, FCOL0 = 5120;
constexpr int NE = 32, DFF = 1024, MAXTILES = 288, SLOTS = MAXTILES * 256;
constexpr int LRU_TS = 128, LRU_NSEG = SEQ / LRU_TS, LRU_UNITS = BATCH * 16 * LRU_NSEG;
constexpr float RMS_EPS = 1e-6f, LOG2E = 1.4426950408889634f;
constexpr float W8_SCALE = 127.0f * 32.0f / 4.0f, H8_SCALE = 127.0f / 4.0f, ACT8_SCALE = 127.0f / 8.0f, Y8_SCALE = 127.0f / 4.0f;

constexpr size_t MiB = 1u << 20;
constexpr size_t WS_CTL = 0, CTL_ZERO_BYTES = 128 * 1024;
constexpr size_t WS_WIN = 2 * MiB, WS_WLRU = 16 * MiB, WS_WFOX = 18 * MiB, WS_WO = 20 * MiB;
constexpr size_t WS_WG = 22 * MiB, WS_SP = 22 * MiB + 512 * 1024;
constexpr size_t WS_LOGF = 23 * MiB, WS_KB = 24 * MiB, WS_SEG = 25 * MiB, WS_ROUTE = 26 * MiB, WS_TOKMAP = 27 * MiB;
constexpr size_t WS_H2 = 960 * MiB;
constexpr size_t WS_H = 32 * MiB;
constexpr size_t WS_WGU = 64 * MiB, WS_WD = 192 * MiB;
constexpr size_t WS_PROJ = 256 * MiB, PROJ_STRIDE = 32 * MiB;
constexpr size_t WS_YLRU = 480 * MiB, WS_TMP = 512 * MiB, WS_MERGED = 544 * MiB, WS_X1 = 576 * MiB;
constexpr size_t WS_ACT = 640 * MiB, WS_Y = 784 * MiB, WS_YFOX = 928 * MiB, WS_END = 976 * MiB;
static_assert(WS_Y + (size_t)SLOTS * 1024 * 2 <= WS_YFOX && WS_ACT + (size_t)SLOTS * 1024 * 2 <= WS_Y, "d_ws map");
constexpr int CW_TMO = 0, CW_CODE = 1;
constexpr int CW_BAR = 4096;
constexpr int CW_CNT = 16384;
constexpr int CW_KN = 20480, CW_QN = 20544;                          static_assert((20544 + 64 * 16) * 4 <= 128 * 1024, "control words inside the memset region");
constexpr int CW_END_ = 0;

constexpr int RING_OFF = 0, RING_BYTES = 131072;
constexpr int LDSCTL_OFF = RING_BYTES, MISC_OFF = LDSCTL_OFF + 320, EXTRA_OFF = LDSCTL_OFF + 512;
constexpr int LDS_BYTES = 147456;
constexpr int EX_TILE_E = 0, EX_NCNT = 320, EX_TPRE = 448, EX_ROWS = 1024, EX_MAXU = 14;
static_assert(EXTRA_OFF + EX_ROWS + EX_MAXU * 1024 <= LDS_BYTES, "LDS map");

#define GAS __attribute__((address_space(1)))
#define LAS __attribute__((address_space(3)))
typedef unsigned short bf16;
typedef unsigned v4u __attribute__((ext_vector_type(4)));
typedef unsigned v2u __attribute__((ext_vector_type(2)));
typedef float f32x4 __attribute__((ext_vector_type(4)));
typedef float f32x2 __attribute__((ext_vector_type(2)));
typedef short bf16x8 __attribute__((ext_vector_type(8)));
typedef GAS unsigned gu32;
typedef GAS unsigned long long gu64;
#define RLX_AGENT __ATOMIC_RELAXED, __HIP_MEMORY_SCOPE_AGENT
#define LDS_WAIT() asm volatile("s_waitcnt lgkmcnt(0)" ::: "memory")
#define VM_WAIT() asm volatile("s_waitcnt vmcnt(0)" ::: "memory")
__device__ __forceinline__ unsigned pk2(float lo, float hi) { return pg8::cvt_pk_bf16(lo, hi); }
__device__ __forceinline__ float bflo(unsigned w) { return __uint_as_float(w << 16); }
__device__ __forceinline__ float bfhi(unsigned w) { return __uint_as_float(w & 0xffff0000u); }
__device__ __forceinline__ float sigm(float x) { return __builtin_amdgcn_rcpf(1.0f + __builtin_amdgcn_exp2f(-LOG2E * x)); }
__device__ __forceinline__ float gelu_tanh(float x) { const float u = 0.7978845608028654f * (x + 0.044715f * x * x * x); return x * sigm(2.0f * u); }

#define XB_TMO      128
#define XB_XCNT(j)  (256  + 64 * (j))
#define XB_XSUB(j)  (1280 + 64 * (j))
#define XB_XGEN(j)  (2304 + 64 * (j))
#define XB_TOP      3328
#define XB_TOPGEN   3392
#define XCD_BAR_WORDS 3456
#define XB_SPIN_CAP (1u << 18)

__device__ __forceinline__ unsigned xb_ld(unsigned* p)              { return __hip_atomic_load(p, __ATOMIC_RELAXED, __HIP_MEMORY_SCOPE_AGENT); }
__device__ __forceinline__ unsigned xb_add(unsigned* p, unsigned v) { return __hip_atomic_fetch_add(p, v, __ATOMIC_RELAXED, __HIP_MEMORY_SCOPE_AGENT); }
__device__ __forceinline__ unsigned xb_xcc_id() { return (unsigned)__builtin_amdgcn_s_getreg((3 << 11) | 20) & 0xFu; }
#define XB_SPIN(cond, bar) do { unsigned _sp = 0; while (cond) { __builtin_amdgcn_s_sleep(1); \
    if ((++_sp & 255u) == 0u) { if (xb_ld(&(bar)[XB_TMO])) break; if (_sp > XB_SPIN_CAP) { atomicAdd(&(bar)[XB_TMO], 1u); break; } } } } while (0)

struct XcdBarrier {
    unsigned* bar; unsigned x;
    volatile LAS unsigned* st;
};
__device__ __forceinline__ XcdBarrier xcd_barrier_post(unsigned* bar, volatile LAS unsigned* st) {
    XcdBarrier b; b.bar = bar; b.x = xb_xcc_id(); b.st = st;
    if (threadIdx.x == 0) (void)xb_add(&bar[XB_XCNT(b.x)], 1u);
    return b;
}
__device__ __forceinline__ void xcd_barrier_complete(unsigned* bar, unsigned x, unsigned& nloc, unsigned& nx) {
    const unsigned G = gridDim.x * gridDim.y * gridDim.z;
    unsigned sum, cnt, mine, sp = 0u;
    for (;;) {
        sum = 0u; cnt = 0u; mine = 0u;
#pragma unroll
        for (unsigned j = 0; j < 16; ++j) { const unsigned c = xb_ld(&bar[XB_XCNT(j)]); sum += c; cnt += (c > 0u) ? 1u : 0u; mine = (j == x) ? c : mine; }
        if (sum == G) break;
        __builtin_amdgcn_s_sleep(1);
        if ((++sp & 255u) == 0u) { if (xb_ld(&bar[XB_TMO])) break; if (sp > XB_SPIN_CAP) { atomicAdd(&bar[XB_TMO], 1u); break; } }
    }
    nloc = mine > 0u ? mine : 1u; nx = cnt > 0u ? cnt : 1u;
}
__device__ __forceinline__ void xcd_barrier(const XcdBarrier& b) {
    asm volatile("s_waitcnt vmcnt(0)" ::: "memory");
    __syncthreads();
    if (threadIdx.x == 0) {
        unsigned* bar = b.bar;
        __builtin_amdgcn_s_waitcnt(0);
        unsigned nloc = b.st[0], nx = b.st[1];
        if (nloc == 0u) { xcd_barrier_complete(bar, b.x, nloc, nx); b.st[0] = nloc; b.st[1] = nx; }
        const unsigned old = xb_add(&bar[XB_XSUB(b.x)], 1u);
        const unsigned gen = old / nloc;
        if (old + 1u == (gen + 1u) * nloc) {
            __builtin_amdgcn_fence(__ATOMIC_RELEASE, "agent");
            asm volatile("s_waitcnt vmcnt(0)" ::: "memory");
            const unsigned og = xb_add(&bar[XB_TOP], 1u);
            const unsigned tg = og / nx;
            if (og + 1u == (tg + 1u) * nx) xb_add(&bar[XB_TOPGEN], 1u);
            else XB_SPIN(xb_ld(&bar[XB_TOPGEN]) == tg, bar);
            __builtin_amdgcn_fence(__ATOMIC_ACQUIRE, "agent");
            xb_add(&bar[XB_XGEN(b.x)], 1u);
            asm volatile("s_waitcnt vmcnt(0)" ::: "memory");
        } else {
            XB_SPIN(xb_ld(&bar[XB_XGEN(b.x)]) == gen, bar);
            __builtin_amdgcn_fence(__ATOMIC_ACQUIRE, "agent");
            asm volatile("s_waitcnt vmcnt(0)" ::: "memory");
        }
    }
    __syncthreads();
}

struct Frame {
    LAS unsigned char* lds;
    volatile LAS unsigned* MISC;
    gu32* ctl;
    int wave;
    int vcu, G;
    const float* in[22];
    float* out;
    unsigned char* ws;
};
#define IN_X 0
#define IN_GMIX 1
#define IN_WIN 2
#define IN_CONVW 3
#define IN_CONVB 4
#define IN_WRG 5
#define IN_BRG 6
#define IN_WIG 7
#define IN_BIG 8
#define IN_LAMBDA 9
#define IN_BF 10
#define IN_WLRU 11
#define IN_WFOX 12
#define IN_WO 13
#define IN_GFFN 14
#define IN_WROUTER 15
#define IN_BROUTER 16
#define IN_WGU 17
#define IN_BGU 18
#define IN_WD 19
#define IN_BD 20
#define IN_GFINAL 21

__device__ __forceinline__ float wave_sum(float v) {
#pragma unroll
    for (int o = 1; o < 64; o <<= 1) v += __shfl_xor(v, o);
    return v;
}
__device__ __forceinline__ float wave_max(float v) {
#pragma unroll
    for (int o = 1; o < 64; o <<= 1) v = fmaxf(v, __shfl_xor(v, o));
    return v;
}
__device__ __forceinline__ float lane_sel(float a, float b, unsigned long long m) { float r; asm("v_cndmask_b32_e64 %0, %1, %2, %3" : "=v"(r) : "v"(a), "v"(b), "s"(m)); return r; }
template <int N> __device__ __forceinline__ void xreduce(float (&f)[N], int lane) {
    (void)lane;
    constexpr unsigned long long MASKS[6] = {0xFFFFFFFF00000000ull, 0xFFFF0000FFFF0000ull, 0xFF00FF00FF00FF00ull, 0xF0F0F0F0F0F0F0F0ull, 0xCCCCCCCCCCCCCCCCull, 0xAAAAAAAAAAAAAAAAull};
    int s = 32, k = 0;
#pragma unroll
    for (int half = N / 2; half >= 1; half >>= 1, s >>= 1, ++k) {
        const unsigned long long m = MASKS[k];
#pragma unroll
        for (int i = 0; i < half; ++i) { const float keep = lane_sel(f[i], f[i + half], m), send = lane_sel(f[i + half], f[i], m); f[i] = keep + __shfl_xor(send, s); }
    }
#pragma unroll
    for (int q = 0; q < 6; ++q) if ((32 >> q) <= s && (32 >> q) >= 1 && (32 >> q) < (64 / N) ) f[0] += __shfl_xor(f[0], 32 >> q);
}
#ifndef CV_LG
#define CV_LG 4
#endif
constexpr int CV_NL = 1 << CV_LG, CV_IK = 8 * (64 >> CV_LG), CV_IN = 4 << CV_LG, CV_KB = 1024 / CV_IK;
struct CvtItem { const float* src; unsigned char* dst; int ldw, K, k0, i8; };
__device__ __forceinline__ void cvt_load(const CvtItem& c, int lane, f32x4 (&v)[8]) {
#pragma unroll
    for (int i = 0; i < 8; ++i) v[i] = __builtin_nontemporal_load((const GAS f32x4*)(c.src + (size_t)(c.k0 + 8 * (lane >> CV_LG) + i) * c.ldw + 4 * (lane & (CV_NL - 1))));
}
__device__ __forceinline__ unsigned q8_low(float x, float scale) {
    const float lim = 127.0f / scale; const float c = __builtin_amdgcn_fmed3f(x, -lim, lim); return __float_as_uint(__builtin_fmaf(c, scale, 12582912.0f)); }
__device__ __forceinline__ unsigned lo4(unsigned a, unsigned b, unsigned c, unsigned d) {
    const unsigned ab = __builtin_amdgcn_perm(b, a, 0x0c0c0400u), cd = __builtin_amdgcn_perm(d, c, 0x0c0c0400u); return ab | (cd << 16); }
__device__ __forceinline__ void cvt_store(const CvtItem& c, int lane, const f32x4 (&v)[8]) {
    const int kg = lane >> CV_LG, ng = lane & (CV_NL - 1);
    if (c.i8) {
#pragma unroll
        for (int j = 0; j < 4; ++j) { unsigned q[8];
#pragma unroll
            for (int i = 0; i < 8; ++i) q[i] = q8_low(v[i][j], W8_SCALE);
            v2u o; o.x = lo4(q[0], q[1], q[2], q[3]); o.y = lo4(q[4], q[5], q[6], q[7]);
            *(GAS v2u*)(c.dst + (size_t)(4 * ng + j) * c.K + c.k0 + 8 * kg) = o; }
    } else {
#pragma unroll
        for (int j = 0; j < 4; ++j) { v4u o; o.x = pk2(v[0][j], v[1][j]); o.y = pk2(v[2][j], v[3][j]); o.z = pk2(v[4][j], v[5][j]); o.w = pk2(v[6][j], v[7][j]);
            *(GAS v4u*)(c.dst + ((size_t)(4 * ng + j) * c.K + c.k0 + 8 * kg) * 2) = o; }
    }
}
#define LANE_TID() const int lane_ = hw_lane(); const int tid_ = F.wave * 64 + lane_
__device__ __forceinline__ void p0_prologue(Frame& F) {
    LANE_TID();
    unsigned char* ws = F.ws;
    const int gw = F.vcu * NWAVES + F.wave, NGW = F.G * NWAVES;
    {
        constexpr int I_IN = (NPROJ / CV_IN) * CV_KB;
        CvtItem c0, c1; f32x4 v0[8], v1[8];
#define P0_DEC(c, it) do { const int cb = (it) / CV_KB, kb = (it) % CV_KB, drow = CV_IN * cb, scol = drow < FCOL0 ? drow : drow + 16; \
            c.src = F.in[IN_WIN] + scol; c.ldw = IN_COLS; c.K = D; c.k0 = CV_IK * kb; c.i8 = 1; c.dst = ws + WS_WIN + (size_t)drow * D; } while (0)
        int it = gw;
        if (it < I_IN) { P0_DEC(c0, it); cvt_load(c0, lane_, v0); }
        if (it + NGW < I_IN) { P0_DEC(c1, it + NGW); cvt_load(c1, lane_, v1); }
#pragma unroll 1
        for (; it < I_IN; it += 2 * NGW) {
            cvt_store(c0, lane_, v0); if (it + 2 * NGW < I_IN) { P0_DEC(c0, it + 2 * NGW); cvt_load(c0, lane_, v0); }
            if (it + NGW < I_IN) { cvt_store(c1, lane_, v1); if (it + 3 * NGW < I_IN) { P0_DEC(c1, it + 3 * NGW); cvt_load(c1, lane_, v1); } }
        }
#undef P0_DEC
    }
    {
        const int gt = F.vcu * (NWAVES * 64) + tid_, NGT = F.G * NWAVES * 64;
        bf16* WG = (bf16*)(ws + WS_WG); const float* const w_ig_p = F.in[IN_WIG]; const float* const w_rg_p = F.in[IN_WRG];
        for (int idx = gt; idx < 2 * 16 * 64 * 64; idx += NGT) { const int i = idx & 63, j = (idx >> 6) & 63, gate = (idx >> 12) & 1, blk = idx >> 13;
            const float w = (gate ? w_ig_p : w_rg_p)[(blk * 64 + i) * 64 + j];
            WG[idx] = (bf16)(pk2(w, 0.f) & 0xffffu); }
        float* SP = (float*)(ws + WS_SP);
        for (int c = gt; c < D; c += NGT) { const float z = -F.in[IN_LAMBDA][c]; const float sp = fmaxf(z, 0.f) + log1pf(expf(-fabsf(z))); SP[c] = 8.0f * sp * LOG2E; }
    }
    __syncthreads();
    {
        LAS float* WF = (LAS float*)(F.lds + RING_OFF);
        for (int idx = tid_; idx < 16 * D; idx += NWAVES * 64) { const int c = idx >> 4, hd = idx & 15; WF[hd * D + c] = F.in[IN_WIN][(size_t)c * IN_COLS + FCOL0 + hd] * F.in[IN_GMIX][c]; }
        __syncthreads();
        f32x4 gm[4];
#pragma unroll
        for (int j = 0; j < 4; ++j) gm[j] = *((const GAS f32x4*)F.in[IN_GMIX] + lane_ + 64 * j);
        const int hd = (lane_ >> 2) & 15; const float bfv = F.in[IN_BF][hd];
        bf16* H = (bf16*)(ws + WS_H); float* LOGF = (float*)(ws + WS_LOGF);
#pragma unroll 1
        for (int m = gw; m < M; m += NGW) {
            const GAS f32x4* xr = (const GAS f32x4*)(F.in[IN_X] + (size_t)m * D) + lane_;
            f32x4 v[4]; float s = 0.f;
#pragma unroll
            for (int j = 0; j < 4; ++j) { v[j] = xr[64 * j]; s += (v[j].x * v[j].x + v[j].y * v[j].y) + (v[j].z * v[j].z + v[j].w * v[j].w); }
            const float rstd = 1.0f / sqrtf(wave_sum(s) * (1.f / D) + RMS_EPS);
            GAS unsigned* o8 = (GAS unsigned*)((unsigned char*)H + (size_t)m * D) + lane_;
#pragma unroll
            for (int j = 0; j < 4; ++j) { const f32x4 y = v[j] * (rstd * H8_SCALE) * gm[j]; o8[64 * j] = pg8::pk4_i8(y.x, y.y, y.z, y.w); }
            float f[16];
#pragma unroll
            for (int h = 0; h < 16; ++h) { float a = 0.f; f32x2 a2 = (f32x2){0.f, 0.f};
#pragma unroll
                for (int j = 0; j < 4; ++j) { const f32x4 w = *((const LAS f32x4*)(WF + h * D) + lane_ + 64 * j);
                    a2 = __builtin_elementwise_fma((f32x2){v[j].x, v[j].y}, (f32x2){w.x, w.y}, a2); a2 = __builtin_elementwise_fma((f32x2){v[j].z, v[j].w}, (f32x2){w.z, w.w}, a2); }
                a = a2.x + a2.y; f[h] = a; if ((h & 3) == 3) __builtin_amdgcn_sched_barrier(0); }
            xreduce<16>(f, lane_);
            if ((lane_ & 3) == 0) { const float z = f[0] * rstd + bfv;
                const float lf = fminf(z, 0.f) - log1pf(expf(-fabsf(z)));
                const int b = m / SEQ, t = m % SEQ; LOGF[((size_t)(b * 16 + hd)) * SEQ + t] = lf; }
        }
    }
}

__device__ __forceinline__ void lru_decode(int u, int& b, int& blk, int& seg) { seg = u >> 6; b = (u >> 4) & 3; blk = u & 15; }
struct LruConst { f32x4 brg[4], big[4], spv[4]; float cw[4][8], cb[8]; };
constexpr int LRU_XR = 0, LRU_XC = 16896, LRU_AA = 35328, LRU_BB = 70144, LRU_SM = 104960, LRU_WG = 109056;
__device__ __forceinline__ void lru_load_const(Frame& F, int blk, int tid, int lane, LruConst& C) {
    const int fr = lane & 15, fq = lane >> 4, c0 = blk * 64, ch = tid & 7;
    const bf16* WG = (const bf16*)(F.ws + WS_WG) + (size_t)blk * 2 * 64 * 64; const float* SP = (const float*)(F.ws + WS_SP);
#pragma unroll
    for (int k = 0; k < 2; ++k) { const int it = tid + 512 * k, l = it & 63, fg = it >> 6, kt = fg & 1, nt = (fg >> 1) & 3, gt = fg >> 3;
        *(LAS bf16x8*)(F.lds + RING_OFF + LRU_WG + it * 16) = *(const GAS bf16x8*)(WG + ((gt * 64 + 16 * nt + (l & 15)) * 64 + 32 * kt + 8 * (l >> 4))); }
    (void)fr; (void)fq;
#pragma unroll
    for (int nt = 0; nt < 4; ++nt) { const int j0 = 16 * nt + 4 * fq;
        C.brg[nt] = *(const GAS f32x4*)(F.in[IN_BRG] + c0 + j0); C.big[nt] = *(const GAS f32x4*)(F.in[IN_BIG] + c0 + j0); C.spv[nt] = *(const GAS f32x4*)(SP + c0 + j0); }
#pragma unroll
    for (int k = 0; k < 4; ++k) { const f32x4 a = *(const GAS f32x4*)(F.in[IN_CONVW] + k * D + c0 + ch * 8), bq = *(const GAS f32x4*)(F.in[IN_CONVW] + k * D + c0 + ch * 8 + 4);
        C.cw[k][0] = a.x; C.cw[k][1] = a.y; C.cw[k][2] = a.z; C.cw[k][3] = a.w; C.cw[k][4] = bq.x; C.cw[k][5] = bq.y; C.cw[k][6] = bq.z; C.cw[k][7] = bq.w; }
    { const f32x4 a = *(const GAS f32x4*)(F.in[IN_CONVB] + c0 + ch * 8), bq = *(const GAS f32x4*)(F.in[IN_CONVB] + c0 + ch * 8 + 4);
        C.cb[0] = a.x; C.cb[1] = a.y; C.cb[2] = a.z; C.cb[3] = a.w; C.cb[4] = bq.x; C.cb[5] = bq.y; C.cb[6] = bq.z; C.cb[7] = bq.w; }
}
__device__ __forceinline__ void lru_raw_load(Frame& F, int b, int blk, int seg, int tid, v4u (&raw)[3]) {
    const bf16* LX = (const bf16*)(F.ws + WS_PROJ); const long row0 = (long)b * SEQ + seg * LRU_TS; const int c0 = blk * 64;
#pragma unroll
    for (int k = 0; k < 3; ++k) { const int idx = tid + 512 * k, r = idx >> 3, ch = idx & 7; raw[k] = (v4u){0u, 0u, 0u, 0u};
        if (idx < 131 * 8 && (seg > 0 || r >= 3)) raw[k] = *(const GAS v4u*)(LX + (row0 + r - 3) * D + c0 + ch * 8); }
}
__device__ __forceinline__ void lru_raw_store(Frame& F, int tid, const v4u (&raw)[3]) {
    LAS unsigned char* L = F.lds + RING_OFF;
#pragma unroll
    for (int k = 0; k < 3; ++k) { const int idx = tid + 512 * k, r = idx >> 3, ch = idx & 7; if (idx < 131 * 8) *(LAS v4u*)(L + LRU_XR + r * 128 + ch * 16) = raw[k]; }
}
template <int PASS>
__device__ __forceinline__ void lru_run(Frame& F) {
    LAS unsigned char* L = F.lds + RING_OFF;
    const int lane = hw_lane(), w = F.wave, tid = w * 64 + lane, fr = lane & 15, fq = lane >> 4;
    const bf16* LG = (const bf16*)(F.ws + WS_PROJ + PROJ_STRIDE);
    LAS float* HIN = (LAS float*)(F.lds + EXTRA_OFF);
    int nun = 0; for (int u = F.vcu; u < LRU_UNITS; u += F.G) ++nun;
    if (nun == 0) return;
    if (nun > 56) nun = 56;
    if (PASS == 1) {
        const f32x2* SEGp = (const f32x2*)(F.ws + WS_SEG);
        for (int i = tid >> 6; i < nun; i += NWAVES) { const int u = i * F.G + F.vcu, c = tid & 63; int b, blk, seg; lru_decode(u, b, blk, seg); float Hc = 0.f;
            const GAS f32x2* sp = (const GAS f32x2*)SEGp + (size_t)(b * LRU_NSEG) * D + blk * 64 + c;
            for (int s0 = 0; s0 < seg; s0 += 8) { f32x2 v[8];
#pragma unroll
                for (int k = 0; k < 8; ++k) { const int s = s0 + k; v[k] = sp[(size_t)(s < seg ? s : 0) * D]; if (s >= seg) v[k] = (f32x2){1.f, 0.f}; }
#pragma unroll
                for (int k = 0; k < 8; ++k) Hc = v[k].x * Hc + v[k].y; }
            HIN[i * 64 + c] = Hc; }
    }
    LruConst C; int cur_blk = -1;
    { int b, blk, seg; lru_decode(F.vcu, b, blk, seg); v4u raw[3]; lru_raw_load(F, b, blk, seg, tid, raw); lru_raw_store(F, tid, raw); }
#pragma unroll 1
    for (int i = 0; i < nun; ++i) {
        const int u = i * F.G + F.vcu; int b, blk, seg; lru_decode(u, b, blk, seg);
        const long row0 = (long)b * SEQ + seg * LRU_TS; const int c0 = blk * 64;
        if (blk != cur_blk) { lru_load_const(F, blk, tid, lane, C); cur_blk = blk; }
        v4u nraw[3];
        if (i + 1 < nun) { int b2, blk2, seg2; lru_decode(u + F.G, b2, blk2, seg2); lru_raw_load(F, b2, blk2, seg2, tid, nraw); }
        v4u gate8[2];
        if (PASS == 1) {
#pragma unroll
            for (int k = 0; k < 2; ++k) { const int t = (tid >> 3) + 64 * k, ch = tid & 7; gate8[k] = *(const GAS v4u*)(LG + (row0 + t) * D + c0 + ch * 8); }
        }
        __syncthreads();
        { const int ch = tid & 7;
#pragma unroll
            for (int k2 = 0; k2 < 2; ++k2) { const int t = (tid >> 3) + 64 * k2; float a[8];
#pragma unroll
                for (int e = 0; e < 8; ++e) a[e] = C.cb[e];
#pragma unroll
                for (int k = 0; k < 4; ++k) { const v4u xv = *(const LAS v4u*)(L + LRU_XR + (t + k) * 128 + ch * 16);
                    a[0] += C.cw[k][0] * bflo(xv.x); a[1] += C.cw[k][1] * bfhi(xv.x); a[2] += C.cw[k][2] * bflo(xv.y); a[3] += C.cw[k][3] * bfhi(xv.y);
                    a[4] += C.cw[k][4] * bflo(xv.z); a[5] += C.cw[k][5] * bfhi(xv.z); a[6] += C.cw[k][6] * bflo(xv.w); a[7] += C.cw[k][7] * bfhi(xv.w); }
                v4u o; o.x = pk2(a[0], a[1]); o.y = pk2(a[2], a[3]); o.z = pk2(a[4], a[5]); o.w = pk2(a[6], a[7]);
                *(LAS v4u*)(L + LRU_XC + t * 144 + ch * 16) = o; }
        }
        __syncthreads();
        { bf16x8 af[2];
#pragma unroll
            for (int kt = 0; kt < 2; ++kt) af[kt] = *(const LAS bf16x8*)(L + LRU_XC + (16 * w + fr) * 144 + (32 * kt + 8 * fq) * 2);
#pragma unroll
            for (int nt = 0; nt < 4; ++nt) { f32x4 gr = (f32x4){0.f, 0.f, 0.f, 0.f}, gi = (f32x4){0.f, 0.f, 0.f, 0.f};
#pragma unroll
                for (int kt = 0; kt < 2; ++kt) { const bf16x8 wr_ = *(const LAS bf16x8*)(L + LRU_WG + ((nt * 2 + kt) * 64 + lane) * 16), wi_ = *(const LAS bf16x8*)(L + LRU_WG + (((4 + nt) * 2 + kt) * 64 + lane) * 16);
                    gr = __builtin_amdgcn_mfma_f32_16x16x32_bf16(wr_, af[kt], gr, 0, 0, 0); gi = __builtin_amdgcn_mfma_f32_16x16x32_bf16(wi_, af[kt], gi, 0, 0, 0); }
                const int j0 = 16 * nt + 4 * fq;
                const v2u xw = *(const LAS v2u*)(L + LRU_XC + (16 * w + fr) * 144 + j0 * 2);
                const float xs[4] = {bflo(xw.x), bfhi(xw.x), bflo(xw.y), bfhi(xw.y)};
                f32x4 av, bv;
#pragma unroll
                for (int e = 0; e < 4; ++e) { const float rt = sigm(gr[e] + C.brg[nt][e]), it = sigm(gi[e] + C.big[nt][e]);
                    const float a = __builtin_amdgcn_exp2f(-rt * C.spv[nt][e]); const float mult = __builtin_amdgcn_sqrtf(fmaxf(1.0f - a * a, 0.f));
                    av[e] = a; bv[e] = mult * it * xs[e]; }
                *(LAS f32x4*)(L + LRU_AA + ((16 * w + fr) * 68 + j0) * 4) = av; *(LAS f32x4*)(L + LRU_BB + ((16 * w + fr) * 68 + j0) * 4) = bv; }
        }
        __syncthreads();
        const LAS float* Af = (const LAS float*)(L + LRU_AA); LAS float* Bf = (LAS float*)(L + LRU_BB);
        { float Aw = 1.f, Bw = 0.f;
#pragma unroll
            for (int s = 0; s < 16; ++s) { const int t = 16 * w + s; const float a = Af[t * 68 + lane], bb = Bf[t * 68 + lane]; Bw = a * Bw + bb; Aw *= a; }
            *(LAS f32x2*)(L + LRU_SM + (w * 64 + lane) * 8) = (f32x2){Aw, Bw}; }
        __syncthreads();
        if (PASS == 0) {
            if (w == 0) { float A = 1.f, Bq = 0.f;
#pragma unroll
                for (int ww = 0; ww < 8; ++ww) { const f32x2 v = *(const LAS f32x2*)(L + LRU_SM + (ww * 64 + lane) * 8); Bq = v.x * Bq + v.y; A *= v.x; }
                *(GAS f32x2*)((float*)(F.ws + WS_SEG) + ((size_t)(b * LRU_NSEG + seg) * D + c0 + lane) * 2) = (f32x2){A, Bq}; }
        } else {
            float Hc = HIN[i * 64 + lane];
#pragma unroll
            for (int ww = 0; ww < 7; ++ww) if (ww < w) { const f32x2 v = *(const LAS f32x2*)(L + LRU_SM + (ww * 64 + lane) * 8); Hc = v.x * Hc + v.y; }
#pragma unroll
            for (int s = 0; s < 16; ++s) { const int t = 16 * w + s; const float a = Af[t * 68 + lane], bb = Bf[t * 68 + lane]; Hc = a * Hc + bb; Bf[t * 68 + lane] = Hc; }
            __syncthreads();
            bf16* YL = (bf16*)(F.ws + WS_YLRU);
#pragma unroll
            for (int k = 0; k < 2; ++k) { const int t = (tid >> 3) + 64 * k, ch = tid & 7;
                const f32x4 h0 = *(const LAS f32x4*)(L + LRU_BB + (t * 68 + ch * 8) * 4), h1 = *(const LAS f32x4*)(L + LRU_BB + (t * 68 + ch * 8 + 4) * 4); const v4u g = gate8[k];
                v4u o; o.x = pk2(h0.x * gelu_tanh(bflo(g.x)), h0.y * gelu_tanh(bfhi(g.x))); o.y = pk2(h0.z * gelu_tanh(bflo(g.y)), h0.w * gelu_tanh(bfhi(g.y)));
                o.z = pk2(h1.x * gelu_tanh(bflo(g.z)), h1.y * gelu_tanh(bfhi(g.z))); o.w = pk2(h1.z * gelu_tanh(bflo(g.w)), h1.w * gelu_tanh(bfhi(g.w)));
                *(GAS v4u*)(YL + (row0 + t) * D + c0 + ch * 8) = o; }
        }
        if (i + 1 < nun) lru_raw_store(F, tid, nraw);
    }
    __syncthreads();
}

__device__ __forceinline__ void p2_phase(Frame& F) {
    LANE_TID();
    const int gw = F.vcu * NWAVES + F.wave, NGW = F.G * NWAVES;
    for (int bh = gw; bh < BATCH * 16; bh += NGW) {
        const float* src = (const float*)(F.ws + WS_LOGF) + (size_t)bh * SEQ + 64 * lane_; float* dst = (float*)(F.ws + WS_KB) + (size_t)bh * SEQ + 64 * lane_;
        f32x4 v[16]; float tot = 0.f;
#pragma unroll
        for (int i = 0; i < 16; ++i) { v[i] = *((const GAS f32x4*)src + i); tot += (v[i].x + v[i].y) + (v[i].z + v[i].w); }
        float incl = tot;
#pragma unroll
        for (int o = 1; o < 64; o <<= 1) { const float t = __shfl_up(incl, o); if (lane_ >= o) incl += t; }
        float run = incl - tot;
#pragma unroll
        for (int i = 0; i < 16; ++i) { f32x4 o; run += v[i].x; o.x = -LOG2E * run; run += v[i].y; o.y = -LOG2E * run; run += v[i].z; o.z = -LOG2E * run; run += v[i].w; o.w = -LOG2E * run;
            *((GAS f32x4*)dst + i) = o; }
    }
    {
        LAS unsigned* nrm = (LAS unsigned*)(F.lds + EXTRA_OFF);
        const bf16* Qp = (const bf16*)(F.ws + WS_PROJ + 2 * PROJ_STRIDE); const bf16* Kp = (const bf16*)(F.ws + WS_PROJ + 3 * PROJ_STRIDE);
        for (int chunk = F.vcu; chunk < M / 64; chunk += F.G) {
            if (tid_ < 32) nrm[tid_] = 0u;
            __syncthreads();
            float qm[2] = {0.f, 0.f}, km[2] = {0.f, 0.f};
#pragma unroll
            for (int r0 = 0; r0 < 8; r0 += 4) { v4u qv[4][2], kv[4][2];
#pragma unroll
                for (int r = 0; r < 4; ++r)
#pragma unroll
                    for (int hf = 0; hf < 2; ++hf) { const size_t off = (size_t)(chunk * 64 + F.wave * 8 + r0 + r) * D + hf * 512 + lane_ * 8; qv[r][hf] = *(const GAS v4u*)(Qp + off); kv[r][hf] = *(const GAS v4u*)(Kp + off); }
#pragma unroll
                for (int r = 0; r < 4; ++r)
#pragma unroll
                    for (int hf = 0; hf < 2; ++hf) { float sq = 0.f, sk = 0.f;
#pragma unroll
                        for (int e = 0; e < 4; ++e) { const float a = bflo(qv[r][hf][e]), b2 = bfhi(qv[r][hf][e]), c = bflo(kv[r][hf][e]), d = bfhi(kv[r][hf][e]); sq += a * a + b2 * b2; sk += c * c + d * d; }
                        sq += __shfl_xor(sq, 1); sq += __shfl_xor(sq, 2); sq += __shfl_xor(sq, 4); sk += __shfl_xor(sk, 1); sk += __shfl_xor(sk, 2); sk += __shfl_xor(sk, 4);
                        qm[hf] = fmaxf(qm[hf], sq); km[hf] = fmaxf(km[hf], sk); } }
            if ((lane_ & 7) == 0) {
#pragma unroll
                for (int hf = 0; hf < 2; ++hf) { const int h = hf * 8 + (lane_ >> 3);
                    __hip_atomic_fetch_max(nrm + h, __float_as_uint(qm[hf]), __ATOMIC_RELAXED, __HIP_MEMORY_SCOPE_WORKGROUP); __hip_atomic_fetch_max(nrm + 16 + h, __float_as_uint(km[hf]), __ATOMIC_RELAXED, __HIP_MEMORY_SCOPE_WORKGROUP); } }
            __syncthreads();
            if (tid_ < 32) { const int b = chunk / (SEQ / 64), qb = (chunk % (SEQ / 64)) / 4, h = tid_ & 15; const unsigned v = nrm[tid_];
                if (tid_ < 16) __hip_atomic_fetch_max(F.ctl + CW_QN + (b * 16 + h) * 16 + qb, v, RLX_AGENT); else __hip_atomic_fetch_max(F.ctl + CW_KN + b * 16 + h, v, RLX_AGENT); }
            __syncthreads();
        }
    }
    lru_run<0>(F);
}
__device__ __forceinline__ void p3_lru(Frame& F) { lru_run<1>(F); }

constexpr int P6_WRB = 0, P6_AT = 65536, P6_LOG = 65536 + 32768;
__device__ __forceinline__ void p6_route(Frame& F) {
    LANE_TID();
    LAS unsigned char* L = F.lds + RING_OFF;
    LAS unsigned* lcnt = (LAS unsigned*)(F.lds + EXTRA_OFF);
    LAS unsigned* gbase = lcnt + 32;
    LAS unsigned* stash = lcnt + 64;
    LAS float* rstd_t = (LAS float*)(lcnt + 64 + 768);
    LAS f32x2* sel = (LAS f32x2*)(lcnt + 64 + 768 + 64);
    {
        f32x4 wv[16]; float gv[16];
#pragma unroll
        for (int q = 0; q < 16; ++q) { const int i4 = tid_ + 512 * q; wv[q] = *((const GAS f32x4*)F.in[IN_WROUTER] + i4); gv[q] = F.in[IN_GFFN][i4 >> 3]; }
#pragma unroll
        for (int q = 0; q < 16; ++q) { const int i4 = tid_ + 512 * q, k = i4 >> 3, e0 = (i4 & 7) * 4, s = k >> 4, kh = (k >> 3) & 1, i = k & 7;
            LAS unsigned short* d = (LAS unsigned short*)(L + P6_WRB + (s * 64 + kh * 32 + e0) * 16 + i * 2);
            d[0] = (unsigned short)(pk2(wv[q].x * gv[q], 0.f) & 0xffffu); d[8] = (unsigned short)(pk2(wv[q].y * gv[q], 0.f) & 0xffffu);
            d[16] = (unsigned short)(pk2(wv[q].z * gv[q], 0.f) & 0xffffu); d[24] = (unsigned short)(pk2(wv[q].w * gv[q], 0.f) & 0xffffu); }
    }
    f32x4 gm[4];
#pragma unroll
    for (int j = 0; j < 4; ++j) gm[j] = *((const GAS f32x4*)F.in[IN_GFFN] + lane_ + 64 * j);
    const float* X1 = F.in[IN_X]; const bf16* DX = (const bf16*)(F.ws + WS_X1); unsigned char* H2 = (unsigned char*)(F.ws + WS_H2);
    unsigned* TOKMAP = (unsigned*)(F.ws + WS_TOKMAP); v4u* ROUTE = (v4u*)(F.ws + WS_ROUTE);
    typedef float f32x16 __attribute__((ext_vector_type(16)));
    for (int chunk = F.vcu; chunk < M / 64; chunk += F.G) {
        if (tid_ < 32) lcnt[tid_] = 0u;
        f32x4 v[4][4];
#pragma unroll
        for (int i = 0; i < 4; ++i)
#pragma unroll
            for (int j = 0; j < 4; ++j) { const size_t ro = (size_t)(chunk * 64 + 4 * F.wave + i) * D; const v2u dw = *((const GAS v2u*)(DX + ro) + lane_ + 64 * j);
                v[i][j] = *((const GAS f32x4*)(X1 + ro) + lane_ + 64 * j) + (f32x4){bflo(dw.x), bfhi(dw.x), bflo(dw.y), bfhi(dw.y)}; }
#pragma unroll 1
        for (int half = 0; half < 2; ++half) {
            {
#pragma unroll
              for (int i = 0; i < 4; ++i) { const int r = 4 * F.wave + i, m = chunk * 64 + half * 32 + r; float s = 0.f;
#pragma unroll
                  for (int j = 0; j < 4; ++j) s += (v[i][j].x * v[i][j].x + v[i][j].y * v[i][j].y) + (v[i][j].z * v[i][j].z + v[i][j].w * v[i][j].w);
                  const float rstd = 1.0f / sqrtf(wave_sum(s) * (1.f / D) + RMS_EPS);
                  if (lane_ == 0) rstd_t[half * 32 + r] = rstd;
                  GAS unsigned* o8 = (GAS unsigned*)(H2 + (size_t)m * D) + lane_;
#pragma unroll
                  for (int j = 0; j < 4; ++j) { const f32x4 y = v[i][j] * (rstd * H8_SCALE) * gm[j]; o8[64 * j] = pg8::pk4_i8(y.x, y.y, y.z, y.w);
                      const int c = (lane_ >> 1) + 32 * j, pc = (c & ~15) | ((c ^ r) & 15); v2u w; w.x = pk2(v[i][j].x, v[i][j].y); w.y = pk2(v[i][j].z, v[i][j].w);
                      *(LAS v2u*)(L + P6_AT + r * 2048 + pc * 16 + (lane_ & 1) * 8) = w; } }
              if (half == 0) {
#pragma unroll
                  for (int i = 0; i < 4; ++i)
#pragma unroll
                      for (int j = 0; j < 4; ++j) { const size_t ro = (size_t)(chunk * 64 + 32 + 4 * F.wave + i) * D; const v2u dw = *((const GAS v2u*)(DX + ro) + lane_ + 64 * j);
                          v[i][j] = *((const GAS f32x4*)(X1 + ro) + lane_ + 64 * j) + (f32x4){bflo(dw.x), bfhi(dw.x), bflo(dw.y), bfhi(dw.y)}; } } }
            __syncthreads();
            f32x16 acc = {};
            { const int r = lane_ & 31, kh = lane_ >> 5;
#pragma unroll
              for (int q = 0; q < 8; ++q) { const int s = 8 * F.wave + q, c = 2 * s + kh, pc = (c & ~15) | ((c ^ r) & 15);
                  const bf16x8 a = *(const LAS bf16x8*)(L + P6_AT + r * 2048 + pc * 16), b = *(const LAS bf16x8*)(L + P6_WRB + (s * 64 + lane_) * 16);
                  acc = __builtin_amdgcn_mfma_f32_32x32x16_bf16(a, b, acc, 0, 0, 0); } }
            __syncthreads();
            { LAS float* P = (LAS float*)(L + P6_AT) + F.wave * 1024;
#pragma unroll
              for (int rg = 0; rg < 16; ++rg) P[((rg & 3) + 8 * (rg >> 2) + 4 * (lane_ >> 5)) * 32 + (lane_ & 31)] = acc[rg]; }
            __syncthreads();
            { const LAS float* P = (const LAS float*)(L + P6_AT); LAS float* LG = (LAS float*)(L + P6_LOG);
#pragma unroll
              for (int k = 0; k < 2; ++k) { const int idx = tid_ + 512 * k; float s = 0.f;
#pragma unroll
                  for (int w = 0; w < 8; ++w) s += P[w * 1024 + idx];
                  LG[idx] = s * rstd_t[half * 32 + (idx >> 5)] + F.in[IN_BROUTER][idx & 31]; } }
            __syncthreads();
            { const LAS float* LG = (const LAS float*)(L + P6_LOG);
#pragma unroll
              for (int k = 0; k < 2; ++k) { const int idx = tid_ + 512 * k, i = idx >> 5, j = idx & 31; const float v = LG[idx]; int rank = 0;
#pragma unroll
                  for (int q = 0; q < 8; ++q) { const f32x4 o = *(const LAS f32x4*)(LG + i * 32 + 4 * q);
                      rank += (o.x > v || (o.x == v && 4 * q + 0 < j)) ? 1 : 0; rank += (o.y > v || (o.y == v && 4 * q + 1 < j)) ? 1 : 0;
                      rank += (o.z > v || (o.z == v && 4 * q + 2 < j)) ? 1 : 0; rank += (o.w > v || (o.w == v && 4 * q + 3 < j)) ? 1 : 0; }
                  if (rank < 4) sel[(half * 32 + i) * 4 + rank] = (f32x2){__uint_as_float((unsigned)j), v}; } }
            __syncthreads();
            if (tid_ < 128) { const int rl = half * 32 + (tid_ >> 2), k = tid_ & 3; const f32x2 s0 = sel[rl * 4 + 0], s1 = sel[rl * 4 + 1], s2 = sel[rl * 4 + 2], s3 = sel[rl * 4 + 3];
                const float p1 = __expf(s1.y - s0.y), p2 = __expf(s2.y - s0.y), p3 = __expf(s3.y - s0.y), inv = 1.0f / (1.0f + p1 + p2 + p3);
                const unsigned e = __float_as_uint(k == 0 ? s0.x : k == 1 ? s1.x : k == 2 ? s2.x : s3.x) & 31u; const float wv = (k == 0 ? 1.0f : k == 1 ? p1 : k == 2 ? p2 : p3) * inv;
                const unsigned lp = __hip_atomic_fetch_add(lcnt + e, 1u, __ATOMIC_RELAXED, __HIP_MEMORY_SCOPE_WORKGROUP);
                LAS unsigned* st = stash + (rl * 4 + k) * 3; st[0] = e; st[1] = lp; st[2] = __float_as_uint(wv); }
            __syncthreads();
        }
        const int t2 = F.wave * 64 + hw_lane();
        if (t2 < 32) { const unsigned n = lcnt[t2]; gbase[t2] = n ? __hip_atomic_fetch_add(F.ctl + CW_CNT + 64 * t2, n, RLX_AGENT) : 0u; }
        __syncthreads();
        if (t2 < 256) { const LAS unsigned* st = stash + t2 * 3; const unsigned e = st[0], pos = gbase[e] + st[1]; const int m = chunk * 64 + (t2 >> 2);
            TOKMAP[(size_t)e * M + pos] = (unsigned)m; ROUTE[(size_t)m * 4 + (t2 & 3)] = (v4u){e, pos, st[2], 0u}; }
        __syncthreads();
    }
}
__device__ __forceinline__ int moe_tables(Frame& F) {
    LANE_TID();
    LAS unsigned char* EX = F.lds + EXTRA_OFF;
    LAS unsigned char* tile_e = EX + EX_TILE_E; LAS unsigned* ncnt = (LAS unsigned*)(EX + EX_NCNT); LAS unsigned* tpre = (LAS unsigned*)(EX + EX_TPRE);
    if (tid_ < 32) { unsigned n = __hip_atomic_load(F.ctl + CW_CNT + 64 * tid_, RLX_AGENT); if (n > (unsigned)M) n = (unsigned)M; ncnt[tid_] = n; }
    __syncthreads();
    if (tid_ == 0) { unsigned a = 0; for (int e = 0; e < 32; ++e) { tpre[e] = a; a += (ncnt[e] + 255u) >> 8; if (a > (unsigned)MAXTILES) a = (unsigned)MAXTILES; } tpre[32] = a; }
    __syncthreads();
    const int TT = (int)tpre[32];
    for (int t = tid_; t < TT; t += NWAVES * 64) { int e = 0;
#pragma unroll 1
        for (int k = 1; k < 32; ++k) if ((int)tpre[k] <= t) e = k;
        tile_e[t] = (unsigned char)e; }
    __syncthreads();
    return TT;
}

__device__ __forceinline__ void p9_final(Frame& F) {
    LANE_TID();
    const int gw = F.vcu * NWAVES + F.wave, NGW = F.G * NWAVES;
    unsigned tl = 0; if (lane_ < 32) { unsigned n = __hip_atomic_load(F.ctl + CW_CNT + 64 * lane_, RLX_AGENT); if (n > (unsigned)M) n = (unsigned)M; tl = (n + 255u) >> 8; }
    unsigned incl = tl;
#pragma unroll
    for (int o = 1; o < 32; o <<= 1) { const unsigned t = __shfl_up(incl, o); if (lane_ >= o) incl += t; }
    const unsigned excl = incl - tl;
    f32x4 gm[4];
#pragma unroll
    for (int j = 0; j < 4; ++j) gm[j] = *((const GAS f32x4*)F.in[IN_GFINAL] + lane_ + 64 * j);
    const float* X1 = F.in[IN_X]; const bf16* DX = (const bf16*)(F.ws + WS_X1); const signed char* Y = (const signed char*)(F.ws + WS_Y); const v4u* ROUTE = (const v4u*)(F.ws + WS_ROUTE);
#pragma unroll 1
    for (int m = gw; m < M; m += NGW) {
        const GAS f32x4* xr = (const GAS f32x4*)(X1 + (size_t)m * D) + lane_;
        f32x4 v[4];
#pragma unroll
        for (int j = 0; j < 4; ++j) { const v2u dw = *((const GAS v2u*)(DX + (size_t)m * D) + lane_ + 64 * j); v[j] = xr[64 * j] + (f32x4){bflo(dw.x), bfhi(dw.x), bflo(dw.y), bfhi(dw.y)}; }
#pragma unroll
        for (int k = 0; k < 4; ++k) { const v4u rt = *((const GAS v4u*)ROUTE + (size_t)m * 4 + k); const unsigned e = rt.x & 31u; const float wv = __uint_as_float(rt.z) * (1.0f / Y8_SCALE);
            unsigned slot = (unsigned)__shfl((int)excl, (int)e) * 256u + rt.y; if (slot >= (unsigned)SLOTS) slot = 0u;
            const GAS unsigned* yr = (const GAS unsigned*)(Y + (size_t)slot * D) + lane_;
#pragma unroll
            for (int j = 0; j < 4; ++j) { const unsigned yw = yr[64 * j];
                v[j].x += wv * (float)((int)(yw << 24) >> 24); v[j].y += wv * (float)((int)(yw << 16) >> 24); v[j].z += wv * (float)((int)(yw << 8) >> 24); v[j].w += wv * (float)((int)yw >> 24); } }
        float s = 0.f;
#pragma unroll
        for (int j = 0; j < 4; ++j) s += (v[j].x * v[j].x + v[j].y * v[j].y) + (v[j].z * v[j].z + v[j].w * v[j].w);
        const float rstd = 1.0f / sqrtf(wave_sum(s) * (1.f / D) + RMS_EPS);
        GAS f32x4* o = (GAS f32x4*)(F.out + (size_t)m * D) + lane_;
#pragma unroll
        for (int j = 0; j < 4; ++j) o[64 * j] = v[j] * rstd * gm[j];
    }
}


constexpr int CV_SQ = (D / CV_IN) * CV_KB, CV_GU = NE * (2 * DFF / CV_IN) * CV_KB, CV_D = NE * (D / CV_IN) * CV_KB, CV_N = 3 * CV_SQ + CV_GU + CV_D, CV_P1 = 3 * CV_SQ + CV_GU;
__device__ __forceinline__ void cvt_decode(Frame& F, int it, CvtItem& c) {
    unsigned char* ws = F.ws; int r = it;
    const float* const w_lru_p = F.in[IN_WLRU]; const float* const w_fox_p = F.in[IN_WFOX]; const float* const w_o_p = F.in[IN_WO];
    if (r < 3 * CV_SQ) { const int which = r / CV_SQ, rr = r % CV_SQ, cb = rr / CV_KB, kb = rr % CV_KB;
        c.src = (which == 0 ? w_lru_p : which == 1 ? w_fox_p : w_o_p) + CV_IN * cb; c.ldw = D; c.K = D; c.k0 = CV_IK * kb; c.i8 = 0;
        c.dst = ws + (which == 0 ? WS_WLRU : which == 1 ? WS_WFOX : WS_WO) + (size_t)(CV_IN * cb) * D * 2; return; }
    r -= 3 * CV_SQ;
    if (r < CV_GU) { const int cb = r / CV_KB, kb = r % CV_KB, cpe = 2 * DFF / CV_IN, e = cb / cpe, nn0 = CV_IN * (cb % cpe), pn = nn0 >> 8, bj = (nn0 >> 7) & 1, cp = nn0 & 127, scol = bj * DFF + 128 * pn + cp;
        c.src = F.in[IN_WGU] + (size_t)e * D * 2 * DFF + scol; c.ldw = 2 * DFF; c.K = D; c.k0 = CV_IK * kb; c.i8 = 1; c.dst = ws + WS_WGU + ((size_t)e * 2 * DFF + nn0) * D; return; }
    r -= CV_GU;
    { const int cb = r / CV_KB, kb = r % CV_KB, cpe = D / CV_IN, e = cb / cpe, n0 = CV_IN * (cb % cpe);
        c.src = F.in[IN_WD] + (size_t)e * DFF * D + n0; c.ldw = D; c.K = DFF; c.k0 = CV_IK * kb; c.i8 = 1; c.dst = ws + WS_WD + ((size_t)e * D + n0) * DFF; }
}
__device__ __forceinline__ void cvt_slice(Frame& F, int k_lo, int k_hi, int item_lo = 0, int item_hi = CV_N) {
    const int lane = hw_lane(); const int NGW = F.G * NWAVES, gw0 = item_lo + F.vcu * NWAVES + F.wave, gw = gw0 + k_lo * NGW;
    const int CV_END = (k_hi >= (CV_N + NGW - 1) / NGW) ? item_hi : ((gw0 + k_hi * NGW) < item_hi ? (gw0 + k_hi * NGW) : item_hi);
    CvtItem c0, c1, c2, c3; f32x4 v0[8], v1[8], v2[8], v3[8];
    int it = gw;
#define CV_LOAD(c, v, idx) do { if ((idx) < CV_END) { cvt_decode(F, (idx), c); cvt_load(c, lane, v); } } while (0)
    CV_LOAD(c0, v0, it); CV_LOAD(c1, v1, it + NGW); CV_LOAD(c2, v2, it + 2 * NGW); CV_LOAD(c3, v3, it + 3 * NGW);
#pragma unroll 1
    for (; it < CV_END; it += 4 * NGW) {
        cvt_store(c0, lane, v0); CV_LOAD(c0, v0, it + 4 * NGW);
        if (it + NGW < CV_END) { cvt_store(c1, lane, v1); CV_LOAD(c1, v1, it + 5 * NGW); }
        if (it + 2 * NGW < CV_END) { cvt_store(c2, lane, v2); CV_LOAD(c2, v2, it + 6 * NGW); }
        if (it + 3 * NGW < CV_END) { cvt_store(c3, lane, v3); CV_LOAD(c3, v3, it + 7 * NGW); }
    }
#undef CV_LOAD
}
__device__ __forceinline__ void ph1(Frame& F) {
    unsigned char* ws = F.ws;
    pg8::Gemm g{(const bf16*)(ws + WS_H), (const bf16*)(ws + WS_WIN), M, NPROJ, D}; pg8::StaticOrder S; S.init(M, NPROJ, F.G, (int)blockIdx.x);
    pg8::EpiSplit E{(bf16*)(ws + WS_PROJ), D, D, (size_t)PROJ_STRIDE / 2, 2, attn_body::C2, 1.0f / (W8_SCALE * H8_SCALE)};
    const int rounds = (S.nwg + F.G - 1) / F.G, slot = F.vcu % (rounds + 1);
    const int pre = 2 * ((F.vcu / (rounds + 1)) % 8);
    cvt_slice(F, 0, pre, 0, CV_P1);
    __syncthreads();
    S.i0 = 0; S.i1 = slot;
    pg8::gemm_phase<pg8::EpiSplit, pg8::StaticOrder, true, true>(F.lds + RING_OFF, g, S, E, F.wave);
    cvt_slice(F, pre, 0x7fffffff, 0, CV_P1);
    __syncthreads();
    S.i0 = slot; S.i1 = rounds;
    pg8::gemm_phase<pg8::EpiSplit, pg8::StaticOrder, true, true>(F.lds + RING_OFF, g, S, E, F.wave);
}
__device__ __forceinline__ void ph3(Frame& F, unsigned char* lds_generic) {
    unsigned char* ws = F.ws;
    const attn_body::AttnTensors AT{(const attn_body::bf16*)(ws + WS_PROJ + 2 * PROJ_STRIDE), (const attn_body::bf16*)(ws + WS_PROJ + 3 * PROJ_STRIDE), (const attn_body::bf16*)(ws + WS_PROJ + 4 * PROJ_STRIDE),
                                    (attn_body::bf16*)(ws + WS_YFOX), (const float*)(ws + WS_KB), (const unsigned*)(F.ctl + CW_QN), (const unsigned*)(F.ctl + CW_KN)};
    attn_body::StaticOrder S((int)F.G, (int)blockIdx.x);
    const int pos = F.vcu % 5;
    S.i0 = 0; S.i1 = pos;
    attn_body::attn_phase<attn_body::StaticOrder>((char*)lds_generic + RING_OFF, AT, S, F.wave);
    cvt_slice(F, 0, 0x7fffffff, CV_P1, CV_N);
    S.i0 = pos; S.i1 = 0x7fffffff;
    attn_body::attn_phase<attn_body::StaticOrder>((char*)lds_generic + RING_OFF, AT, S, F.wave);
    __syncthreads();
    p3_lru(F);
}
__device__ __forceinline__ void ph4(Frame& F) {
    unsigned char* ws = F.ws;
    static_assert(WS_WFOX == WS_WLRU + (size_t)D * D * 2, "the two weight copies are contiguous");
    pg8::Gemm g{(const bf16*)ws, (const bf16*)(ws + WS_WLRU), M, D, D}; pg8::PairOrder S; S.init(M, D, F.G, (int)blockIdx.x); S.abase[0] = (unsigned)WS_YLRU; S.abase[1] = (unsigned)WS_YFOX;
    pg8::EpiGatePair E{{(bf16*)(ws + WS_TMP), (const bf16*)(ws + WS_PROJ + 5 * PROJ_STRIDE), nullptr, D}, {(bf16*)(ws + WS_MERGED), (const bf16*)(ws + WS_PROJ + 6 * PROJ_STRIDE), (const bf16*)(ws + WS_TMP), D}, D / 256};
    pg8::gemm_phase<pg8::EpiGatePair, pg8::PairOrder, true>(F.lds + RING_OFF, g, S, E, F.wave);
}
__device__ __forceinline__ void ph5(Frame& F) {
    unsigned char* ws = F.ws;
    pg8::Gemm g{(const bf16*)(ws + WS_MERGED), (const bf16*)(ws + WS_WO), M, D, D}; pg8::StaticOrder S; S.init(M, D, F.G, (int)blockIdx.x);
    pg8::EpiPlainBf16 E{(bf16*)(ws + WS_X1), D};
    pg8::gemm_phase<pg8::EpiPlainBf16, pg8::StaticOrder, true>(F.lds + RING_OFF, g, S, E, F.wave);
}
__device__ __forceinline__ void ph7(Frame& F) {
    unsigned char* ws = F.ws;
    const int TT = moe_tables(F);
    LAS unsigned char* EX = F.lds + EXTRA_OFF; LAS unsigned* rows = (LAS unsigned*)(EX + EX_ROWS);
    const LAS unsigned* ncnt = (const LAS unsigned*)(EX + EX_NCNT); const LAS unsigned* tpre = (const LAS unsigned*)(EX + EX_TPRE);
    pg8::GroupedOrder<true> S; S.init(TT, 8, F.G, (int)blockIdx.x, EX + EX_TILE_E, rows);
    { const unsigned* TOKMAP = (const unsigned*)(ws + WS_TOKMAP); pg8::Unit u;
      const int tid_ = F.wave * 64 + hw_lane();
      for (int i = 0; i < EX_MAXU && S.next(i, u); ++i) if (tid_ < 256) { const int e = u.pn >> 3; const unsigned pos = (unsigned)(u.pm - (int)tpre[e]) * 256u + (unsigned)tid_;
          rows[i * 256 + tid_] = TOKMAP[(size_t)e * M + (pos < ncnt[e] ? pos : 0u)] & (unsigned)(M - 1); } }
    __syncthreads();
    pg8::Gemm g{(const bf16*)(ws + WS_H2), (const bf16*)(ws + WS_WGU), SLOTS, 2 * DFF, D};
    pg8::EpiSwiglu E{(unsigned char*)(ws + WS_ACT), F.in[IN_BGU], 8, 1.0f / (W8_SCALE * H8_SCALE), ACT8_SCALE};
    pg8::gemm_phase<pg8::EpiSwiglu, pg8::GroupedOrder<true>, true, true>(F.lds + RING_OFF, g, S, E, F.wave);
}
__device__ __forceinline__ void ph8(Frame& F) {
    unsigned char* ws = F.ws;
    const int TT = moe_tables(F);
    LAS unsigned char* EX = F.lds + EXTRA_OFF;
    pg8::GroupedOrder<false> S; S.init(TT, 4, F.G, (int)blockIdx.x, EX + EX_TILE_E, nullptr);
    pg8::Gemm g{(const bf16*)(ws + WS_ACT), (const bf16*)(ws + WS_WD), SLOTS, D, DFF};
    pg8::EpiDown E{(unsigned char*)(ws + WS_Y), F.in[IN_BD], 4, 1.0f / (W8_SCALE * ACT8_SCALE), Y8_SCALE};
    pg8::gemm_phase<pg8::EpiDown, pg8::GroupedOrder<false>, true, true>(F.lds + RING_OFF, g, S, E, F.wave);
}
struct Args { const float* in[22]; float* out; unsigned char* ws; int ph_lo, ph_hi, li, pad; };
__global__ void __launch_bounds__(NWAVES * 64, 2) mk_fwd(Args args) {
    extern __shared__ __attribute__((aligned(16))) unsigned char lds[];
    Frame F;
    F.lds = (LAS unsigned char*)lds;
    F.MISC = (volatile LAS unsigned*)(F.lds + MISC_OFF);
    F.wave = __builtin_amdgcn_readfirstlane((int)threadIdx.x >> 6);
    F.G = gridDim.x; { const int bx = blockIdx.x; F.vcu = (F.G % 8 == 0) ? (bx % 8) * (F.G / 8) + bx / 8 : bx; }
#pragma unroll
    for (int i = 0; i < 22; ++i) F.in[i] = args.in[i];
    F.out = args.out; F.ws = args.ws; F.ctl = (gu32*)(args.ws + WS_CTL);
    for (int u = threadIdx.x; u < (LDS_BYTES - LDSCTL_OFF) / 4; u += NWAVES * 64) ((LAS unsigned*)(F.lds + LDSCTL_OFF))[u] = 0u;
    __syncthreads();
    XcdBarrier bar; bar.bar = (unsigned*)(F.ctl + CW_BAR); bar.x = 0; bar.st = nullptr;
    if (N_LAUNCHES != PER_PHASE) bar = xcd_barrier_post((unsigned*)(F.ctl + CW_BAR), F.MISC + 8);
#define GRID_BAR(seam) do { if (N_LAUNCHES == PER_PHASE) { if (threadIdx.x == 0) __hip_atomic_store(F.ctl + CW_TMO, 0xBADBA0u | (unsigned)(seam), RLX_AGENT); } else { xcd_barrier(bar); } } while (0)
    const int lo = args.ph_lo, hi = args.ph_hi;
#define IN(k) (lo <= (k) && (k) < hi)
#define BOTH(k) (IN(k) && IN((k) + 1))

#ifndef PROBE_REPEAT
#define PROBE_REPEAT -1
#endif
#ifndef ONLY_PHASE
#define ONLY_PHASE -1
#endif
#define RUN(k, call) do { if ((ONLY_PHASE < 0 || ONLY_PHASE == (k)) && IN(k)) { call; if (PROBE_REPEAT == (k)) { GRID_BAR(k); call; } if (BOTH(k)) GRID_BAR(k); } } while (0)
    RUN(0, p0_prologue(F));
    RUN(1, ph1(F));
#if PROBE_REPEAT == 11
    if (IN(1)) { pg8::Gemm g{(const bf16*)(F.ws + WS_H), (const bf16*)(F.ws + WS_WIN), M, NPROJ, D}; pg8::StaticOrder S; S.init(M, NPROJ, F.G, (int)blockIdx.x); pg8::EpiNull E;
        pg8::gemm_phase<pg8::EpiNull, pg8::StaticOrder, true, true>(F.lds + RING_OFF, g, S, E, F.wave); GRID_BAR(1); }
#endif
#if PROBE_REPEAT == 12
    if (IN(1)) { pg8::Gemm g{(const bf16*)(F.ws + WS_H), (const bf16*)(F.ws + WS_WIN), M, NPROJ, D}; pg8::StaticOrder S; S.init(M, NPROJ, F.G, (int)blockIdx.x);
        pg8::EpiSplit E{(bf16*)(F.ws + WS_Y), 0, D, 0, 2, attn_body::C2, 1.0f / (W8_SCALE * H8_SCALE)};
        pg8::gemm_phase<pg8::EpiSplit, pg8::StaticOrder, true, true>(F.lds + RING_OFF, g, S, E, F.wave); GRID_BAR(1); }
#endif
    RUN(2, p2_phase(F));
    RUN(3, ph3(F, lds));
#if PROBE_REPEAT == 14
    if (IN(3)) { unsigned char* ws = F.ws; const attn_body::AttnTensors AT{(const attn_body::bf16*)(ws + WS_PROJ + 2 * PROJ_STRIDE), (const attn_body::bf16*)(ws + WS_PROJ + 3 * PROJ_STRIDE), (const attn_body::bf16*)(ws + WS_PROJ + 4 * PROJ_STRIDE),
                                    (attn_body::bf16*)(ws + WS_TMP), (const float*)(ws + WS_KB), (const unsigned*)(F.ctl + CW_QN), (const unsigned*)(F.ctl + CW_KN)};
        const attn_body::StaticOrder S((int)F.G, (int)blockIdx.x); attn_body::attn_phase<attn_body::StaticOrder>((char*)lds + RING_OFF, AT, S, F.wave, -1.0f); GRID_BAR(3); }
#endif
#if PROBE_REPEAT == 13
    if (IN(3)) { unsigned char* ws = F.ws; const attn_body::AttnTensors AT{(const attn_body::bf16*)(ws + WS_PROJ + 2 * PROJ_STRIDE), (const attn_body::bf16*)(ws + WS_PROJ + 3 * PROJ_STRIDE), (const attn_body::bf16*)(ws + WS_PROJ + 4 * PROJ_STRIDE),
                                    (attn_body::bf16*)(ws + WS_YFOX), (const float*)(ws + WS_KB), (const unsigned*)(F.ctl + CW_QN), (const unsigned*)(F.ctl + CW_KN)};
        const attn_body::StaticOrder S((int)F.G, (int)blockIdx.x); attn_body::attn_phase<attn_body::StaticOrder>((char*)lds + RING_OFF, AT, S, F.wave); GRID_BAR(3); }
#endif
    RUN(4, ph4(F));
    RUN(5, ph5(F));
    RUN(6, p6_route(F));
#if PROBE_REPEAT == 16
    if (IN(6)) { if (blockIdx.x == 0 && threadIdx.x < 32) __hip_atomic_store(F.ctl + CW_CNT + 64 * threadIdx.x, 0u, RLX_AGENT); GRID_BAR(6); p6_route(F); GRID_BAR(6); }
#endif
    RUN(7, ph7(F));
#if PROBE_REPEAT == 17
    if (IN(7)) { unsigned char* ws = F.ws; const int TT = moe_tables(F); LAS unsigned char* EX = F.lds + EXTRA_OFF; LAS unsigned* rows = (LAS unsigned*)(EX + EX_ROWS);
        pg8::GroupedOrder<true> S; S.init(TT, 8, F.G, (int)blockIdx.x, EX + EX_TILE_E, rows);
        pg8::Gemm g{(const bf16*)(ws + WS_H2), (const bf16*)(ws + WS_WGU), SLOTS, 2 * DFF, D}; pg8::EpiNull E;
        pg8::gemm_phase<pg8::EpiNull, pg8::GroupedOrder<true>, true, true>(F.lds + RING_OFF, g, S, E, F.wave); GRID_BAR(7); }
#endif
    RUN(8, ph8(F));
    RUN(9, p9_final(F));
#undef RUN
#undef IN
#undef BOTH
}

extern "C" void kernel_launch(void* const* d_in, const int* in_sizes, int n_in, void* d_out, int out_size, void* d_ws, size_t ws_size, hipStream_t stream) {
    static int grid = 0;
    if (grid == 0) {
        if (n_in != 22 || in_sizes[0] != M * D || out_size != M * D || ws_size < WS_END) { fprintf(stderr, "kernel_launch: unexpected problem: n_in %d in0 %d out %d ws %zu (need %zu)\n", n_in, n_in > 0 ? in_sizes[0] : -1, out_size, ws_size, (size_t)WS_END); grid = -1; return; }
        int dev = 0, cus = 0, per_cu = 0;
        if (hipGetDevice(&dev) != hipSuccess || hipDeviceGetAttribute(&cus, hipDeviceAttributeMultiprocessorCount, dev) != hipSuccess) { grid = -1; return; }
        if (hipFuncSetAttribute((const void*)mk_fwd, hipFuncAttributeMaxDynamicSharedMemorySize, LDS_BYTES) != hipSuccess) { fprintf(stderr, "kernel_launch: hipFuncSetAttribute failed\n"); grid = -1; return; }
        if (hipOccupancyMaxActiveBlocksPerMultiprocessor(&per_cu, (const void*)mk_fwd, NWAVES * 64, LDS_BYTES) != hipSuccess || per_cu < 1) { fprintf(stderr, "kernel_launch: occupancy query reports %d workgroups per CU\n", per_cu); }
        (void)hipGetLastError();
        grid = cus;
    }
    if (grid < 0) return;
    if (hipMemsetAsync((char*)d_ws + WS_CTL, 0, CTL_ZERO_BYTES, stream) != hipSuccess) return;
    Args a{};
    for (int i = 0; i < 22; ++i) a.in[i] = (const float*)d_in[i];
    a.out = (float*)d_out; a.ws = (unsigned char*)d_ws;
    for (int li = 0; li < N_LAUNCHES; ++li) {
        a.ph_lo = (N_LAUNCHES == PER_PHASE) ? li : 0; a.ph_hi = (N_LAUNCHES == PER_PHASE) ? li + 1 : PER_PHASE; a.li = li; a.pad = 0;
        hipLaunchKernelGGL(mk_fwd, dim3(grid), dim3(NWAVES * 64), LDS_BYTES, stream, a);
    }
}
```

```cpp
#include <hip/hip_runtime.h>
#include <cstdio>
#include <cstdint>
__device__ __forceinline__ int hw_lane() { int l; asm volatile("v_mbcnt_lo_u32_b32 %0, -1, 0\n\tv_mbcnt_hi_u32_b32 %0, -1, %0" : "=v"(l)); return l; }
namespace pg8 {
#define PG8_LAS __attribute__((address_space(3)))
typedef unsigned short bf16_t;
typedef short bf16x8 __attribute__((ext_vector_type(8)));
typedef float f32x4 __attribute__((ext_vector_type(4)));
typedef unsigned u32x4 __attribute__((ext_vector_type(4)));
constexpr int BM = 256, BK = 64, HALF = 128, HTB = HALF * BK * 2  , STAGE_BYTES = 8 * HTB, NXCD = 8, WGM = 8;

__host__ __device__ __forceinline__ int lds_byte(int r, int c) { const int st = (r >> 4) * 2 + (c >> 5), rr = r & 15, cc = c & 31, ob = rr * 64 + cc * 2; return st * 1024 + (ob ^ (((ob >> 9) & 1) << 5)); }
__host__ __device__ __forceinline__ void stage_rc(int b, int& R, int& C) { const int st = b / 1024, sb = b % 1024, swz = sb ^ (((sb >> 9) & 1) << 5); R = (st >> 1) * 16 + swz / 64; C = (st & 1) * 32 + (swz % 64) / 2; }
__host__ __device__ __forceinline__ int perm32(int rho) { const int n = rho >> 4, i = rho & 15; return 8 * (i >> 2) + 4 * n + (i & 3); }

struct Unit { int pm, pn; };
struct Gemm { const bf16_t* A; const bf16_t* Bt; int M, N, K; };

struct StaticOrder {
    static constexpr bool GATHER = false;
    int nM, nN, nwg, G, c, i0, i1;
    __device__ __forceinline__ void init(int M, int N, int G_, int c_) { nM = M / BM; nN = N / BM; nwg = nM * nN; G = G_; c = c_; i0 = 0; i1 = 0x7fffffff; }
    __device__ __forceinline__ bool next(int i, Unit& u) const {
        if (i >= i1 - i0) return false;
        const long L = (long)(i + i0) * G + c; if (L >= nwg) return false;
        int wgid = (int)L; { const int q = nwg / NXCD, r = nwg % NXCD, xcd = wgid % NXCD, off = wgid / NXCD; wgid = (xcd < r ? xcd * (q + 1) : r * (q + 1) + (xcd - r) * q) + off; }
        const int nig = WGM * nN, gid = wgid / nig, fm = gid * WGM, gsz = (nM - fm) < WGM ? (nM - fm) : WGM;
        u.pm = fm + ((wgid % nig) % gsz); u.pn = (wgid % nig) / gsz; return true;
    }
    __device__ __forceinline__ unsigned a_off(int, const Unit& u, int rloc, int rowbytes) const { return (unsigned)(u.pm * BM + rloc) * (unsigned)rowbytes; }
};
struct PairOrder : StaticOrder {
    unsigned abase[2];
    __device__ __forceinline__ bool next(int i, Unit& u) const { if (!StaticOrder::next(i >> 1, u)) return false; u.pn += (i & 1) * nN; return true; }
    __device__ __forceinline__ unsigned a_off(int, const Unit& u, int rloc, int rowbytes) const { return abase[u.pn >= nN ? 1 : 0] + (unsigned)(u.pm * BM + rloc) * (unsigned)rowbytes; }
};
template <bool GATHER_> struct GroupedOrder {
    static constexpr bool GATHER = GATHER_;
    int nM, nN, nwg, G, c;
    const PG8_LAS unsigned char* tile_e; const PG8_LAS unsigned* rows;
    __device__ __forceinline__ void init(int TT, int nN_, int G_, int c_, const PG8_LAS unsigned char* te, const PG8_LAS unsigned* rw) { nM = TT; nN = nN_; nwg = nM * nN; G = G_; c = c_; tile_e = te; rows = rw; }
    __device__ __forceinline__ bool next(int i, Unit& u) const {
        const long L = (long)i * G + c; if (L >= nwg) return false;
        int wgid = (int)L; { const int q = nwg / NXCD, r = nwg % NXCD, xcd = wgid % NXCD, off = wgid / NXCD; wgid = (xcd < r ? xcd * (q + 1) : r * (q + 1) + (xcd - r) * q) + off; }
        const int nig = WGM * nN, gid = wgid / nig, fm = gid * WGM, gsz = (nM - fm) < WGM ? (nM - fm) : WGM;
        u.pm = fm + ((wgid % nig) % gsz); u.pn = (int)tile_e[u.pm] * nN + (wgid % nig) / gsz; return true;
    }
    __device__ __forceinline__ unsigned a_off(int i, const Unit& u, int rloc, int rowbytes) const {
        return GATHER ? rows[i * 256 + rloc] * (unsigned)rowbytes : (unsigned)(u.pm * BM + rloc) * (unsigned)rowbytes; }
};

__device__ __forceinline__ unsigned cvt_pk_bf16(float lo, float hi) { unsigned r; asm volatile("v_cvt_pk_bf16_f32 %0, %1, %2" : "=v"(r) : "v"(lo), "v"(hi)); return r; }
__device__ __forceinline__ float bf_lo(unsigned w) { return __uint_as_float(w << 16); }
__device__ __forceinline__ float bf_hi(unsigned w) { return __uint_as_float(w & 0xffff0000u); }
__device__ __forceinline__ float sigm(float x) { return __builtin_amdgcn_rcpf(1.0f + __builtin_amdgcn_exp2f(-1.4426950408889634f * x)); }

__device__ __forceinline__ unsigned q8lo(float x) { return __float_as_uint(__builtin_amdgcn_fmed3f(x, -127.0f, 127.0f) + 12582912.0f); }
__device__ __forceinline__ unsigned pk4_i8(float a, float b, float c, float d) {
    const unsigned ab = __builtin_amdgcn_perm(q8lo(b), q8lo(a), 0x0c0c0400u), cd = __builtin_amdgcn_perm(q8lo(d), q8lo(c), 0x0c0c0400u); return ab | (cd << 16); }
struct EpiSplit {
    static constexpr bool PERM = true, AFTER_DRAIN = false;
    bf16_t* O; int ldc; int split_cols; size_t split_stride; int scale_t; float scale; float accscale;
    __device__ __forceinline__ void operator()(const f32x4 (&acc)[2][2][4][2], const Unit& u, int wr, int wc, int fr, int fq) const {
        const int row0 = u.pm * BM + wr * 64 + fr; int colt = u.pn * BM; bf16_t* base = O;
        const int t = colt / split_cols; base += (size_t)t * split_stride; colt -= t * split_cols; const float sc = ((t == scale_t) ? scale : 1.f) * accscale;
        const int col0 = colt + wc * 32 + 8 * fq;
#pragma unroll
        for (int ai = 0; ai < 2; ++ai)
#pragma unroll
            for (int m = 0; m < 4; ++m) { bf16_t* rowp = base + (size_t)(row0 + ai * HALF + m * 16) * ldc + col0;
#pragma unroll
                for (int bj = 0; bj < 2; ++bj) { const f32x4 v0 = acc[ai][bj][m][0] * sc, v1 = acc[ai][bj][m][1] * sc;
                    u32x4 w; w.x = cvt_pk_bf16(v0[0], v0[1]); w.y = cvt_pk_bf16(v0[2], v0[3]); w.z = cvt_pk_bf16(v1[0], v1[1]); w.w = cvt_pk_bf16(v1[2], v1[3]);
                    *(u32x4*)(rowp + bj * HALF) = w; } }
    }
};
struct EpiNull {
    static constexpr bool PERM = true, AFTER_DRAIN = false;
    __device__ __forceinline__ void operator()(const f32x4 (&acc)[2][2][4][2], const Unit&, int, int, int, int) const {
#pragma unroll
        for (int ai = 0; ai < 2; ++ai)
#pragma unroll
            for (int bj = 0; bj < 2; ++bj)
#pragma unroll
                for (int m = 0; m < 4; ++m) asm volatile("" :: "v"(acc[ai][bj][m][0]), "v"(acc[ai][bj][m][1]));
    }
};
template <bool ADD> struct EpiGate {
    static constexpr bool PERM = true, AFTER_DRAIN = false;
    bf16_t* O; const bf16_t* G; const bf16_t* T; int ldc;
    __device__ __forceinline__ void operator()(const f32x4 (&acc)[2][2][4][2], const Unit& u, int wr, int wc, int fr, int fq) const {
        const int row0 = u.pm * BM + wr * 64 + fr, col0 = u.pn * BM + wc * 32 + 8 * fq;
#pragma unroll
        for (int ai = 0; ai < 2; ++ai)
#pragma unroll
            for (int m = 0; m < 4; ++m) { const size_t off = (size_t)(row0 + ai * HALF + m * 16) * ldc + col0;
#pragma unroll
                for (int bj = 0; bj < 2; ++bj) { const u32x4 g = *(const u32x4*)(G + off + bj * HALF); u32x4 tv = (u32x4){0u, 0u, 0u, 0u}; if (ADD) tv = *(const u32x4*)(T + off + bj * HALF);
                    const f32x4 v0 = acc[ai][bj][m][0], v1 = acc[ai][bj][m][1]; float r[8];
                    r[0] = sigm(bf_lo(g.x)) * v0[0]; r[1] = sigm(bf_hi(g.x)) * v0[1]; r[2] = sigm(bf_lo(g.y)) * v0[2]; r[3] = sigm(bf_hi(g.y)) * v0[3];
                    r[4] = sigm(bf_lo(g.z)) * v1[0]; r[5] = sigm(bf_hi(g.z)) * v1[1]; r[6] = sigm(bf_lo(g.w)) * v1[2]; r[7] = sigm(bf_hi(g.w)) * v1[3];
                    if (ADD) { r[0] += bf_lo(tv.x); r[1] += bf_hi(tv.x); r[2] += bf_lo(tv.y); r[3] += bf_hi(tv.y); r[4] += bf_lo(tv.z); r[5] += bf_hi(tv.z); r[6] += bf_lo(tv.w); r[7] += bf_hi(tv.w); }
                    u32x4 w; w.x = cvt_pk_bf16(r[0], r[1]); w.y = cvt_pk_bf16(r[2], r[3]); w.z = cvt_pk_bf16(r[4], r[5]); w.w = cvt_pk_bf16(r[6], r[7]);
                    *(u32x4*)(O + off + bj * HALF) = w; } }
    }
};
struct EpiGatePair {
    static constexpr bool PERM = true, AFTER_DRAIN = false;
    EpiGate<false> e0; EpiGate<true> e1; int nN;
    __device__ __forceinline__ void operator()(const f32x4 (&acc)[2][2][4][2], const Unit& u, int wr, int wc, int fr, int fq) const {
        if (u.pn < nN) e0(acc, u, wr, wc, fr, fq); else { Unit v = u; v.pn -= nN; e1(acc, v, wr, wc, fr, fq); } }
};
struct EpiPlainBf16 {
    static constexpr bool PERM = true, AFTER_DRAIN = false;
    bf16_t* O; int ldc;
    __device__ __forceinline__ void operator()(const f32x4 (&acc)[2][2][4][2], const Unit& u, int wr, int wc, int fr, int fq) const {
        const int row0 = u.pm * BM + wr * 64 + fr, col0 = u.pn * BM + wc * 32 + 8 * fq;
#pragma unroll
        for (int ai = 0; ai < 2; ++ai)
#pragma unroll
            for (int m = 0; m < 4; ++m) { bf16_t* rowp = O + (size_t)(row0 + ai * HALF + m * 16) * ldc + col0;
#pragma unroll
                for (int bj = 0; bj < 2; ++bj) { const f32x4 v0 = acc[ai][bj][m][0], v1 = acc[ai][bj][m][1];
                    u32x4 w; w.x = cvt_pk_bf16(v0[0], v0[1]); w.y = cvt_pk_bf16(v0[2], v0[3]); w.z = cvt_pk_bf16(v1[0], v1[1]); w.w = cvt_pk_bf16(v1[2], v1[3]);
                    *(u32x4*)(rowp + bj * HALF) = w; } }
    }
};
struct EpiResF32 {
    static constexpr bool PERM = false, AFTER_DRAIN = false;
    const float* base; float* out; int ldc;
    __device__ __forceinline__ void operator()(const f32x4 (&acc)[2][2][4][2], const Unit& u, int wr, int wc, int fr, int fq) const {
        const int row0 = u.pm * BM + wr * 64 + fr, col0 = u.pn * BM + wc * 32 + 4 * fq;
#pragma unroll
        for (int ai = 0; ai < 2; ++ai)
#pragma unroll
            for (int m = 0; m < 4; ++m) { const size_t off = (size_t)(row0 + ai * HALF + m * 16) * ldc + col0;
#pragma unroll
                for (int bj = 0; bj < 2; ++bj)
#pragma unroll
                    for (int n = 0; n < 2; ++n) *(f32x4*)(out + off + bj * HALF + n * 16) = *(const f32x4*)(base + off + bj * HALF + n * 16) + acc[ai][bj][m][n]; }
    }
};
struct EpiSwiglu {
    static constexpr bool PERM = true, AFTER_DRAIN = false;
    unsigned char* O; const float* bias; int nN; float accscale, outscale;
    typedef float f2 __attribute__((ext_vector_type(2)));
    __device__ __forceinline__ f2 act2(f2 ga, f2 ua, f2 bg, f2 bu) const {
        f2 g = __builtin_elementwise_fma(ga, (f2){accscale, accscale}, bg), u = __builtin_elementwise_fma(ua, (f2){accscale, accscale}, bu);
        g.x = fminf(g.x, 7.0f); g.y = fminf(g.y, 7.0f); u.x = __builtin_amdgcn_fmed3f(u.x, -7.0f, 7.0f); u.y = __builtin_amdgcn_fmed3f(u.y, -7.0f, 7.0f);
        const f2 t = g * (-1.702f * 1.4426950408889634f); f2 e; e.x = __builtin_amdgcn_exp2f(t.x); e.y = __builtin_amdgcn_exp2f(t.y);
        const f2 d = e + 1.0f; f2 r; r.x = __builtin_amdgcn_rcpf(d.x); r.y = __builtin_amdgcn_rcpf(d.y);
        return (u + 1.0f) * (g * outscale) * r; }
    __device__ __forceinline__ void operator()(const f32x4 (&acc)[2][2][4][2], const Unit& u, int wr, int wc, int fr, int fq) const {
        const int e = u.pn / nN, pnl = u.pn - e * nN; const int row0 = u.pm * BM + wr * 64 + fr, colg = pnl * HALF + wc * 32 + 8 * fq;
        f32x4 bg[2], bu[2];
#pragma unroll
        for (int n = 0; n < 2; ++n) { bg[n] = *(const f32x4*)(bias + (size_t)e * 2048 + colg + 4 * n); bu[n] = *(const f32x4*)(bias + (size_t)e * 2048 + 1024 + colg + 4 * n); }
#pragma unroll
        for (int ai = 0; ai < 2; ++ai)
#pragma unroll
            for (int m = 0; m < 4; ++m) { f2 r[4];
#pragma unroll
                for (int n = 0; n < 2; ++n) { const f32x4 ga = acc[ai][0][m][n], ua = acc[ai][1][m][n];
                    r[2 * n] = act2((f2){ga[0], ga[1]}, (f2){ua[0], ua[1]}, (f2){bg[n][0], bg[n][1]}, (f2){bu[n][0], bu[n][1]});
                    r[2 * n + 1] = act2((f2){ga[2], ga[3]}, (f2){ua[2], ua[3]}, (f2){bg[n][2], bg[n][3]}, (f2){bu[n][2], bu[n][3]}); }
                typedef unsigned u32x2_ __attribute__((ext_vector_type(2))); u32x2_ w; w.x = pk4_i8(r[0].x, r[0].y, r[1].x, r[1].y); w.y = pk4_i8(r[2].x, r[2].y, r[3].x, r[3].y);
                *(u32x2_*)(O + (size_t)(row0 + ai * HALF + m * 16) * 1024 + colg) = w; }
    }
};
struct EpiDown {
    static constexpr bool PERM = true, AFTER_DRAIN = false;
    unsigned char* O; const float* bias; int nN; float accscale, outscale;
    __device__ __forceinline__ void operator()(const f32x4 (&acc)[2][2][4][2], const Unit& u, int wr, int wc, int fr, int fq) const {
        const int e = u.pn / nN, pnl = u.pn - e * nN; const int row0 = u.pm * BM + wr * 64 + fr, col0 = pnl * BM + wc * 32 + 8 * fq;
        f32x4 bv[2][2];
#pragma unroll
        for (int bj = 0; bj < 2; ++bj)
#pragma unroll
            for (int n = 0; n < 2; ++n) bv[bj][n] = *(const f32x4*)(bias + (size_t)e * 1024 + col0 + bj * HALF + 4 * n);
#pragma unroll
        for (int ai = 0; ai < 2; ++ai)
#pragma unroll
            for (int m = 0; m < 4; ++m) { unsigned char* rowp = O + (size_t)(row0 + ai * HALF + m * 16) * 1024 + col0;
#pragma unroll
                for (int bj = 0; bj < 2; ++bj) { const f32x4 v0 = (acc[ai][bj][m][0] * accscale + bv[bj][0]) * outscale, v1 = (acc[ai][bj][m][1] * accscale + bv[bj][1]) * outscale;
                    typedef unsigned u32x2_ __attribute__((ext_vector_type(2))); u32x2_ w; w.x = pk4_i8(v0[0], v0[1], v0[2], v0[3]); w.y = pk4_i8(v1[0], v1[1], v1[2], v1[3]);
                    *(u32x2_*)(rowp + bj * HALF) = w; } }
    }
};

typedef int i32x4 __attribute__((ext_vector_type(4)));
template <class Epi, class Sched, bool ALIGN_EPI, bool I8 = false>
__device__ __forceinline__ void gemm_phase(PG8_LAS unsigned char* lds, const Gemm g, const Sched& S, const Epi& E, int wave_id) {
    const int wid = wave_id, lane = hw_lane(), tid = wid * 64 + lane, wr = wid >> 2, wc = wid & 3, fr = lane & 15, fq = lane >> 4;
    const int K = g.K, rowb = I8 ? K : K * 2, nt = rowb / (BK * 2);
    int RA[2], CA2[2]; unsigned voffB[2], voffA[2];
#pragma unroll
    for (int i = 0; i < 2; ++i) { int R, C; stage_rc(tid * 16 + i * 8192, R, C); const int Rb = Epi::PERM ? ((R & ~31) + perm32(R & 31)) : R;
        RA[i] = R; CA2[i] = C * 2; voffB[i] = (unsigned)(Rb * rowb + C * 2); voffA[i] = (unsigned)(R * rowb + C * 2); }
    const unsigned kstep = (unsigned)(BK * 2);
    const size_t hstep = (size_t)HALF * rowb;
    const size_t tstep = 2 * hstep;
    const unsigned ldsw = (unsigned)wid * 1024u;
    const int aoff = lds_byte(wr * 64 + fr, fq * 8), boff = lds_byte(wc * 32 + fr, fq * 8);
    const char* Abase = (const char*)g.A;
#define PG8_SA(b, h) (((b) * 2 + (h)) * HTB)
#define PG8_SB(b, h) ((4 + (b) * 2 + (h)) * HTB)
#define PG8_STAGE(bufoff, gbase, voff) do { _Pragma("unroll") for (int _i = 0; _i < 2; ++_i) \
        __builtin_amdgcn_global_load_lds((const unsigned*)((const char*)(gbase) + (voff)[_i]), (PG8_LAS unsigned*)(lds + (bufoff) + ldsw + _i * 8192), 16, 0, 0); } while (0)
#define PG8_STAGEA(bufoff, h, NX, kb) do { _Pragma("unroll") for (int _i = 0; _i < 2; ++_i) { \
        const unsigned _o = Sched::GATHER ? (((NX) ? offN[h][_i] : offC[h][_i]) + (kb)) : (voffA[_i] + (unsigned)((h) * (HALF * rowb)) + ((NX) ? uaN : uaC) + (kb)); \
        __builtin_amdgcn_global_load_lds((const unsigned*)(Abase + (size_t)_o), (PG8_LAS unsigned*)(lds + (bufoff) + ldsw + _i * 8192), 16, 0, 0); } } while (0)
#define PG8_LDA(dst, b, h) do { _Pragma("unroll") for (int m = 0; m < 4; ++m) _Pragma("unroll") for (int k = 0; k < 2; ++k) dst[m][k] = *(const PG8_LAS bf16x8*)(lds + PG8_SA(b, h) + aoff + m * 2048 + k * 1024); } while (0)
#define PG8_LDB(dst, b, h) do { _Pragma("unroll") for (int n = 0; n < 2; ++n) _Pragma("unroll") for (int k = 0; k < 2; ++k) dst[n][k] = *(const PG8_LAS bf16x8*)(lds + PG8_SB(b, h) + boff + n * 2048 + k * 1024); } while (0)
#define PG8_MMA(ai, bj, At, Bt) do { __builtin_amdgcn_s_setprio(1); _Pragma("unroll") for (int m = 0; m < 4; ++m) _Pragma("unroll") for (int n = 0; n < 2; ++n) _Pragma("unroll") for (int k = 0; k < 2; ++k) { \
        if constexpr (I8) acc[ai][bj][m][n] = __builtin_bit_cast(f32x4, __builtin_amdgcn_mfma_i32_16x16x64_i8(__builtin_bit_cast(i32x4, Bt[n][k]), __builtin_bit_cast(i32x4, At[m][k]), __builtin_bit_cast(i32x4, acc[ai][bj][m][n]), 0, 0, 0)); \
        else acc[ai][bj][m][n] = __builtin_amdgcn_mfma_f32_16x16x32_bf16(Bt[n][k], At[m][k], acc[ai][bj][m][n], 0, 0, 0); } __builtin_amdgcn_s_setprio(0); } while (0)
#define PG8_WAIT_V(n) asm volatile("s_waitcnt vmcnt(" #n ")" ::: "memory")
#define PG8_WAIT_L(n) asm volatile("s_waitcnt lgkmcnt(" #n ")" ::: "memory")
#define PG8_BAR __builtin_amdgcn_s_barrier()
#define PG8_SCHED __builtin_amdgcn_sched_barrier(0)
    Unit cur, nxt; int ui = 0;
    if (!S.next(0, cur)) return;
    f32x4 acc[2][2][4][2];
#pragma unroll
    for (int a = 0; a < 2; ++a)
#pragma unroll
        for (int b = 0; b < 2; ++b)
#pragma unroll
            for (int m = 0; m < 4; ++m)
#pragma unroll
                for (int n = 0; n < 2; ++n) acc[a][b][m][n] = (f32x4){0.f, 0.f, 0.f, 0.f};
    bf16x8 At[4][2], B0[2][2], B1[2][2];
    unsigned offC[2][2], offN[2][2];
    unsigned uaC = 0u, uaN = 0u;
    if constexpr (Sched::GATHER) {
#pragma unroll
        for (int h = 0; h < 2; ++h)
#pragma unroll
            for (int i = 0; i < 2; ++i) offC[h][i] = S.a_off(0, cur, h * HALF + RA[i], rowb) + (unsigned)CA2[i];
    } else uaC = S.a_off(0, cur, 0, rowb);
    const char* cB = (const char*)g.Bt + (size_t)cur.pn * tstep;
    PG8_STAGE(PG8_SB(0, 0), cB, voffB); PG8_STAGE(PG8_SB(0, 1), cB + hstep, voffB); PG8_STAGEA(PG8_SA(0, 0), 0, false, 0u); PG8_STAGEA(PG8_SA(0, 1), 1, false, 0u);
    if (wr == 1) PG8_BAR;
    PG8_WAIT_V(2); PG8_BAR;
    PG8_STAGE(PG8_SB(1, 0), cB + kstep, voffB); PG8_STAGEA(PG8_SA(1, 0), 0, false, kstep); PG8_STAGE(PG8_SB(1, 1), cB + hstep + kstep, voffB);
    PG8_WAIT_V(6); PG8_BAR;
    for (;;) {
        const bool has_next = S.next(ui + 1, nxt);
        const char* nB = has_next ? (const char*)g.Bt + (size_t)nxt.pn * tstep : cB;
        if constexpr (Sched::GATHER) {
#pragma unroll
            for (int h = 0; h < 2; ++h)
#pragma unroll
                for (int i = 0; i < 2; ++i) offN[h][i] = has_next ? S.a_off(ui + 1, nxt, h * HALF + RA[i], rowb) + (unsigned)CA2[i] : offC[h][i];
        } else uaN = has_next ? S.a_off(ui + 1, nxt, 0, rowb) : uaC;
#pragma unroll 1
        for (int t = 0; t < nt; t += 2) {
            const bool last = (t == nt - 2);
            const unsigned kb1 = (unsigned)(t + 1) * kstep, kb2 = last ? 0u : (unsigned)(t + 2) * kstep, kb3 = kb2 + kstep;
            const char* b2 = last ? nB : cB + (size_t)(t + 2) * kstep; const char* b3 = b2 + kstep;
            PG8_LDB(B0, 0, 0); PG8_LDB(B1, 0, 1); PG8_SCHED; PG8_LDA(At, 0, 0); PG8_STAGEA(PG8_SA(1, 1), 1, false, kb1);
            PG8_WAIT_V(8); PG8_WAIT_L(0); PG8_BAR; PG8_MMA(0, 0, At, B0); PG8_MMA(0, 1, At, B1); PG8_BAR; PG8_SCHED;
            PG8_LDA(At, 0, 1); PG8_STAGE(PG8_SB(0, 0), b2, voffB); PG8_STAGE(PG8_SB(0, 1), b2 + hstep, voffB); PG8_STAGEA(PG8_SA(0, 0), 0, last, kb2);
            PG8_WAIT_V(8); PG8_WAIT_L(0); PG8_BAR; PG8_MMA(1, 0, At, B0); PG8_MMA(1, 1, At, B1); PG8_BAR; PG8_SCHED;
            PG8_LDB(B0, 1, 0); PG8_LDB(B1, 1, 1); PG8_SCHED; PG8_LDA(At, 1, 0); PG8_STAGEA(PG8_SA(0, 1), 1, last, kb2);
            PG8_WAIT_V(8); PG8_WAIT_L(0); PG8_BAR; PG8_MMA(0, 0, At, B0); PG8_MMA(0, 1, At, B1); PG8_BAR; PG8_SCHED;
            PG8_LDA(At, 1, 1); PG8_STAGE(PG8_SB(1, 0), b3, voffB); PG8_STAGE(PG8_SB(1, 1), b3 + hstep, voffB); PG8_STAGEA(PG8_SA(1, 0), 0, last, kb3);
            PG8_WAIT_V(8); PG8_WAIT_L(0); PG8_BAR; PG8_MMA(1, 0, At, B0); PG8_MMA(1, 1, At, B1); PG8_BAR; PG8_SCHED;
        }
        if constexpr (ALIGN_EPI) { if (wr == 0) PG8_BAR; }
        if constexpr (I8) {
#pragma unroll
            for (int a = 0; a < 2; ++a)
#pragma unroll
                for (int b = 0; b < 2; ++b)
#pragma unroll
                    for (int m = 0; m < 4; ++m)
#pragma unroll
                        for (int n = 0; n < 2; ++n) { const i32x4 iv = __builtin_bit_cast(i32x4, acc[a][b][m][n]); acc[a][b][m][n] = (f32x4){(float)iv[0], (float)iv[1], (float)iv[2], (float)iv[3]}; } }
        E(acc, cur, wr, wc, fr, fq);
        if (!has_next) break;
#pragma unroll
        for (int a = 0; a < 2; ++a)
#pragma unroll
            for (int b = 0; b < 2; ++b)
#pragma unroll
                for (int m = 0; m < 4; ++m)
#pragma unroll
                    for (int n = 0; n < 2; ++n) acc[a][b][m][n] = (f32x4){0.f, 0.f, 0.f, 0.f};
        cur = nxt; cB = nB; ++ui; uaC = uaN;
        if constexpr (Sched::GATHER) {
#pragma unroll
            for (int h = 0; h < 2; ++h)
#pragma unroll
                for (int i = 0; i < 2; ++i) offC[h][i] = offN[h][i]; }
        if constexpr (ALIGN_EPI) { if (wr == 1) PG8_BAR; }
    }
    PG8_WAIT_V(0);
    if constexpr (!ALIGN_EPI) { if (wr == 0) PG8_BAR; }
    PG8_BAR;
#undef PG8_SA
#undef PG8_SB
#undef PG8_STAGE
#undef PG8_STAGEA
#undef PG8_LDA
#undef PG8_LDB
#undef PG8_MMA
#undef PG8_WAIT_V
#undef PG8_WAIT_L
#undef PG8_BAR
#undef PG8_SCHED
}
}
#include <hip/hip_bf16.h>
#include <cmath>
namespace attn_body {
using bf16=__hip_bfloat16;
using bf16x8=__attribute__((ext_vector_type(8)))short;
using s16x4=__attribute__((ext_vector_type(4)))short;
using f32x16=__attribute__((ext_vector_type(16)))float;
using u32x4=__attribute__((ext_vector_type(4)))unsigned;
constexpr int BATCH=4,NHEAD=16,SEQ=4096,D=64,DM=NHEAD*D;
constexpr int NW=8,QBLK=32,QB=QBLK*NW,KVBLK=64,NQB=SEQ/QB;
constexpr int ATTN_PITCH=DM, ATTN_UNIT_ROWS=QB;
__device__ __forceinline__ int crow(int r,int hi){return (r&3)+8*(r>>2)+4*hi;}
#define SBAR() __builtin_amdgcn_sched_barrier(0)
__device__ __forceinline__ void cmask(f32x16&p0,f32x16&p1,int jb,int qrel,int hi){
  const float NEG=-INFINITY; int kb=64*jb+4*hi;
  #pragma unroll
  for(int r=0;r<16;++r){int kv=kb+(r&3)+8*(r>>2); if(kv>qrel)p0[r]=NEG; if(kv+32>qrel)p1[r]=NEG;}
}

constexpr int NSLOT=3, SLOTB=8192;
constexpr int LDS_K=0, LDS_V=NSLOT*SLOTB, LDS_WS=2*NSLOT*SLOTB, LDS_OST=LDS_WS+NW*64*4, LDS_KB=LDS_OST+NW*4096, LDS_BYTES=LDS_KB+SEQ*4+256;
constexpr float C2=0.125f*1.4426950408889634f;
__device__ __forceinline__ void glds16(const void*gsrc,unsigned lds_dst){unsigned keep;
  asm volatile("s_mov_b32 %0, m0\n\ts_mov_b32 m0, %2\n\ts_nop 0\n\tglobal_load_lds_dwordx4 %1, off\n\ts_mov_b32 m0, %0":"=&s"(keep):"v"(gsrc),"s"(lds_dst):"memory");}
__device__ __forceinline__ float max3f(float a,float b,float c){float r;asm("v_max3_f32 %0, %1, %2, %3":"=v"(r):"v"(a),"v"(b),"v"(c));return r;}
__device__ __forceinline__ float max2f(float a,float b){float r;asm("v_max_f32_e32 %0, %1, %2":"=v"(r):"v"(a),"v"(b));return r;}
__device__ __forceinline__ float fadd_s(float a,float b){float r;asm("v_add_f32_e32 %0, %1, %2":"=v"(r):"v"(a),"v"(b));return r;}
__device__ __forceinline__ float fsub_s(float a,float b){float r;asm("v_sub_f32_e32 %0, %1, %2":"=v"(r):"v"(a),"v"(b));return r;}
typedef float f32x2_t __attribute__((ext_vector_type(2))); typedef __bf16 bf16x2_t __attribute__((ext_vector_type(2)));
__device__ __forceinline__ unsigned cvtpk_s(float lo,float hi){f32x2_t v={lo,hi};bf16x2_t b=__builtin_convertvector(v,bf16x2_t);return __builtin_bit_cast(unsigned,b);}
#define WAIT_BAR(N) asm volatile("s_waitcnt vmcnt(" #N ") lgkmcnt(0)\n\ts_barrier":::"memory")

__device__ __forceinline__ void qkt(f32x16&p0,f32x16&p1,const char*Kslot,const bf16x8*qr,int r32,int hi){
  const char*kb=Kslot+hi*1024+r32*16;
  #pragma unroll
  for(int d0=0;d0<4;++d0){
    const bf16x8 b0=*reinterpret_cast<const bf16x8*>(kb+d0*2048);
    const bf16x8 b1=*reinterpret_cast<const bf16x8*>(kb+d0*2048+512);
    p0=__builtin_amdgcn_mfma_f32_32x32x16_bf16(b0,qr[d0],p0,0,0,0);p1=__builtin_amdgcn_mfma_f32_32x32x16_bf16(b1,qr[d0],p1,0,0,0);}
}
typedef __attribute__((address_space(3))) const char* lds_cptr;
typedef short v4i16_t __attribute__((ext_vector_type(4)));
__device__ __forceinline__ void kload8(bf16x8*kf,lds_cptr kp){
  kf[0]=*(const __attribute__((address_space(3))) bf16x8*)(kp);      kf[1]=*(const __attribute__((address_space(3))) bf16x8*)(kp+512);
  kf[2]=*(const __attribute__((address_space(3))) bf16x8*)(kp+2048); kf[3]=*(const __attribute__((address_space(3))) bf16x8*)(kp+2560);
  kf[4]=*(const __attribute__((address_space(3))) bf16x8*)(kp+4096); kf[5]=*(const __attribute__((address_space(3))) bf16x8*)(kp+4608);
  kf[6]=*(const __attribute__((address_space(3))) bf16x8*)(kp+6144); kf[7]=*(const __attribute__((address_space(3))) bf16x8*)(kp+6656);
}
__device__ __forceinline__ void kload2(bf16x8*kf,lds_cptr kp,int j){ kf[2*j]=*(const __attribute__((address_space(3))) bf16x8*)(kp+j*2048); kf[2*j+1]=*(const __attribute__((address_space(3))) bf16x8*)(kp+j*2048+512); }
__device__ __forceinline__ s16x4 vtr(lds_cptr p){ return __builtin_bit_cast(s16x4,__builtin_amdgcn_ds_read_tr16_b64_v4i16((__attribute__((address_space(3))) v4i16_t*)p)); }
__device__ __forceinline__ float rowmax(const f32x16&p0,const f32x16&p1){
  float a=max3f(p0[0],p0[1],p1[0]),b=max3f(p0[2],p0[3],p1[1]);a=max3f(a,p1[2],p1[3]);
  #pragma unroll
  for(int r=4;r<16;r+=4){a=max3f(a,p0[r],p0[r+1]);b=max3f(b,p0[r+2],p0[r+3]);a=max3f(a,p1[r],p1[r+1]);b=max3f(b,p1[r+2],p1[r+3]);}
  const float m=max2f(a,b);
  auto rr=__builtin_amdgcn_permlane32_swap(__float_as_uint(m),__float_as_uint(m),false,false);
  return max2f(__uint_as_float(rr[0]),__uint_as_float(rr[1]));
}
__device__ __forceinline__ void pv(f32x16*o,int vb,bf16x8 pa0,bf16x8 pa1,bf16x8 pa2,bf16x8 pa3){
  #pragma unroll
  for(int d0=0;d0<2;++d0){s16x4 lo[4],hi[4];
    #pragma unroll
    for(int ks=0;ks<4;++ks){
      asm volatile("ds_read_b64_tr_b16 %0,%1 offset:%c2":"=&v"(lo[ks]):"v"(vb),"i"(d0*4096+ks*1024):"memory");
      asm volatile("ds_read_b64_tr_b16 %0,%1 offset:%c2":"=&v"(hi[ks]):"v"(vb),"i"(d0*4096+ks*1024+512):"memory");}
    asm volatile("s_waitcnt lgkmcnt(0)":::"memory");SBAR();
    #define PK(k) (bf16x8){lo[k][0],lo[k][1],lo[k][2],lo[k][3],hi[k][0],hi[k][1],hi[k][2],hi[k][3]}
    o[d0]=__builtin_amdgcn_mfma_f32_32x32x16_bf16(pa0,PK(0),o[d0],0,0,0);
    o[d0]=__builtin_amdgcn_mfma_f32_32x32x16_bf16(pa1,PK(1),o[d0],0,0,0);
    o[d0]=__builtin_amdgcn_mfma_f32_32x32x16_bf16(pa2,PK(2),o[d0],0,0,0);
    o[d0]=__builtin_amdgcn_mfma_f32_32x32x16_bf16(pa3,PK(3),o[d0],0,0,0);
    #undef PK
  }
}

#ifndef ATTN_STORE16
#define ATTN_STORE16(p,v) (*(u32x4*)(p)=(v))
#endif
typedef float f32x4v __attribute__((ext_vector_type(4)));
template<int THRL> __device__ __forceinline__ void attn_unit(int b,int h,int qb,const bf16*Q,const bf16*__restrict__ K,const bf16*__restrict__ V,bf16*O,const float*__restrict__ KBg,float qk2max,char*shm,int wave_id){
  const int wid=wave_id,lane=hw_lane(),tid=wid*64+lane,r32=lane&31,hi=lane>>5;
  const long rowbase=(long)b*SEQ; const int q0=qb*QB;
  const bf16*Qw=Q+(rowbase+q0+wid*QBLK)*DM+h*D;
  int ts=0;
  { const int NT0=(q0+QB)/KVBLK; const float lim=KBg[q0]-2.0f*__builtin_sqrtf(qk2max)-32.0f;
    const float kbl=(lane<NT0)?KBg[64*lane+63]:INFINITY; const unsigned long long bal=__ballot(kbl<lim);
    ts=(int)__builtin_popcountll(bal)&~1; if(ts>NT0-4)ts=NT0-4; ts=__builtin_amdgcn_readfirstlane(ts); }
  KBg+=ts*KVBLK;
  const bf16*Kh=K+(rowbase+(long)ts*KVBLK)*DM+h*D,*Vh=V+(rowbase+(long)ts*KVBLK)*DM+h*D;
  const unsigned lds0=(unsigned)(uintptr_t)shm;
  float*wsf=(float*)(shm+LDS_WS)+wid*64;
  const bf16*ksrc=Kh+(long)lane*DM+wid*8;
  const bf16*vsrc=Vh+(long)(16*(wid&3)+(lane>>2))*DM+(wid>>2)*32+(lane&3)*8;
  const unsigned kdst=lds0+LDS_K+wid*1024, vdst=lds0+LDS_V+wid*1024;
  #define DMA_K(t,slot) glds16(ksrc+(long)(t)*KVBLK*DM,(unsigned)__builtin_amdgcn_readfirstlane(kdst+(slot)))
  #define DMA_V(t,slot) glds16(vsrc+(long)(t)*KVBLK*DM,(unsigned)__builtin_amdgcn_readfirstlane(vdst+(slot)))
  const int vb0=(int)(lds0+LDS_V)+((lane>>4)&1)*32+(lane&3)*8+(4*hi+((lane&15)>>2))*64;
  const char*Kbase=shm+LDS_K; bf16x8 kf[8];
  const lds_cptr shm3=(lds_cptr)shm; const lds_cptr kp0=shm3+LDS_K+hi*1024+r32*16; const lds_cptr vp0=shm3+LDS_V+((lane>>4)&1)*32+(lane&3)*8+(4*hi+((lane&15)>>2))*64;
  const int NT=(q0+QB)/KVBLK-ts;
  const int nkb4=(q0+QB-ts*KVBLK)>>2; f32x4v kbt0=(f32x4v){0.f,0.f,0.f,0.f},kbt1=kbt0;
  { const f32x4v*src=(const f32x4v*)KBg; if(tid<nkb4)kbt0=src[tid]; if(tid+512<nkb4)kbt1=src[tid+512]; }
  DMA_K(0,0);DMA_V(0,0);DMA_K(1,SLOTB);
  bf16x8 qr[4];
  #pragma unroll
  for(int d0=0;d0<4;++d0)qr[d0]=*reinterpret_cast<const bf16x8*>(&Qw[(long)r32*DM+d0*16+hi*8]);
  { __attribute__((address_space(3))) f32x4v*kd=(__attribute__((address_space(3))) f32x4v*)((lds_cptr)shm+LDS_KB); if(tid<nkb4)kd[tid]=kbt0; if(tid+512<nkb4)kd[tid+512]=kbt1; }
  const lds_cptr kbp=(lds_cptr)shm+LDS_KB+hi*16;
  #define KBV(t,g8) (*(const __attribute__((address_space(3))) f32x4v*)(kbp+(t)*256+(g8)*32))
  float mhat=0.f,l_reg=0.f;f32x16 o[2];o[0]=f32x16{};o[1]=f32x16{};
  const int qrel=wid*QBLK+r32;
  #define CMASK(P0,P1,t) do{int jb_=(t)-(NT-4); if(jb_>=0)cmask(P0,P1,jb_,qrel,hi);}while(0)
  bool resc=false;
  #define START(P0,P1) do{ const float rm=rowmax(P0,P1); resc=false; \
    { const float dl=rm; mhat=fadd_s(mhat,dl); \
      _Pragma("unroll") for(int r=0;r<16;++r){P0[r]=fsub_s(P0[r],dl);P1[r]=fsub_s(P1[r],dl);} } \
    _Pragma("unroll") for(int r=0;r<16;++r)P0[r]=__builtin_amdgcn_exp2f(P0[r]); }while(0)
  #define RESC() do{ if(resc){ asm volatile("s_waitcnt lgkmcnt(0)":::"memory"); \
      _Pragma("unroll") for(int d_=0;d_<2;++d_) _Pragma("unroll") for(int r=0;r<16;++r)o[d_][r]*=wsf[crow(r,hi)]; } }while(0)
  f32x16 pA0,pA1,pB0,pB1;
  int sl_prev=0,sl_cur=0,sl_next=SLOTB;
  #define ROT() do{sl_prev=sl_cur;sl_cur=sl_next;sl_next=(sl_next==(NSLOT-1)*SLOTB)?0:sl_next+SLOTB;}while(0)
  DMA_K(2,2*SLOTB);
  WAIT_BAR(3);
  #define KBINIT(P0,P1,t) do{ _Pragma("unroll") for(int g_=0;g_<4;++g_){ const f32x4v a_=KBV(t,g_),b_=KBV(t,g_+4); \
      P0[4*g_]=a_[0]-mhat;P0[4*g_+1]=a_[1]-mhat;P0[4*g_+2]=a_[2]-mhat;P0[4*g_+3]=a_[3]-mhat; P1[4*g_]=b_[0]-mhat;P1[4*g_+1]=b_[1]-mhat;P1[4*g_+2]=b_[2]-mhat;P1[4*g_+3]=b_[3]-mhat; } }while(0)
  KBINIT(pA0,pA1,0);
  qkt(pA0,pA1,Kbase,qr,r32,hi);asm volatile("s_nop 15\n\ts_nop 7":"+v"(pA0),"+v"(pA1));CMASK(pA0,pA1,0);
  START(pA0,pA1);
  _Pragma("unroll") for(int r=0;r<16;++r)pA1[r]=__builtin_amdgcn_exp2f(pA1[r]);
  WAIT_BAR(0);
  DMA_K(3,0);DMA_V(1,SLOTB);
  ROT();
  kload8(kf,kp0+sl_cur);
  KBINIT(pB0,pB1,1);
  WAIT_BAR(2);
  s16x4 vlo[8],vhi[8]; u32x4 pw0,pw1,pw2,pw3;
  #define PKW(P,B) cvtpk_s(P[B],P[B+1])
  #define PAF(k) __builtin_bit_cast(bf16x8,pw##k)
  #define VFR(i) (bf16x8){vlo[i][0],vlo[i][1],vlo[i][2],vlo[i][3],vhi[i][0],vhi[i][1],vhi[i][2],vhi[i][3]}
  #define PIN(x) asm volatile("":"+v"(x))
  #define MX3(a,b,c) __builtin_fmaxf(__builtin_fmaxf((a),(b)),(c))
  #define GAPA(MF,A0,A1,A2,A3,W0,W1,PW) do{ MF; sacc+=A0; sacc+=A1; sacc+=A2; sacc+=A3; PIN(sacc); W0; W1; PIN(PW); SBAR(); }while(0)
  #define EX(v) __builtin_amdgcn_exp2f(v)
  #define GAPB(MF,X,B,Y,KU,KL,G8N,t) do{ if((G8N)>=0){KL=KBV((t)+1,(G8N)<0?0:(G8N));} MF; X[B]=EX(X[B]); X[B+1]=EX(X[B+1]); X[B+2]=EX(X[B+2]); X[B+3]=EX(X[B+3]); PIN(X); \
      Y[B]=KU[0]-mhat; Y[B+1]=KU[1]-mhat; Y[B+2]=KU[2]-mhat; Y[B+3]=KU[3]-mhat; PIN(Y); SBAR(); }while(0)
  #define VRD(i) do{ vlo[i]=vtr(vp_+(((i)>>2)*4096+((i)&3)*1024)); vhi[i]=vtr(vp_+(((i)>>2)*4096+((i)&3)*1024+512)); }while(0)
  #define KRD(G,j) do{ if(G){ kload2(kf,kp0+sl_next,j); SBAR(); } }while(0)
  #define STEP(C0,C1,P0,P1,t,GK,GV,GL) do{ SBAR(); \
    const lds_cptr vp_=vp0+sl_prev; \
    VRD(0); SBAR(); float sacc=(P0[0]+P0[1]); \
    GAPA(C0=__builtin_amdgcn_mfma_f32_32x32x16_bf16(kf[0],qr[0],C0,0,0,0), P0[2],P0[3],P0[4],P0[5],     pw0[0]=PKW(P0,0), pw0[1]=PKW(P0,2), pw0); \
    VRD(4); SBAR(); GAPA(C1=__builtin_amdgcn_mfma_f32_32x32x16_bf16(kf[1],qr[0],C1,0,0,0), P0[6],P0[7],P0[8],P0[9],     pw0[2]=PKW(P0,4), pw0[3]=PKW(P0,6), pw0); \
    VRD(1); SBAR(); GAPA(C0=__builtin_amdgcn_mfma_f32_32x32x16_bf16(kf[2],qr[1],C0,0,0,0),   P0[10],P0[11],P0[12],P0[13], pw1[0]=PKW(P0,8), pw1[1]=PKW(P0,10), pw1); \
    VRD(5); SBAR(); GAPA(C1=__builtin_amdgcn_mfma_f32_32x32x16_bf16(kf[3],qr[1],C1,0,0,0),   P0[14],P0[15],P1[0],P1[1],   pw1[2]=PKW(P0,12),pw1[3]=PKW(P0,14), pw1); \
    VRD(2); SBAR(); GAPA(C0=__builtin_amdgcn_mfma_f32_32x32x16_bf16(kf[4],qr[2],C0,0,0,0),   P1[2],P1[3],P1[4],P1[5],     pw2[0]=PKW(P1,0), pw2[1]=PKW(P1,2), pw2); \
    VRD(6); SBAR(); GAPA(C1=__builtin_amdgcn_mfma_f32_32x32x16_bf16(kf[5],qr[2],C1,0,0,0),   P1[6],P1[7],P1[8],P1[9],     pw2[2]=PKW(P1,4), pw2[3]=PKW(P1,6), pw2); \
    VRD(3); SBAR(); GAPA(C0=__builtin_amdgcn_mfma_f32_32x32x16_bf16(kf[6],qr[3],C0,0,0,0),   P1[10],P1[11],P1[12],P1[13], pw3[0]=PKW(P1,8), pw3[1]=PKW(P1,10), pw3); \
    VRD(7); SBAR(); GAPA(C1=__builtin_amdgcn_mfma_f32_32x32x16_bf16(kf[7],qr[3],C1,0,0,0),   P1[14],P1[15],0.f,0.f,       pw3[2]=PKW(P1,12),pw3[3]=PKW(P1,14), pw3); \
    l_reg+=sacc; \
    if(GK){DMA_K((t)+3,sl_cur);} if(GV){DMA_V((t)+1,sl_next);} \
    CMASK(C0,C1,t); \
    { float a=MX3(C0[0],C0[1],C1[0]),b=MX3(C0[2],C0[3],C1[1]); a=MX3(a,C1[2],C1[3]); \
      _Pragma("unroll") for(int r=4;r<16;r+=4){a=MX3(a,C0[r],C0[r+1]);b=MX3(b,C0[r+2],C0[r+3]);a=MX3(a,C1[r],C1[r+1]);b=MX3(b,C1[r+2],C1[r+3]);} \
      float rm=__builtin_fmaxf(a,b); { auto rr=__builtin_amdgcn_permlane32_swap(__float_as_uint(rm),__float_as_uint(rm),false,false); rm=__builtin_fmaxf(__uint_as_float(rr[0]),__uint_as_float(rr[1])); } \
      resc=false; \
      if(__builtin_expect(__any(rm>(float)THRL),0)){ const float dl=__builtin_fmaxf(rm,0.f); mhat+=dl; \
        _Pragma("unroll") for(int r=0;r<16;++r){C0[r]-=dl;C1[r]-=dl;} \
        const float f=__builtin_amdgcn_exp2f(-dl); l_reg*=f; if(hi==0)wsf[r32]=f; resc=true; } } \
    SBAR(); \
    f32x4v kq0_=KBV((t)+1,0),kq1_; \
    GAPB(o[0]=__builtin_amdgcn_mfma_f32_32x32x16_bf16(PAF(0),VFR(0),o[0],0,0,0), C0,0, P0,kq0_,kq1_,1,t); \
    GAPB(o[1]=__builtin_amdgcn_mfma_f32_32x32x16_bf16(PAF(0),VFR(4),o[1],0,0,0), C0,4, P0,kq1_,kq0_,2,t); \
    KRD(GL,0); GAPB(o[0]=__builtin_amdgcn_mfma_f32_32x32x16_bf16(PAF(1),VFR(1),o[0],0,0,0), C0,8, P0,kq0_,kq1_,3,t); \
    KRD(GL,1); GAPB(o[1]=__builtin_amdgcn_mfma_f32_32x32x16_bf16(PAF(1),VFR(5),o[1],0,0,0), C0,12, P0,kq1_,kq0_,4,t); \
    KRD(GL,2); GAPB(o[0]=__builtin_amdgcn_mfma_f32_32x32x16_bf16(PAF(2),VFR(2),o[0],0,0,0), C1,0, P1,kq0_,kq1_,5,t); \
    KRD(GL,3); GAPB(o[1]=__builtin_amdgcn_mfma_f32_32x32x16_bf16(PAF(2),VFR(6),o[1],0,0,0), C1,4, P1,kq1_,kq0_,6,t); \
    GAPB(o[0]=__builtin_amdgcn_mfma_f32_32x32x16_bf16(PAF(3),VFR(3),o[0],0,0,0), C1,8, P1,kq0_,kq1_,7,t); \
    GAPB(o[1]=__builtin_amdgcn_mfma_f32_32x32x16_bf16(PAF(3),VFR(7),o[1],0,0,0), C1,12, P1,kq1_,kq0_,-1,t); \
    }while(0)
  int t=1;
  #undef CMASK
  #define CMASK(P0,P1,t) do{}while(0)
  for(;t+5<NT;t+=2){
    STEP(pB0,pB1,pA0,pA1,t,true,true,true);     WAIT_BAR(2); RESC(); ROT();
    STEP(pA0,pA1,pB0,pB1,t+1,true,true,true);   WAIT_BAR(2); RESC(); ROT();
  }
  #undef CMASK
  #define CMASK(P0,P1,t) do{int jb_=(t)-(NT-4); if(jb_>=0)cmask(P0,P1,jb_,qrel,hi);}while(0)
  #define ENDW(tt) do{ if((tt)+3<NT){WAIT_BAR(2);} else if((tt)+2<NT){WAIT_BAR(1);} else {WAIT_BAR(0);} }while(0)
  for(;t+1<NT;t+=2){
    STEP(pB0,pB1,pA0,pA1,t,(t+3<NT),(t+1<NT),(t+1<NT));       ENDW(t);   RESC(); ROT();
    STEP(pA0,pA1,pB0,pB1,t+1,(t+4<NT),(t+2<NT),(t+2<NT));     ENDW(t+1); RESC(); ROT();
  }
  STEP(pB0,pB1,pA0,pA1,NT-1,false,false,false); RESC();
  { float sacc=pB0[0]+pB0[1]; _Pragma("unroll") for(int r=2;r<16;++r)sacc+=pB0[r]; _Pragma("unroll") for(int r=0;r<16;++r)sacc+=pB1[r]; l_reg+=sacc;
    pw0=(u32x4){PKW(pB0,0),PKW(pB0,2),PKW(pB0,4),PKW(pB0,6)};pw1=(u32x4){PKW(pB0,8),PKW(pB0,10),PKW(pB0,12),PKW(pB0,14)};pw2=(u32x4){PKW(pB1,0),PKW(pB1,2),PKW(pB1,4),PKW(pB1,6)};pw3=(u32x4){PKW(pB1,8),PKW(pB1,10),PKW(pB1,12),PKW(pB1,14)};
    SBAR(); pv(o,vb0+sl_cur,PAF(0),PAF(1),PAF(2),PAF(3)); }
  #undef PKW
  #undef PAF
  #undef VFR
  #undef PIN
  #undef MX3
  #undef GAPA
  #undef GAPB
  #undef EX
  #undef VRD
  #undef KRD
  #undef STEP
  #undef ENDW
  {auto rr=__builtin_amdgcn_permlane32_swap(__float_as_uint(l_reg),__float_as_uint(l_reg),false,false);l_reg=__uint_as_float(rr[0])+__uint_as_float(rr[1]);}
  if(hi==0)wsf[32+r32]=l_reg;asm volatile("s_waitcnt lgkmcnt(0)":::"memory");
  float rli[16];
  #pragma unroll
  for(int r=0;r<16;++r)rli[r]=__builtin_amdgcn_rcpf(wsf[32+crow(r,hi)]);
  bf16*Ow=O+(rowbase+q0+wid*QBLK)*DM+h*D;
  { bf16*stg=(bf16*)(shm+LDS_OST)+wid*2048;
    #pragma unroll
    for(int r=0;r<16;++r){const int orow=crow(r,hi);
      #pragma unroll
      for(int d0=0;d0<2;++d0)stg[orow*64+d0*32+r32]=__float2bfloat16(o[d0][r]*rli[r]);}
    asm volatile("s_waitcnt lgkmcnt(0)":::"memory");
    #pragma unroll
    for(int i=0;i<4;++i){const int row=i*8+(lane>>3),ch=lane&7; const u32x4 v=*(const u32x4*)(stg+row*64+ch*8); ATTN_STORE16(Ow+(long)row*DM+ch*8,v);} }
  asm volatile("s_waitcnt lgkmcnt(0)\n\ts_barrier":::"memory");
  #undef DMA_K
  #undef DMA_V
  #undef KBV
  #undef KBINIT
  #undef CMASK
  #undef START
  #undef RESC
  #undef ROT
}
constexpr int ATTN_LDS_BYTES=LDS_BYTES;
struct AttnTensors { const bf16* Q; const bf16* K; const bf16* V; bf16* O; const float* KB; const unsigned* QN2; const unsigned* KN2; };
struct AttnUnit { int bh; int qb; };
struct StaticOrder {
  int vcu, G, i0, i1;
  __device__ __forceinline__ explicit StaticOrder(int grid,int block):vcu((grid%8==0)?(block%8)*(grid/8)+block/8:block),G(grid),i0(0),i1(0x7fffffff){}
  __device__ __forceinline__ bool next(int i_,AttnUnit&u)const{ if(i_>=i1-i0)return false; const int i=i_+i0;
    if(G==256){ if(i>=4)return false; const int s=vcu&3; u.bh=vcu>>2; u.qb=(i==0)?s:(i==1)?7-s:(i==2)?8+s:15-s; return true; }
    const int L=i*G+vcu; if(L>=BATCH*NHEAD*NQB)return false; u.qb=NQB-1-L/(BATCH*NHEAD); u.bh=L%(BATCH*NHEAD); return true; }
  __device__ __forceinline__ void a_ready(const AttnUnit&)const{}
  __device__ __forceinline__ void done(const AttnUnit&)const{}
};
template<class Sched,int THRL=8> __device__ __forceinline__ void attn_phase(char*lds,const AttnTensors&T,const Sched&S,int wave_id){
  AttnUnit u;
  for(int i=0;S.next(i,u);++i){ S.a_ready(u); attn_unit<THRL>(u.bh/NHEAD,u.bh%NHEAD,u.qb,T.Q,T.K,T.V,T.O,T.KB+(size_t)u.bh*SEQ,__uint_as_float(T.QN2[u.bh*NQB+u.qb])*__uint_as_float(T.KN2[u.bh]),lds,wave_id); S.done(u); }
}
#undef SBAR
#undef WAIT_BAR
}
constexpr int NWAVES = 8;
#ifndef MK_N_LAUNCHES
#define MK_N_LAUNCHES 1
#endif
constexpr int PER_PHASE = 10;
constexpr int N_LAUNCHES = MK_N_LAUNCHES;

constexpr int BATCH = 4, SEQ = 4096, D = 1024, M = BATCH * SEQ;
constexpr int IN_COLS = 7184, NPROJ = 7168, FCOL0 = 5120;
constexpr int NE = 32, DFF = 1024, MAXTILES = 288, SLOTS = MAXTILES * 256;
constexpr int LRU_TS = 128, LRU_NSEG = SEQ / LRU_TS, LRU_UNITS = BATCH * 16 * LRU_NSEG;
constexpr float RMS_EPS = 1e-6f, LOG2E = 1.4426950408889634f;
constexpr float W8_SCALE = 127.0f * 32.0f / 4.0f, H8_SCALE = 127.0f / 4.0f, ACT8_SCALE = 127.0f / 8.0f, Y8_SCALE = 127.0f / 4.0f;

constexpr size_t MiB = 1u << 20;
constexpr size_t WS_CTL = 0, CTL_ZERO_BYTES = 128 * 1024;
constexpr size_t WS_WIN = 2 * MiB, WS_WLRU = 16 * MiB, WS_WFOX = 18 * MiB, WS_WO = 20 * MiB;
constexpr size_t WS_WG = 22 * MiB, WS_SP = 22 * MiB + 512 * 1024;
constexpr size_t WS_LOGF = 23 * MiB, WS_KB = 24 * MiB, WS_SEG = 25 * MiB, WS_ROUTE = 26 * MiB, WS_TOKMAP = 27 * MiB;
constexpr size_t WS_H2 = 960 * MiB;
constexpr size_t WS_H = 32 * MiB;
constexpr size_t WS_WGU = 64 * MiB, WS_WD = 192 * MiB;
constexpr size_t WS_PROJ = 256 * MiB, PROJ_STRIDE = 32 * MiB;
constexpr size_t WS_YLRU = 480 * MiB, WS_TMP = 512 * MiB, WS_MERGED = 544 * MiB, WS_X1 = 576 * MiB;
constexpr size_t WS_X1B = WS_MERGED;
constexpr size_t WS_ACT = 640 * MiB, WS_Y = 784 * MiB, WS_YFOX = 928 * MiB, WS_END = 976 * MiB;
static_assert(WS_Y + (size_t)SLOTS * 1024 * 2 <= WS_YFOX && WS_ACT + (size_t)SLOTS * 1024 * 2 <= WS_Y, "d_ws map");
constexpr int CW_TMO = 0, CW_CODE = 1;
constexpr int CW_BAR = 4096;
constexpr int CW_CNT = 16384;
constexpr int CW_KN = 20480, CW_QN = 20544;                          static_assert((20544 + 64 * 16) * 4 <= 128 * 1024, "control words inside the memset region");
constexpr int CW_END_ = 0;

constexpr int RING_OFF = 0, RING_BYTES = 131072;
constexpr int LDSCTL_OFF = RING_BYTES, MISC_OFF = LDSCTL_OFF + 320, EXTRA_OFF = LDSCTL_OFF + 512;
constexpr int LDS_BYTES = 147456;
constexpr int EX_TILE_E = 0, EX_NCNT = 320, EX_TPRE = 448, EX_ROWS = 1024, EX_MAXU = 14;
static_assert(EXTRA_OFF + EX_ROWS + EX_MAXU * 1024 <= LDS_BYTES, "LDS map");

#define GAS __attribute__((address_space(1)))
#define LAS __attribute__((address_space(3)))
typedef unsigned short bf16;
typedef unsigned v4u __attribute__((ext_vector_type(4)));
typedef unsigned v2u __attribute__((ext_vector_type(2)));
typedef float f32x4 __attribute__((ext_vector_type(4)));
typedef float f32x2 __attribute__((ext_vector_type(2)));
typedef short bf16x8 __attribute__((ext_vector_type(8)));
typedef GAS unsigned gu32;
typedef GAS unsigned long long gu64;
#define RLX_AGENT __ATOMIC_RELAXED, __HIP_MEMORY_SCOPE_AGENT
#define LDS_WAIT() asm volatile("s_waitcnt lgkmcnt(0)" ::: "memory")
#define VM_WAIT() asm volatile("s_waitcnt vmcnt(0)" ::: "memory")
__device__ __forceinline__ unsigned pk2(float lo, float hi) { return pg8::cvt_pk_bf16(lo, hi); }
__device__ __forceinline__ float bflo(unsigned w) { return __uint_as_float(w << 16); }
__device__ __forceinline__ float bfhi(unsigned w) { return __uint_as_float(w & 0xffff0000u); }
__device__ __forceinline__ float sigm(float x) { return __builtin_amdgcn_rcpf(1.0f + __builtin_amdgcn_exp2f(-LOG2E * x)); }
__device__ __forceinline__ float gelu_tanh(float x) { const float u = 0.7978845608028654f * (x + 0.044715f * x * x * x); return x * sigm(2.0f * u); }

#define XB_TMO      128
#define XB_XCNT(j)  (256  + 64 * (j))
#define XB_XSUB(j)  (1280 + 64 * (j))
#define XB_XGEN(j)  (2304 + 64 * (j))
#define XB_TOP      3328
#define XB_TOPGEN   3392
#define XCD_BAR_WORDS 3456
#define XB_SPIN_CAP (1u << 18)

__device__ __forceinline__ unsigned xb_ld(unsigned* p)              { return __hip_atomic_load(p, __ATOMIC_RELAXED, __HIP_MEMORY_SCOPE_AGENT); }
__device__ __forceinline__ unsigned xb_add(unsigned* p, unsigned v) { return __hip_atomic_fetch_add(p, v, __ATOMIC_RELAXED, __HIP_MEMORY_SCOPE_AGENT); }
__device__ __forceinline__ unsigned xb_xcc_id() { return (unsigned)__builtin_amdgcn_s_getreg((3 << 11) | 20) & 0xFu; }
#define XB_SPIN(cond, bar) do { unsigned _sp = 0; while (cond) { __builtin_amdgcn_s_sleep(1); \
    if ((++_sp & 255u) == 0u) { if (xb_ld(&(bar)[XB_TMO])) break; if (_sp > XB_SPIN_CAP) { atomicAdd(&(bar)[XB_TMO], 1u); break; } } } } while (0)

struct XcdBarrier {
    unsigned* bar; unsigned x;
    volatile LAS unsigned* st;
};
__device__ __forceinline__ XcdBarrier xcd_barrier_post(unsigned* bar, volatile LAS unsigned* st) {
    XcdBarrier b; b.bar = bar; b.x = xb_xcc_id(); b.st = st;
    if (threadIdx.x == 0) (void)xb_add(&bar[XB_XCNT(b.x)], 1u);
    return b;
}
__device__ __forceinline__ void xcd_barrier_complete(unsigned* bar, unsigned x, unsigned& nloc, unsigned& nx) {
    const unsigned G = gridDim.x * gridDim.y * gridDim.z;
    unsigned sum, cnt, mine, sp = 0u;
    for (;;) {
        sum = 0u; cnt = 0u; mine = 0u;
#pragma unroll
        for (unsigned j = 0; j < 16; ++j) { const unsigned c = xb_ld(&bar[XB_XCNT(j)]); sum += c; cnt += (c > 0u) ? 1u : 0u; mine = (j == x) ? c : mine; }
        if (sum == G) break;
        __builtin_amdgcn_s_sleep(1);
        if ((++sp & 255u) == 0u) { if (xb_ld(&bar[XB_TMO])) break; if (sp > XB_SPIN_CAP) { atomicAdd(&bar[XB_TMO], 1u); break; } }
    }
    nloc = mine > 0u ? mine : 1u; nx = cnt > 0u ? cnt : 1u;
}
__device__ __forceinline__ void xcd_barrier(const XcdBarrier& b) {
    asm volatile("s_waitcnt vmcnt(0)" ::: "memory");
    __syncthreads();
    if (threadIdx.x == 0) {
        unsigned* bar = b.bar;
        __builtin_amdgcn_s_waitcnt(0);
        unsigned nloc = b.st[0], nx = b.st[1];
        if (nloc == 0u) { xcd_barrier_complete(bar, b.x, nloc, nx); b.st[0] = nloc; b.st[1] = nx; }
        const unsigned old = xb_add(&bar[XB_XSUB(b.x)], 1u);
        const unsigned gen = old / nloc;
        if (old + 1u == (gen + 1u) * nloc) {
            __builtin_amdgcn_fence(__ATOMIC_RELEASE, "agent");
            asm volatile("s_waitcnt vmcnt(0)" ::: "memory");
            const unsigned og = xb_add(&bar[XB_TOP], 1u);
            const unsigned tg = og / nx;
            if (og + 1u == (tg + 1u) * nx) xb_add(&bar[XB_TOPGEN], 1u);
            else XB_SPIN(xb_ld(&bar[XB_TOPGEN]) == tg, bar);
            __builtin_amdgcn_fence(__ATOMIC_ACQUIRE, "agent");
            xb_add(&bar[XB_XGEN(b.x)], 1u);
            asm volatile("s_waitcnt vmcnt(0)" ::: "memory");
        } else {
            XB_SPIN(xb_ld(&bar[XB_XGEN(b.x)]) == gen, bar);
            __builtin_amdgcn_fence(__ATOMIC_ACQUIRE, "agent");
            asm volatile("s_waitcnt vmcnt(0)" ::: "memory");
        }
    }
    __syncthreads();
}

struct Frame {
    LAS unsigned char* lds;
    volatile LAS unsigned* MISC;
    gu32* ctl;
    int wave;
    int vcu, G;
    const float* in[22];
    float* out;
    unsigned char* ws;
};
#define IN_X 0
#define IN_GMIX 1
#define IN_WIN 2
#define IN_CONVW 3
#define IN_CONVB 4
#define IN_WRG 5
#define IN_BRG 6
#define IN_WIG 7
#define IN_BIG 8
#define IN_LAMBDA 9
#define IN_BF 10
#define IN_WLRU 11
#define IN_WFOX 12
#define IN_WO 13
#define IN_GFFN 14
#define IN_WROUTER 15
#define IN_BROUTER 16
#define IN_WGU 17
#define IN_BGU 18
#define IN_WD 19
#define IN_BD 20
#define IN_GFINAL 21

__device__ __forceinline__ float wave_sum(float v) {
#pragma unroll
    for (int o = 1; o < 64; o <<= 1) v += __shfl_xor(v, o);
    return v;
}
__device__ __forceinline__ float wave_max(float v) {
#pragma unroll
    for (int o = 1; o < 64; o <<= 1) v = fmaxf(v, __shfl_xor(v, o));
    return v;
}
__device__ __forceinline__ float lane_sel(float a, float b, unsigned long long m) { float r; asm("v_cndmask_b32_e64 %0, %1, %2, %3" : "=v"(r) : "v"(a), "v"(b), "s"(m)); return r; }
template <int N> __device__ __forceinline__ void xreduce(float (&f)[N], int lane) {
    (void)lane;
    constexpr unsigned long long MASKS[6] = {0xFFFFFFFF00000000ull, 0xFFFF0000FFFF0000ull, 0xFF00FF00FF00FF00ull, 0xF0F0F0F0F0F0F0F0ull, 0xCCCCCCCCCCCCCCCCull, 0xAAAAAAAAAAAAAAAAull};
    int s = 32, k = 0;
#pragma unroll
    for (int half = N / 2; half >= 1; half >>= 1, s >>= 1, ++k) {
        const unsigned long long m = MASKS[k];
#pragma unroll
        for (int i = 0; i < half; ++i) { const float keep = lane_sel(f[i], f[i + half], m), send = lane_sel(f[i + half], f[i], m); f[i] = keep + __shfl_xor(send, s); }
    }
#pragma unroll
    for (int q = 0; q < 6; ++q) if ((32 >> q) <= s && (32 >> q) >= 1 && (32 >> q) < (64 / N) ) f[0] += __shfl_xor(f[0], 32 >> q);
}
#ifndef CV_LG
#define CV_LG 4
#endif
constexpr int CV_NL = 1 << CV_LG, CV_IK = 8 * (64 >> CV_LG), CV_IN = 4 << CV_LG, CV_KB = 1024 / CV_IK;
struct CvtItem { const float* src; unsigned char* dst; int ldw, K, k0, i8; };
__device__ __forceinline__ void cvt_load(const CvtItem& c, int lane, f32x4 (&v)[8]) {
#pragma unroll
    for (int i = 0; i < 8; ++i) v[i] = __builtin_nontemporal_load((const GAS f32x4*)(c.src + (size_t)(c.k0 + 8 * (lane >> CV_LG) + i) * c.ldw + 4 * (lane & (CV_NL - 1))));
}
__device__ __forceinline__ unsigned q8_low(float x, float scale) {
    const float lim = 127.0f / scale; const float c = __builtin_amdgcn_fmed3f(x, -lim, lim); return __float_as_uint(__builtin_fmaf(c, scale, 12582912.0f)); }
__device__ __forceinline__ unsigned lo4(unsigned a, unsigned b, unsigned c, unsigned d) {
    const unsigned ab = __builtin_amdgcn_perm(b, a, 0x0c0c0400u), cd = __builtin_amdgcn_perm(d, c, 0x0c0c0400u); return ab | (cd << 16); }
__device__ __forceinline__ void cvt_store(const CvtItem& c, int lane, const f32x4 (&v)[8]) {
    const int kg = lane >> CV_LG, ng = lane & (CV_NL - 1);
    if (c.i8) {
#pragma unroll
        for (int j = 0; j < 4; ++j) { unsigned q[8];
#pragma unroll
            for (int i = 0; i < 8; ++i) q[i] = q8_low(v[i][j], W8_SCALE);
            v2u o; o.x = lo4(q[0], q[1], q[2], q[3]); o.y = lo4(q[4], q[5], q[6], q[7]);
            *(GAS v2u*)(c.dst + (size_t)(4 * ng + j) * c.K + c.k0 + 8 * kg) = o; }
    } else {
#pragma unroll
        for (int j = 0; j < 4; ++j) { v4u o; o.x = pk2(v[0][j], v[1][j]); o.y = pk2(v[2][j], v[3][j]); o.z = pk2(v[4][j], v[5][j]); o.w = pk2(v[6][j], v[7][j]);
            *(GAS v4u*)(c.dst + ((size_t)(4 * ng + j) * c.K + c.k0 + 8 * kg) * 2) = o; }
    }
}
#define LANE_TID() const int lane_ = hw_lane(); const int tid_ = F.wave * 64 + lane_
__device__ __forceinline__ void p0_prologue(Frame& F) {
    LANE_TID();
    unsigned char* ws = F.ws;
    const int gw = F.vcu * NWAVES + F.wave, NGW = F.G * NWAVES;
    {
        constexpr int I_IN = (NPROJ / CV_IN) * CV_KB;
        CvtItem c0, c1; f32x4 v0[8], v1[8];
#define P0_DEC(c, it) do { const int cb = (it) / CV_KB, kb = (it) % CV_KB, drow = CV_IN * cb, scol = drow < FCOL0 ? drow : drow + 16; \
            c.src = F.in[IN_WIN] + scol; c.ldw = IN_COLS; c.K = D; c.k0 = CV_IK * kb; c.i8 = 1; c.dst = ws + WS_WIN + (size_t)drow * D; } while (0)
        int it = gw;
        if (it < I_IN) { P0_DEC(c0, it); cvt_load(c0, lane_, v0); }
        if (it + NGW < I_IN) { P0_DEC(c1, it + NGW); cvt_load(c1, lane_, v1); }
#pragma unroll 1
        for (; it < I_IN; it += 2 * NGW) {
            cvt_store(c0, lane_, v0); if (it + 2 * NGW < I_IN) { P0_DEC(c0, it + 2 * NGW); cvt_load(c0, lane_, v0); }
            if (it + NGW < I_IN) { cvt_store(c1, lane_, v1); if (it + 3 * NGW < I_IN) { P0_DEC(c1, it + 3 * NGW); cvt_load(c1, lane_, v1); } }
        }
#undef P0_DEC
    }
    {
        const int gt = F.vcu * (NWAVES * 64) + tid_, NGT = F.G * NWAVES * 64;
        bf16* WG = (bf16*)(ws + WS_WG); const float* const w_ig_p = F.in[IN_WIG]; const float* const w_rg_p = F.in[IN_WRG];
        for (int idx = gt; idx < 2 * 16 * 64 * 64; idx += NGT) { const int i = idx & 63, j = (idx >> 6) & 63, gate = (idx >> 12) & 1, blk = idx >> 13;
            const float w = (gate ? w_ig_p : w_rg_p)[(blk * 64 + i) * 64 + j];
            WG[idx] = (bf16)(pk2(w, 0.f) & 0xffffu); }
        float* SP = (float*)(ws + WS_SP);
        for (int c = gt; c < D; c += NGT) { const float z = -F.in[IN_LAMBDA][c]; const float sp = fmaxf(z, 0.f) + log1pf(expf(-fabsf(z))); SP[c] = 8.0f * sp * LOG2E; }
    }
    __syncthreads();
    {
        LAS float* WF = (LAS float*)(F.lds + RING_OFF);
        for (int idx = tid_; idx < 16 * D; idx += NWAVES * 64) { const int c = idx >> 4, hd = idx & 15; WF[hd * D + c] = F.in[IN_WIN][(size_t)c * IN_COLS + FCOL0 + hd] * F.in[IN_GMIX][c]; }
        __syncthreads();
        f32x4 gm[4];
#pragma unroll
        for (int j = 0; j < 4; ++j) gm[j] = *((const GAS f32x4*)F.in[IN_GMIX] + lane_ + 64 * j);
        const int hd = (lane_ >> 2) & 15; const float bfv = F.in[IN_BF][hd];
        bf16* H = (bf16*)(ws + WS_H); float* LOGF = (float*)(ws + WS_LOGF);
#pragma unroll 1
        for (int m = gw; m < M; m += NGW) {
            const GAS f32x4* xr = (const GAS f32x4*)(F.in[IN_X] + (size_t)m * D) + lane_;
            f32x4 v[4]; float s = 0.f;
#pragma unroll
            for (int j = 0; j < 4; ++j) { v[j] = xr[64 * j]; s += (v[j].x * v[j].x + v[j].y * v[j].y) + (v[j].z * v[j].z + v[j].w * v[j].w); }
            const float rstd = 1.0f / sqrtf(wave_sum(s) * (1.f / D) + RMS_EPS);
            GAS unsigned* o8 = (GAS unsigned*)((unsigned char*)H + (size_t)m * D) + lane_;
#pragma unroll
            for (int j = 0; j < 4; ++j) { const f32x4 y = v[j] * (rstd * H8_SCALE) * gm[j]; o8[64 * j] = pg8::pk4_i8(y.x, y.y, y.z, y.w); }
            float f[16];
#pragma unroll
            for (int h = 0; h < 16; ++h) { float a = 0.f; f32x2 a2 = (f32x2){0.f, 0.f};
#pragma unroll
                for (int j = 0; j < 4; ++j) { const f32x4 w = *((const LAS f32x4*)(WF + h * D) + lane_ + 64 * j);
                    a2 = __builtin_elementwise_fma((f32x2){v[j].x, v[j].y}, (f32x2){w.x, w.y}, a2); a2 = __builtin_elementwise_fma((f32x2){v[j].z, v[j].w}, (f32x2){w.z, w.w}, a2); }
                a = a2.x + a2.y; f[h] = a; if ((h & 3) == 3) __builtin_amdgcn_sched_barrier(0); }
            xreduce<16>(f, lane_);
            if ((lane_ & 3) == 0) { const float z = f[0] * rstd + bfv;
                const float lf = fminf(z, 0.f) - log1pf(expf(-fabsf(z)));
                const int b = m / SEQ, t = m % SEQ; LOGF[((size_t)(b * 16 + hd)) * SEQ + t] = lf; }
        }
    }
}

__device__ __forceinline__ void lru_decode(int u, int& b, int& blk, int& seg) { seg = u >> 6; b = (u >> 4) & 3; blk = u & 15; }
struct LruConst { f32x4 brg[4], big[4], spv[4]; float cw[4][8], cb[8]; };
constexpr int LRU_XR = 0, LRU_XC = 16896, LRU_AA = 35328, LRU_BB = 70144, LRU_SM = 104960, LRU_WG = 109056;
__device__ __forceinline__ void lru_load_const(Frame& F, int blk, int tid, int lane, LruConst& C) {
    const int fr = lane & 15, fq = lane >> 4, c0 = blk * 64, ch = tid & 7;
    const bf16* WG = (const bf16*)(F.ws + WS_WG) + (size_t)blk * 2 * 64 * 64; const float* SP = (const float*)(F.ws + WS_SP);
#pragma unroll
    for (int k = 0; k < 2; ++k) { const int it = tid + 512 * k, l = it & 63, fg = it >> 6, kt = fg & 1, nt = (fg >> 1) & 3, gt = fg >> 3;
        *(LAS bf16x8*)(F.lds + RING_OFF + LRU_WG + it * 16) = *(const GAS bf16x8*)(WG + ((gt * 64 + 16 * nt + (l & 15)) * 64 + 32 * kt + 8 * (l >> 4))); }
    (void)fr; (void)fq;
#pragma unroll
    for (int nt = 0; nt < 4; ++nt) { const int j0 = 16 * nt + 4 * fq;
        C.brg[nt] = *(const GAS f32x4*)(F.in[IN_BRG] + c0 + j0); C.big[nt] = *(const GAS f32x4*)(F.in[IN_BIG] + c0 + j0); C.spv[nt] = *(const GAS f32x4*)(SP + c0 + j0); }
#pragma unroll
    for (int k = 0; k < 4; ++k) { const f32x4 a = *(const GAS f32x4*)(F.in[IN_CONVW] + k * D + c0 + ch * 8), bq = *(const GAS f32x4*)(F.in[IN_CONVW] + k * D + c0 + ch * 8 + 4);
        C.cw[k][0] = a.x; C.cw[k][1] = a.y; C.cw[k][2] = a.z; C.cw[k][3] = a.w; C.cw[k][4] = bq.x; C.cw[k][5] = bq.y; C.cw[k][6] = bq.z; C.cw[k][7] = bq.w; }
    { const f32x4 a = *(const GAS f32x4*)(F.in[IN_CONVB] + c0 + ch * 8), bq = *(const GAS f32x4*)(F.in[IN_CONVB] + c0 + ch * 8 + 4);
        C.cb[0] = a.x; C.cb[1] = a.y; C.cb[2] = a.z; C.cb[3] = a.w; C.cb[4] = bq.x; C.cb[5] = bq.y; C.cb[6] = bq.z; C.cb[7] = bq.w; }
}
__device__ __forceinline__ void lru_raw_load(Frame& F, int b, int blk, int seg, int tid, v4u (&raw)[3]) {
    const bf16* LX = (const bf16*)(F.ws + WS_PROJ); const long row0 = (long)b * SEQ + seg * LRU_TS; const int c0 = blk * 64;
#pragma unroll
    for (int k = 0; k < 3; ++k) { const int idx = tid + 512 * k, r = idx >> 3, ch = idx & 7; raw[k] = (v4u){0u, 0u, 0u, 0u};
        if (idx < 131 * 8 && (seg > 0 || r >= 3)) raw[k] = *(const GAS v4u*)(LX + (row0 + r - 3) * D + c0 + ch * 8); }
}
__device__ __forceinline__ void lru_raw_store(Frame& F, int tid, const v4u (&raw)[3]) {
    LAS unsigned char* L = F.lds + RING_OFF;
#pragma unroll
    for (int k = 0; k < 3; ++k) { const int idx = tid + 512 * k, r = idx >> 3, ch = idx & 7; if (idx < 131 * 8) *(LAS v4u*)(L + LRU_XR + r * 128 + ch * 16) = raw[k]; }
}
template <int PASS>
__device__ __forceinline__ void lru_run(Frame& F) {
    LAS unsigned char* L = F.lds + RING_OFF;
    const int lane = hw_lane(), w = F.wave, tid = w * 64 + lane, fr = lane & 15, fq = lane >> 4;
    const bf16* LG = (const bf16*)(F.ws + WS_PROJ + PROJ_STRIDE);
    LAS float* HIN = (LAS float*)(F.lds + EXTRA_OFF);
    int nun = 0; for (int u = F.vcu; u < LRU_UNITS; u += F.G) ++nun;
    if (nun == 0) return;
    if (nun > 56) nun = 56;
    if (PASS == 1) {
        const f32x2* SEGp = (const f32x2*)(F.ws + WS_SEG);
        for (int i = tid >> 6; i < nun; i += NWAVES) { const int u = i * F.G + F.vcu, c = tid & 63; int b, blk, seg; lru_decode(u, b, blk, seg); float Hc = 0.f;
            const GAS f32x2* sp = (const GAS f32x2*)SEGp + (size_t)(b * LRU_NSEG) * D + blk * 64 + c;
            for (int s0 = 0; s0 < seg; s0 += 8) { f32x2 v[8];
#pragma unroll
                for (int k = 0; k < 8; ++k) { const int s = s0 + k; v[k] = sp[(size_t)(s < seg ? s : 0) * D]; if (s >= seg) v[k] = (f32x2){1.f, 0.f}; }
#pragma unroll
                for (int k = 0; k < 8; ++k) Hc = v[k].x * Hc + v[k].y; }
            HIN[i * 64 + c] = Hc; }
    }
    LruConst C; int cur_blk = -1;
    { int b, blk, seg; lru_decode(F.vcu, b, blk, seg); v4u raw[3]; lru_raw_load(F, b, blk, seg, tid, raw); lru_raw_store(F, tid, raw); }
#pragma unroll 1
    for (int i = 0; i < nun; ++i) {
        const int u = i * F.G + F.vcu; int b, blk, seg; lru_decode(u, b, blk, seg);
        const long row0 = (long)b * SEQ + seg * LRU_TS; const int c0 = blk * 64;
        if (blk != cur_blk) { lru_load_const(F, blk, tid, lane, C); cur_blk = blk; }
        v4u nraw[3];
        if (i + 1 < nun) { int b2, blk2, seg2; lru_decode(u + F.G, b2, blk2, seg2); lru_raw_load(F, b2, blk2, seg2, tid, nraw); }
        v4u gate8[2];
        if (PASS == 1) {
#pragma unroll
            for (int k = 0; k < 2; ++k) { const int t = (tid >> 3) + 64 * k, ch = tid & 7; gate8[k] = *(const GAS v4u*)(LG + (row0 + t) * D + c0 + ch * 8); }
        }
        __syncthreads();
        { const int ch = tid & 7;
#pragma unroll
            for (int k2 = 0; k2 < 2; ++k2) { const int t = (tid >> 3) + 64 * k2; float a[8];
#pragma unroll
                for (int e = 0; e < 8; ++e) a[e] = C.cb[e];
#pragma unroll
                for (int k = 0; k < 4; ++k) { const v4u xv = *(const LAS v4u*)(L + LRU_XR + (t + k) * 128 + ch * 16);
                    a[0] += C.cw[k][0] * bflo(xv.x); a[1] += C.cw[k][1] * bfhi(xv.x); a[2] += C.cw[k][2] * bflo(xv.y); a[3] += C.cw[k][3] * bfhi(xv.y);
                    a[4] += C.cw[k][4] * bflo(xv.z); a[5] += C.cw[k][5] * bfhi(xv.z); a[6] += C.cw[k][6] * bflo(xv.w); a[7] += C.cw[k][7] * bfhi(xv.w); }
                v4u o; o.x = pk2(a[0], a[1]); o.y = pk2(a[2], a[3]); o.z = pk2(a[4], a[5]); o.w = pk2(a[6], a[7]);
                *(LAS v4u*)(L + LRU_XC + t * 144 + ch * 16) = o; }
        }
        __syncthreads();
        { bf16x8 af[2];
#pragma unroll
            for (int kt = 0; kt < 2; ++kt) af[kt] = *(const LAS bf16x8*)(L + LRU_XC + (16 * w + fr) * 144 + (32 * kt + 8 * fq) * 2);
#pragma unroll
            for (int nt = 0; nt < 4; ++nt) { f32x4 gr = (f32x4){0.f, 0.f, 0.f, 0.f}, gi = (f32x4){0.f, 0.f, 0.f, 0.f};
#pragma unroll
                for (int kt = 0; kt < 2; ++kt) { const bf16x8 wr_ = *(const LAS bf16x8*)(L + LRU_WG + ((nt * 2 + kt) * 64 + lane) * 16), wi_ = *(const LAS bf16x8*)(L + LRU_WG + (((4 + nt) * 2 + kt) * 64 + lane) * 16);
                    gr = __builtin_amdgcn_mfma_f32_16x16x32_bf16(wr_, af[kt], gr, 0, 0, 0); gi = __builtin_amdgcn_mfma_f32_16x16x32_bf16(wi_, af[kt], gi, 0, 0, 0); }
                const int j0 = 16 * nt + 4 * fq;
                const v2u xw = *(const LAS v2u*)(L + LRU_XC + (16 * w + fr) * 144 + j0 * 2);
                const float xs[4] = {bflo(xw.x), bfhi(xw.x), bflo(xw.y), bfhi(xw.y)};
                f32x4 av, bv;
#pragma unroll
                for (int e = 0; e < 4; ++e) { const float rt = sigm(gr[e] + C.brg[nt][e]), it = sigm(gi[e] + C.big[nt][e]);
                    const float a = __builtin_amdgcn_exp2f(-rt * C.spv[nt][e]); const float mult = __builtin_amdgcn_sqrtf(fmaxf(1.0f - a * a, 0.f));
                    av[e] = a; bv[e] = mult * it * xs[e]; }
                *(LAS f32x4*)(L + LRU_AA + ((16 * w + fr) * 68 + j0) * 4) = av; *(LAS f32x4*)(L + LRU_BB + ((16 * w + fr) * 68 + j0) * 4) = bv; }
        }
        __syncthreads();
        const LAS float* Af = (const LAS float*)(L + LRU_AA); LAS float* Bf = (LAS float*)(L + LRU_BB);
        { float Aw = 1.f, Bw = 0.f;
#pragma unroll
            for (int s = 0; s < 16; ++s) { const int t = 16 * w + s; const float a = Af[t * 68 + lane], bb = Bf[t * 68 + lane]; Bw = a * Bw + bb; Aw *= a; }
            *(LAS f32x2*)(L + LRU_SM + (w * 64 + lane) * 8) = (f32x2){Aw, Bw}; }
        __syncthreads();
        if (PASS == 0) {
            if (w == 0) { float A = 1.f, Bq = 0.f;
#pragma unroll
                for (int ww = 0; ww < 8; ++ww) { const f32x2 v = *(const LAS f32x2*)(L + LRU_SM + (ww * 64 + lane) * 8); Bq = v.x * Bq + v.y; A *= v.x; }
                *(GAS f32x2*)((float*)(F.ws + WS_SEG) + ((size_t)(b * LRU_NSEG + seg) * D + c0 + lane) * 2) = (f32x2){A, Bq}; }
        } else {
            float Hc = HIN[i * 64 + lane];
#pragma unroll
            for (int ww = 0; ww < 7; ++ww) if (ww < w) { const f32x2 v = *(const LAS f32x2*)(L + LRU_SM + (ww * 64 + lane) * 8); Hc = v.x * Hc + v.y; }
#pragma unroll
            for (int s = 0; s < 16; ++s) { const int t = 16 * w + s; const float a = Af[t * 68 + lane], bb = Bf[t * 68 + lane]; Hc = a * Hc + bb; Bf[t * 68 + lane] = Hc; }
            __syncthreads();
            bf16* YL = (bf16*)(F.ws + WS_YLRU);
#pragma unroll
            for (int k = 0; k < 2; ++k) { const int t = (tid >> 3) + 64 * k, ch = tid & 7;
                const f32x4 h0 = *(const LAS f32x4*)(L + LRU_BB + (t * 68 + ch * 8) * 4), h1 = *(const LAS f32x4*)(L + LRU_BB + (t * 68 + ch * 8 + 4) * 4); const v4u g = gate8[k];
                v4u o; o.x = pk2(h0.x * gelu_tanh(bflo(g.x)), h0.y * gelu_tanh(bfhi(g.x))); o.y = pk2(h0.z * gelu_tanh(bflo(g.y)), h0.w * gelu_tanh(bfhi(g.y)));
                o.z = pk2(h1.x * gelu_tanh(bflo(g.z)), h1.y * gelu_tanh(bfhi(g.z))); o.w = pk2(h1.z * gelu_tanh(bflo(g.w)), h1.w * gelu_tanh(bfhi(g.w)));
                *(GAS v4u*)(YL + (row0 + t) * D + c0 + ch * 8) = o; }
        }
        if (i + 1 < nun) lru_raw_store(F, tid, nraw);
    }
    __syncthreads();
}

__device__ __forceinline__ void p2_phase(Frame& F) {
    LANE_TID();
    const int gw = F.vcu * NWAVES + F.wave, NGW = F.G * NWAVES;
    for (int bh = gw; bh < BATCH * 16; bh += NGW) {
        const float* src = (const float*)(F.ws + WS_LOGF) + (size_t)bh * SEQ + 64 * lane_; float* dst = (float*)(F.ws + WS_KB) + (size_t)bh * SEQ + 64 * lane_;
        f32x4 v[16]; float tot = 0.f;
#pragma unroll
        for (int i = 0; i < 16; ++i) { v[i] = *((const GAS f32x4*)src + i); tot += (v[i].x + v[i].y) + (v[i].z + v[i].w); }
        float incl = tot;
#pragma unroll
        for (int o = 1; o < 64; o <<= 1) { const float t = __shfl_up(incl, o); if (lane_ >= o) incl += t; }
        float run = incl - tot;
#pragma unroll
        for (int i = 0; i < 16; ++i) { f32x4 o; run += v[i].x; o.x = -LOG2E * run; run += v[i].y; o.y = -LOG2E * run; run += v[i].z; o.z = -LOG2E * run; run += v[i].w; o.w = -LOG2E * run;
            *((GAS f32x4*)dst + i) = o; }
    }
    {
        LAS unsigned* nrm = (LAS unsigned*)(F.lds + EXTRA_OFF);
        const bf16* Qp = (const bf16*)(F.ws + WS_PROJ + 2 * PROJ_STRIDE); const bf16* Kp = (const bf16*)(F.ws + WS_PROJ + 3 * PROJ_STRIDE);
        for (int chunk = F.vcu; chunk < M / 64; chunk += F.G) {
            if (tid_ < 32) nrm[tid_] = 0u;
            __syncthreads();
            float qm[2] = {0.f, 0.f}, km[2] = {0.f, 0.f};
#pragma unroll
            for (int r0 = 0; r0 < 8; r0 += 4) { v4u qv[4][2], kv[4][2];
#pragma unroll
                for (int r = 0; r < 4; ++r)
#pragma unroll
                    for (int hf = 0; hf < 2; ++hf) { const size_t off = (size_t)(chunk * 64 + F.wave * 8 + r0 + r) * D + hf * 512 + lane_ * 8; qv[r][hf] = *(const GAS v4u*)(Qp + off); kv[r][hf] = *(const GAS v4u*)(Kp + off); }
#pragma unroll
                for (int r = 0; r < 4; ++r)
#pragma unroll
                    for (int hf = 0; hf < 2; ++hf) { float sq = 0.f, sk = 0.f;
#pragma unroll
                        for (int e = 0; e < 4; ++e) { const float a = bflo(qv[r][hf][e]), b2 = bfhi(qv[r][hf][e]), c = bflo(kv[r][hf][e]), d = bfhi(kv[r][hf][e]); sq += a * a + b2 * b2; sk += c * c + d * d; }
                        sq += __shfl_xor(sq, 1); sq += __shfl_xor(sq, 2); sq += __shfl_xor(sq, 4); sk += __shfl_xor(sk, 1); sk += __shfl_xor(sk, 2); sk += __shfl_xor(sk, 4);
                        qm[hf] = fmaxf(qm[hf], sq); km[hf] = fmaxf(km[hf], sk); } }
            if ((lane_ & 7) == 0) {
#pragma unroll
                for (int hf = 0; hf < 2; ++hf) { const int h = hf * 8 + (lane_ >> 3);
                    __hip_atomic_fetch_max(nrm + h, __float_as_uint(qm[hf]), __ATOMIC_RELAXED, __HIP_MEMORY_SCOPE_WORKGROUP); __hip_atomic_fetch_max(nrm + 16 + h, __float_as_uint(km[hf]), __ATOMIC_RELAXED, __HIP_MEMORY_SCOPE_WORKGROUP); } }
            __syncthreads();
            if (tid_ < 32) { const int b = chunk / (SEQ / 64), qb = (chunk % (SEQ / 64)) / 4, h = tid_ & 15; const unsigned v = nrm[tid_];
                if (tid_ < 16) __hip_atomic_fetch_max(F.ctl + CW_QN + (b * 16 + h) * 16 + qb, v, RLX_AGENT); else __hip_atomic_fetch_max(F.ctl + CW_KN + b * 16 + h, v, RLX_AGENT); }
            __syncthreads();
        }
    }
    lru_run<0>(F);
}
__device__ __forceinline__ void p3_lru(Frame& F) { lru_run<1>(F); }

constexpr int P6_WRB = 0, P6_AT = 65536, P6_LOG = 65536 + 32768;
__device__ __forceinline__ void p6_route(Frame& F) {
    LANE_TID();
    LAS unsigned char* L = F.lds + RING_OFF;
    LAS unsigned* lcnt = (LAS unsigned*)(F.lds + EXTRA_OFF);
    LAS unsigned* gbase = lcnt + 32;
    LAS unsigned* stash = lcnt + 64;
    LAS float* rstd_t = (LAS float*)(lcnt + 64 + 768);
    LAS f32x2* sel = (LAS f32x2*)(lcnt + 64 + 768 + 64);
    {
        f32x4 wv[16]; float gv[16];
#pragma unroll
        for (int q = 0; q < 16; ++q) { const int i4 = tid_ + 512 * q; wv[q] = *((const GAS f32x4*)F.in[IN_WROUTER] + i4); gv[q] = F.in[IN_GFFN][i4 >> 3]; }
#pragma unroll
        for (int q = 0; q < 16; ++q) { const int i4 = tid_ + 512 * q, k = i4 >> 3, e0 = (i4 & 7) * 4, s = k >> 4, kh = (k >> 3) & 1, i = k & 7;
            LAS unsigned short* d = (LAS unsigned short*)(L + P6_WRB + (s * 64 + kh * 32 + e0) * 16 + i * 2);
            d[0] = (unsigned short)(pk2(wv[q].x * gv[q], 0.f) & 0xffffu); d[8] = (unsigned short)(pk2(wv[q].y * gv[q], 0.f) & 0xffffu);
            d[16] = (unsigned short)(pk2(wv[q].z * gv[q], 0.f) & 0xffffu); d[24] = (unsigned short)(pk2(wv[q].w * gv[q], 0.f) & 0xffffu); }
    }
    f32x4 gm[4];
#pragma unroll
    for (int j = 0; j < 4; ++j) gm[j] = *((const GAS f32x4*)F.in[IN_GFFN] + lane_ + 64 * j);
    const float* X1 = F.in[IN_X]; const bf16* DX = (const bf16*)(F.ws + WS_X1); unsigned char* H2 = (unsigned char*)(F.ws + WS_H2);
    unsigned* TOKMAP = (unsigned*)(F.ws + WS_TOKMAP); v4u* ROUTE = (v4u*)(F.ws + WS_ROUTE);
    typedef float f32x16 __attribute__((ext_vector_type(16)));
    for (int chunk = F.vcu; chunk < M / 64; chunk += F.G) {
        if (tid_ < 32) lcnt[tid_] = 0u;
        f32x4 v[4][4];
#pragma unroll
        for (int i = 0; i < 4; ++i)
#pragma unroll
            for (int j = 0; j < 4; ++j) { const size_t ro = (size_t)(chunk * 64 + 4 * F.wave + i) * D; const v2u dw = *((const GAS v2u*)(DX + ro) + lane_ + 64 * j);
                v[i][j] = *((const GAS f32x4*)(X1 + ro) + lane_ + 64 * j) + (f32x4){bflo(dw.x), bfhi(dw.x), bflo(dw.y), bfhi(dw.y)}; }
#pragma unroll 1
        for (int half = 0; half < 2; ++half) {
            {
#pragma unroll
              for (int i = 0; i < 4; ++i) { const int r = 4 * F.wave + i, m = chunk * 64 + half * 32 + r; float s = 0.f;
#pragma unroll
                  for (int j = 0; j < 4; ++j) s += (v[i][j].x * v[i][j].x + v[i][j].y * v[i][j].y) + (v[i][j].z * v[i][j].z + v[i][j].w * v[i][j].w);
                  const float rstd = 1.0f / sqrtf(wave_sum(s) * (1.f / D) + RMS_EPS);
                  if (lane_ == 0) rstd_t[half * 32 + r] = rstd;
                  GAS unsigned* o8 = (GAS unsigned*)(H2 + (size_t)m * D) + lane_; GAS v2u* xb = (GAS v2u*)((bf16*)(F.ws + WS_X1B) + (size_t)m * D) + lane_;
#pragma unroll
                  for (int j = 0; j < 4; ++j) { const f32x4 y = v[i][j] * (rstd * H8_SCALE) * gm[j]; o8[64 * j] = pg8::pk4_i8(y.x, y.y, y.z, y.w);
                      { v2u xw; xw.x = pk2(v[i][j].x, v[i][j].y); xw.y = pk2(v[i][j].z, v[i][j].w); xb[64 * j] = xw; }
                      const int c = (lane_ >> 1) + 32 * j, pc = (c & ~15) | ((c ^ r) & 15); v2u w; w.x = pk2(v[i][j].x, v[i][j].y); w.y = pk2(v[i][j].z, v[i][j].w);
                      *(LAS v2u*)(L + P6_AT + r * 2048 + pc * 16 + (lane_ & 1) * 8) = w; } }
              if (half == 0) {
#pragma unroll
                  for (int i = 0; i < 4; ++i)
#pragma unroll
                      for (int j = 0; j < 4; ++j) { const size_t ro = (size_t)(chunk * 64 + 32 + 4 * F.wave + i) * D; const v2u dw = *((const GAS v2u*)(DX + ro) + lane_ + 64 * j);
                          v[i][j] = *((const GAS f32x4*)(X1 + ro) + lane_ + 64 * j) + (f32x4){bflo(dw.x), bfhi(dw.x), bflo(dw.y), bfhi(dw.y)}; } } }
            __syncthreads();
            f32x16 acc = {};
            { const int r = lane_ & 31, kh = lane_ >> 5;
#pragma unroll
              for (int q = 0; q < 8; ++q) { const int s = 8 * F.wave + q, c = 2 * s + kh, pc = (c & ~15) | ((c ^ r) & 15);
                  const bf16x8 a = *(const LAS bf16x8*)(L + P6_AT + r * 2048 + pc * 16), b = *(const LAS bf16x8*)(L + P6_WRB + (s * 64 + lane_) * 16);
                  acc = __builtin_amdgcn_mfma_f32_32x32x16_bf16(a, b, acc, 0, 0, 0); } }
            __syncthreads();
            { LAS float* P = (LAS float*)(L + P6_AT) + F.wave * 1024;
#pragma unroll
              for (int rg = 0; rg < 16; ++rg) P[((rg & 3) + 8 * (rg >> 2) + 4 * (lane_ >> 5)) * 32 + (lane_ & 31)] = acc[rg]; }
            __syncthreads();
            { const LAS float* P = (const LAS float*)(L + P6_AT); LAS float* LG = (LAS float*)(L + P6_LOG);
#pragma unroll
              for (int k = 0; k < 2; ++k) { const int idx = tid_ + 512 * k; float s = 0.f;
#pragma unroll
                  for (int w = 0; w < 8; ++w) s += P[w * 1024 + idx];
                  LG[idx] = s * rstd_t[half * 32 + (idx >> 5)] + F.in[IN_BROUTER][idx & 31]; } }
            __syncthreads();
            { const LAS float* LG = (const LAS float*)(L + P6_LOG);
#pragma unroll
              for (int k = 0; k < 2; ++k) { const int idx = tid_ + 512 * k, i = idx >> 5, j = idx & 31; const float v = LG[idx]; int rank = 0;
#pragma unroll
                  for (int q = 0; q < 8; ++q) { const f32x4 o = *(const LAS f32x4*)(LG + i * 32 + 4 * q);
                      rank += (o.x > v || (o.x == v && 4 * q + 0 < j)) ? 1 : 0; rank += (o.y > v || (o.y == v && 4 * q + 1 < j)) ? 1 : 0;
                      rank += (o.z > v || (o.z == v && 4 * q + 2 < j)) ? 1 : 0; rank += (o.w > v || (o.w == v && 4 * q + 3 < j)) ? 1 : 0; }
                  if (rank < 4) sel[(half * 32 + i) * 4 + rank] = (f32x2){__uint_as_float((unsigned)j), v}; } }
            __syncthreads();
            if (tid_ < 128) { const int rl = half * 32 + (tid_ >> 2), k = tid_ & 3; const f32x2 s0 = sel[rl * 4 + 0], s1 = sel[rl * 4 + 1], s2 = sel[rl * 4 + 2], s3 = sel[rl * 4 + 3];
                const float p1 = __expf(s1.y - s0.y), p2 = __expf(s2.y - s0.y), p3 = __expf(s3.y - s0.y), inv = 1.0f / (1.0f + p1 + p2 + p3);
                const unsigned e = __float_as_uint(k == 0 ? s0.x : k == 1 ? s1.x : k == 2 ? s2.x : s3.x) & 31u; const float wv = (k == 0 ? 1.0f : k == 1 ? p1 : k == 2 ? p2 : p3) * inv;
                const unsigned lp = __hip_atomic_fetch_add(lcnt + e, 1u, __ATOMIC_RELAXED, __HIP_MEMORY_SCOPE_WORKGROUP);
                LAS unsigned* st = stash + (rl * 4 + k) * 3; st[0] = e; st[1] = lp; st[2] = __float_as_uint(wv); }
            __syncthreads();
        }
        const int t2 = F.wave * 64 + hw_lane();
        if (t2 < 32) { const unsigned n = lcnt[t2]; gbase[t2] = n ? __hip_atomic_fetch_add(F.ctl + CW_CNT + 64 * t2, n, RLX_AGENT) : 0u; }
        __syncthreads();
        if (t2 < 256) { const LAS unsigned* st = stash + t2 * 3; const unsigned e = st[0], pos = gbase[e] + st[1]; const int m = chunk * 64 + (t2 >> 2);
            TOKMAP[(size_t)e * M + pos] = (unsigned)m; ROUTE[(size_t)m * 4 + (t2 & 3)] = (v4u){e, pos, st[2], 0u}; }
        __syncthreads();
    }
}
__device__ __forceinline__ int moe_tables(Frame& F) {
    LANE_TID();
    LAS unsigned char* EX = F.lds + EXTRA_OFF;
    LAS unsigned char* tile_e = EX + EX_TILE_E; LAS unsigned* ncnt = (LAS unsigned*)(EX + EX_NCNT); LAS unsigned* tpre = (LAS unsigned*)(EX + EX_TPRE);
    if (tid_ < 32) { unsigned n = __hip_atomic_load(F.ctl + CW_CNT + 64 * tid_, RLX_AGENT); if (n > (unsigned)M) n = (unsigned)M; ncnt[tid_] = n; }
    __syncthreads();
    if (tid_ == 0) { unsigned a = 0; for (int e = 0; e < 32; ++e) { tpre[e] = a; a += (ncnt[e] + 255u) >> 8; if (a > (unsigned)MAXTILES) a = (unsigned)MAXTILES; } tpre[32] = a; }
    __syncthreads();
    const int TT = (int)tpre[32];
    for (int t = tid_; t < TT; t += NWAVES * 64) { int e = 0;
#pragma unroll 1
        for (int k = 1; k < 32; ++k) if ((int)tpre[k] <= t) e = k;
        tile_e[t] = (unsigned char)e; }
    __syncthreads();
    return TT;
}

__device__ __forceinline__ void p9_final(Frame& F) {
    LANE_TID();
    const int gw = F.vcu * NWAVES + F.wave, NGW = F.G * NWAVES;
    unsigned tl = 0; if (lane_ < 32) { unsigned n = __hip_atomic_load(F.ctl + CW_CNT + 64 * lane_, RLX_AGENT); if (n > (unsigned)M) n = (unsigned)M; tl = (n + 255u) >> 8; }
    unsigned incl = tl;
#pragma unroll
    for (int o = 1; o < 32; o <<= 1) { const unsigned t = __shfl_up(incl, o); if (lane_ >= o) incl += t; }
    const unsigned excl = incl - tl;
    f32x4 gm[4];
#pragma unroll
    for (int j = 0; j < 4; ++j) gm[j] = *((const GAS f32x4*)F.in[IN_GFINAL] + lane_ + 64 * j);
    const bf16* DX = (const bf16*)(F.ws + WS_X1B); const signed char* Y = (const signed char*)(F.ws + WS_Y); const v4u* ROUTE = (const v4u*)(F.ws + WS_ROUTE);
#pragma unroll 1
    for (int m = gw; m < M; m += NGW) {
        f32x4 v[4];
#pragma unroll
        for (int j = 0; j < 4; ++j) { const v2u dw = *((const GAS v2u*)(DX + (size_t)m * D) + lane_ + 64 * j); v[j] = (f32x4){bflo(dw.x), bfhi(dw.x), bflo(dw.y), bfhi(dw.y)}; }
#pragma unroll
        for (int k = 0; k < 4; ++k) { const v4u rt = *((const GAS v4u*)ROUTE + (size_t)m * 4 + k); const unsigned e = rt.x & 31u; const float wv = __uint_as_float(rt.z) * (1.0f / Y8_SCALE);
            unsigned slot = (unsigned)__shfl((int)excl, (int)e) * 256u + rt.y; if (slot >= (unsigned)SLOTS) slot = 0u;
            const GAS unsigned* yr = (const GAS unsigned*)(Y + (size_t)slot * D) + lane_;
#pragma unroll
            for (int j = 0; j < 4; ++j) { const unsigned yw = yr[64 * j];
                v[j].x += wv * (float)((int)(yw << 24) >> 24); v[j].y += wv * (float)((int)(yw << 16) >> 24); v[j].z += wv * (float)((int)(yw << 8) >> 24); v[j].w += wv * (float)((int)yw >> 24); } }
        float s = 0.f;
#pragma unroll
        for (int j = 0; j < 4; ++j) s += (v[j].x * v[j].x + v[j].y * v[j].y) + (v[j].z * v[j].z + v[j].w * v[j].w);
        const float rstd = 1.0f / sqrtf(wave_sum(s) * (1.f / D) + RMS_EPS);
        GAS f32x4* o = (GAS f32x4*)(F.out + (size_t)m * D) + lane_;
#pragma unroll
        for (int j = 0; j < 4; ++j) o[64 * j] = v[j] * rstd * gm[j];
    }
}


constexpr int CV_SQ = (D / CV_IN) * CV_KB, CV_GU = NE * (2 * DFF / CV_IN) * CV_KB, CV_D = NE * (D / CV_IN) * CV_KB, CV_N = 3 * CV_SQ + CV_GU + CV_D, CV_P1 = 3 * CV_SQ + CV_GU;
__device__ __forceinline__ void cvt_decode(Frame& F, int it, CvtItem& c) {
    unsigned char* ws = F.ws; int r = it;
    const float* const w_lru_p = F.in[IN_WLRU]; const float* const w_fox_p = F.in[IN_WFOX]; const float* const w_o_p = F.in[IN_WO];
    if (r < 3 * CV_SQ) { const int which = r / CV_SQ, rr = r % CV_SQ, cb = rr / CV_KB, kb = rr % CV_KB;
        c.src = (which == 0 ? w_lru_p : which == 1 ? w_fox_p : w_o_p) + CV_IN * cb; c.ldw = D; c.K = D; c.k0 = CV_IK * kb; c.i8 = 0;
        c.dst = ws + (which == 0 ? WS_WLRU : which == 1 ? WS_WFOX : WS_WO) + (size_t)(CV_IN * cb) * D * 2; return; }
    r -= 3 * CV_SQ;
    if (r < CV_GU) { const int cb = r / CV_KB, kb = r % CV_KB, cpe = 2 * DFF / CV_IN, e = cb / cpe, nn0 = CV_IN * (cb % cpe), pn = nn0 >> 8, bj = (nn0 >> 7) & 1, cp = nn0 & 127, scol = bj * DFF + 128 * pn + cp;
        c.src = F.in[IN_WGU] + (size_t)e * D * 2 * DFF + scol; c.ldw = 2 * DFF; c.K = D; c.k0 = CV_IK * kb; c.i8 = 1; c.dst = ws + WS_WGU + ((size_t)e * 2 * DFF + nn0) * D; return; }
    r -= CV_GU;
    { const int cb = r / CV_KB, kb = r % CV_KB, cpe = D / CV_IN, e = cb / cpe, n0 = CV_IN * (cb % cpe);
        c.src = F.in[IN_WD] + (size_t)e * DFF * D + n0; c.ldw = D; c.K = DFF; c.k0 = CV_IK * kb; c.i8 = 1; c.dst = ws + WS_WD + ((size_t)e * D + n0) * DFF; }
}
__device__ __forceinline__ void cvt_slice(Frame& F, int k_lo, int k_hi, int item_lo = 0, int item_hi = CV_N) {
    const int lane = hw_lane(); const int NGW = F.G * NWAVES, gw0 = item_lo + F.vcu * NWAVES + F.wave, gw = gw0 + k_lo * NGW;
    const int CV_END = (k_hi >= (CV_N + NGW - 1) / NGW) ? item_hi : ((gw0 + k_hi * NGW) < item_hi ? (gw0 + k_hi * NGW) : item_hi);
    CvtItem c0, c1, c2, c3; f32x4 v0[8], v1[8], v2[8], v3[8];
    int it = gw;
#define CV_LOAD(c, v, idx) do { if ((idx) < CV_END) { cvt_decode(F, (idx), c); cvt_load(c, lane, v); } } while (0)
    CV_LOAD(c0, v0, it); CV_LOAD(c1, v1, it + NGW); CV_LOAD(c2, v2, it + 2 * NGW); CV_LOAD(c3, v3, it + 3 * NGW);
#pragma unroll 1
    for (; it < CV_END; it += 4 * NGW) {
        cvt_store(c0, lane, v0); CV_LOAD(c0, v0, it + 4 * NGW);
        if (it + NGW < CV_END) { cvt_store(c1, lane, v1); CV_LOAD(c1, v1, it + 5 * NGW); }
        if (it + 2 * NGW < CV_END) { cvt_store(c2, lane, v2); CV_LOAD(c2, v2, it + 6 * NGW); }
        if (it + 3 * NGW < CV_END) { cvt_store(c3, lane, v3); CV_LOAD(c3, v3, it + 7 * NGW); }
    }
#undef CV_LOAD
}
__device__ __forceinline__ void ph1(Frame& F) {
    unsigned char* ws = F.ws;
    pg8::Gemm g{(const bf16*)(ws + WS_H), (const bf16*)(ws + WS_WIN), M, NPROJ, D}; pg8::StaticOrder S; S.init(M, NPROJ, F.G, (int)blockIdx.x);
    pg8::EpiSplit E{(bf16*)(ws + WS_PROJ), D, D, (size_t)PROJ_STRIDE / 2, 2, attn_body::C2, 1.0f / (W8_SCALE * H8_SCALE)};
    const int rounds = (S.nwg + F.G - 1) / F.G, slot = F.vcu % (rounds + 1);
    const int pre = 2 * ((F.vcu / (rounds + 1)) % 8);
    cvt_slice(F, 0, pre, 0, CV_P1);
    __syncthreads();
    S.i0 = 0; S.i1 = slot;
    pg8::gemm_phase<pg8::EpiSplit, pg8::StaticOrder, true, true>(F.lds + RING_OFF, g, S, E, F.wave);
    cvt_slice(F, pre, 0x7fffffff, 0, CV_P1);
    __syncthreads();
    S.i0 = slot; S.i1 = rounds;
    pg8::gemm_phase<pg8::EpiSplit, pg8::StaticOrder, true, true>(F.lds + RING_OFF, g, S, E, F.wave);
}
__device__ __forceinline__ void ph3(Frame& F, unsigned char* lds_generic) {
    unsigned char* ws = F.ws;
    const attn_body::AttnTensors AT{(const attn_body::bf16*)(ws + WS_PROJ + 2 * PROJ_STRIDE), (const attn_body::bf16*)(ws + WS_PROJ + 3 * PROJ_STRIDE), (const attn_body::bf16*)(ws + WS_PROJ + 4 * PROJ_STRIDE),
                                    (attn_body::bf16*)(ws + WS_YFOX), (const float*)(ws + WS_KB), (const unsigned*)(F.ctl + CW_QN), (const unsigned*)(F.ctl + CW_KN)};
    attn_body::StaticOrder S((int)F.G, (int)blockIdx.x);
    const int pos = F.vcu % 5;
    S.i0 = 0; S.i1 = pos;
    attn_body::attn_phase<attn_body::StaticOrder>((char*)lds_generic + RING_OFF, AT, S, F.wave);
    cvt_slice(F, 0, 0x7fffffff, CV_P1, CV_N);
    S.i0 = pos; S.i1 = 0x7fffffff;
    attn_body::attn_phase<attn_body::StaticOrder>((char*)lds_generic + RING_OFF, AT, S, F.wave);
    __syncthreads();
    p3_lru(F);
}
__device__ __forceinline__ void ph4(Frame& F) {
    unsigned char* ws = F.ws;
    static_assert(WS_WFOX == WS_WLRU + (size_t)D * D * 2, "the two weight copies are contiguous");
    pg8::Gemm g{(const bf16*)ws, (const bf16*)(ws + WS_WLRU), M, D, D}; pg8::PairOrder S; S.init(M, D, F.G, (int)blockIdx.x); S.abase[0] = (unsigned)WS_YLRU; S.abase[1] = (unsigned)WS_YFOX;
    pg8::EpiGatePair E{{(bf16*)(ws + WS_TMP), (const bf16*)(ws + WS_PROJ + 5 * PROJ_STRIDE), nullptr, D}, {(bf16*)(ws + WS_MERGED), (const bf16*)(ws + WS_PROJ + 6 * PROJ_STRIDE), (const bf16*)(ws + WS_TMP), D}, D / 256};
    pg8::gemm_phase<pg8::EpiGatePair, pg8::PairOrder, true>(F.lds + RING_OFF, g, S, E, F.wave);
}
__device__ __forceinline__ void ph5(Frame& F) {
    unsigned char* ws = F.ws;
    pg8::Gemm g{(const bf16*)(ws + WS_MERGED), (const bf16*)(ws + WS_WO), M, D, D}; pg8::StaticOrder S; S.init(M, D, F.G, (int)blockIdx.x);
    pg8::EpiPlainBf16 E{(bf16*)(ws + WS_X1), D};
    pg8::gemm_phase<pg8::EpiPlainBf16, pg8::StaticOrder, true>(F.lds + RING_OFF, g, S, E, F.wave);
}
__device__ __forceinline__ void ph7(Frame& F) {
    unsigned char* ws = F.ws;
    const int TT = moe_tables(F);
    LAS unsigned char* EX = F.lds + EXTRA_OFF; LAS unsigned* rows = (LAS unsigned*)(EX + EX_ROWS);
    const LAS unsigned* ncnt = (const LAS unsigned*)(EX + EX_NCNT); const LAS unsigned* tpre = (const LAS unsigned*)(EX + EX_TPRE);
    pg8::GroupedOrder<true> S; S.init(TT, 8, F.G, (int)blockIdx.x, EX + EX_TILE_E, rows);
    { const unsigned* TOKMAP = (const unsigned*)(ws + WS_TOKMAP); pg8::Unit u;
      const int tid_ = F.wave * 64 + hw_lane();
      for (int i = 0; i < EX_MAXU && S.next(i, u); ++i) if (tid_ < 256) { const int e = u.pn >> 3; const unsigned pos = (unsigned)(u.pm - (int)tpre[e]) * 256u + (unsigned)tid_;
          rows[i * 256 + tid_] = TOKMAP[(size_t)e * M + (pos < ncnt[e] ? pos : 0u)] & (unsigned)(M - 1); } }
    __syncthreads();
    pg8::Gemm g{(const bf16*)(ws + WS_H2), (const bf16*)(ws + WS_WGU), SLOTS, 2 * DFF, D};
    pg8::EpiSwiglu E{(unsigned char*)(ws + WS_ACT), F.in[IN_BGU], 8, 1.0f / (W8_SCALE * H8_SCALE), ACT8_SCALE};
    pg8::gemm_phase<pg8::EpiSwiglu, pg8::GroupedOrder<true>, true, true>(F.lds + RING_OFF, g, S, E, F.wave);
}
__device__ __forceinline__ void ph8(Frame& F) {
    unsigned char* ws = F.ws;
    LAS unsigned char* EX = F.lds + EXTRA_OFF;
    const int TT = (N_LAUNCHES == PER_PHASE) ? moe_tables(F) : (int)((const LAS unsigned*)(EX + EX_TPRE))[32];
    pg8::GroupedOrder<false> S; S.init(TT, 4, F.G, (int)blockIdx.x, EX + EX_TILE_E, nullptr);
    pg8::Gemm g{(const bf16*)(ws + WS_ACT), (const bf16*)(ws + WS_WD), SLOTS, D, DFF};
    pg8::EpiDown E{(unsigned char*)(ws + WS_Y), F.in[IN_BD], 4, 1.0f / (W8_SCALE * ACT8_SCALE), Y8_SCALE};
    pg8::gemm_phase<pg8::EpiDown, pg8::GroupedOrder<false>, true, true>(F.lds + RING_OFF, g, S, E, F.wave);
}
struct Args { const float* in[22]; float* out; unsigned char* ws; int ph_lo, ph_hi, li, pad; };
__global__ void __launch_bounds__(NWAVES * 64, 2) mk_fwd(Args args) {
    extern __shared__ __attribute__((aligned(16))) unsigned char lds[];
    Frame F;
    F.lds = (LAS unsigned char*)lds;
    F.MISC = (volatile LAS unsigned*)(F.lds + MISC_OFF);
    F.wave = __builtin_amdgcn_readfirstlane((int)threadIdx.x >> 6);
    F.G = gridDim.x; { const int bx = blockIdx.x; F.vcu = (F.G % 8 == 0) ? (bx % 8) * (F.G / 8) + bx / 8 : bx; }
#pragma unroll
    for (int i = 0; i < 22; ++i) F.in[i] = args.in[i];
    F.out = args.out; F.ws = args.ws; F.ctl = (gu32*)(args.ws + WS_CTL);
    for (int u = threadIdx.x; u < (LDS_BYTES - LDSCTL_OFF) / 4; u += NWAVES * 64) ((LAS unsigned*)(F.lds + LDSCTL_OFF))[u] = 0u;
    __syncthreads();
    XcdBarrier bar; bar.bar = (unsigned*)(F.ctl + CW_BAR); bar.x = 0; bar.st = nullptr;
    if (N_LAUNCHES != PER_PHASE) bar = xcd_barrier_post((unsigned*)(F.ctl + CW_BAR), F.MISC + 8);
#define GRID_BAR(seam) do { if (N_LAUNCHES == PER_PHASE) { if (threadIdx.x == 0) __hip_atomic_store(F.ctl + CW_TMO, 0xBADBA0u | (unsigned)(seam), RLX_AGENT); } else { xcd_barrier(bar); } } while (0)
    const int lo = args.ph_lo, hi = args.ph_hi;
#define IN(k) (lo <= (k) && (k) < hi)
#define BOTH(k) (IN(k) && IN((k) + 1))

#ifndef PROBE_REPEAT
#define PROBE_REPEAT -1
#endif
#ifndef ONLY_PHASE
#define ONLY_PHASE -1
#endif
#define RUN(k, call) do { if ((ONLY_PHASE < 0 || ONLY_PHASE == (k)) && IN(k)) { call; if (PROBE_REPEAT == (k)) { GRID_BAR(k); call; } if (BOTH(k)) GRID_BAR(k); } } while (0)
    RUN(0, p0_prologue(F));
    RUN(1, ph1(F));
#if PROBE_REPEAT == 11
    if (IN(1)) { pg8::Gemm g{(const bf16*)(F.ws + WS_H), (const bf16*)(F.ws + WS_WIN), M, NPROJ, D}; pg8::StaticOrder S; S.init(M, NPROJ, F.G, (int)blockIdx.x); pg8::EpiNull E;
        pg8::gemm_phase<pg8::EpiNull, pg8::StaticOrder, true, true>(F.lds + RING_OFF, g, S, E, F.wave); GRID_BAR(1); }
#endif
#if PROBE_REPEAT == 12
    if (IN(1)) { pg8::Gemm g{(const bf16*)(F.ws + WS_H), (const bf16*)(F.ws + WS_WIN), M, NPROJ, D}; pg8::StaticOrder S; S.init(M, NPROJ, F.G, (int)blockIdx.x);
        pg8::EpiSplit E{(bf16*)(F.ws + WS_Y), 0, D, 0, 2, attn_body::C2, 1.0f / (W8_SCALE * H8_SCALE)};
        pg8::gemm_phase<pg8::EpiSplit, pg8::StaticOrder, true, true>(F.lds + RING_OFF, g, S, E, F.wave); GRID_BAR(1); }
#endif
    RUN(2, p2_phase(F));
    RUN(3, ph3(F, lds));
#if PROBE_REPEAT == 14
    if (IN(3)) { unsigned char* ws = F.ws; const attn_body::AttnTensors AT{(const attn_body::bf16*)(ws + WS_PROJ + 2 * PROJ_STRIDE), (const attn_body::bf16*)(ws + WS_PROJ + 3 * PROJ_STRIDE), (const attn_body::bf16*)(ws + WS_PROJ + 4 * PROJ_STRIDE),
                                    (attn_body::bf16*)(ws + WS_TMP), (const float*)(ws + WS_KB), (const unsigned*)(F.ctl + CW_QN), (const unsigned*)(F.ctl + CW_KN)};
        const attn_body::StaticOrder S((int)F.G, (int)blockIdx.x); attn_body::attn_phase<attn_body::StaticOrder>((char*)lds + RING_OFF, AT, S, F.wave, -1.0f); GRID_BAR(3); }
#endif
#if PROBE_REPEAT == 13
    if (IN(3)) { unsigned char* ws = F.ws; const attn_body::AttnTensors AT{(const attn_body::bf16*)(ws + WS_PROJ + 2 * PROJ_STRIDE), (const attn_body::bf16*)(ws + WS_PROJ + 3 * PROJ_STRIDE), (const attn_body::bf16*)(ws + WS_PROJ + 4 * PROJ_STRIDE),
                                    (attn_body::bf16*)(ws + WS_YFOX), (const float*)(ws + WS_KB), (const unsigned*)(F.ctl + CW_QN), (const unsigned*)(F.ctl + CW_KN)};
        const attn_body::StaticOrder S((int)F.G, (int)blockIdx.x); attn_body::attn_phase<attn_body::StaticOrder>((char*)lds + RING_OFF, AT, S, F.wave); GRID_BAR(3); }
#endif
    RUN(4, ph4(F));
    RUN(5, ph5(F));
    RUN(6, p6_route(F));
#if PROBE_REPEAT == 16
    if (IN(6)) { if (blockIdx.x == 0 && threadIdx.x < 32) __hip_atomic_store(F.ctl + CW_CNT + 64 * threadIdx.x, 0u, RLX_AGENT); GRID_BAR(6); p6_route(F); GRID_BAR(6); }
#endif
    RUN(7, ph7(F));
#if PROBE_REPEAT == 17
    if (IN(7)) { unsigned char* ws = F.ws; const int TT = moe_tables(F); LAS unsigned char* EX = F.lds + EXTRA_OFF; LAS unsigned* rows = (LAS unsigned*)(EX + EX_ROWS);
        pg8::GroupedOrder<true> S; S.init(TT, 8, F.G, (int)blockIdx.x, EX + EX_TILE_E, rows);
        pg8::Gemm g{(const bf16*)(ws + WS_H2), (const bf16*)(ws + WS_WGU), SLOTS, 2 * DFF, D}; pg8::EpiNull E;
        pg8::gemm_phase<pg8::EpiNull, pg8::GroupedOrder<true>, true, true>(F.lds + RING_OFF, g, S, E, F.wave); GRID_BAR(7); }
#endif
    RUN(8, ph8(F));
    RUN(9, p9_final(F));
#undef RUN
#undef IN
#undef BOTH
}

extern "C" void kernel_launch(void* const* d_in, const int* in_sizes, int n_in, void* d_out, int out_size, void* d_ws, size_t ws_size, hipStream_t stream) {
    static int grid = 0;
    if (grid == 0) {
        if (n_in != 22 || in_sizes[0] != M * D || out_size != M * D || ws_size < WS_END) { fprintf(stderr, "kernel_launch: unexpected problem: n_in %d in0 %d out %d ws %zu (need %zu)\n", n_in, n_in > 0 ? in_sizes[0] : -1, out_size, ws_size, (size_t)WS_END); grid = -1; return; }
        int dev = 0, cus = 0, per_cu = 0;
        if (hipGetDevice(&dev) != hipSuccess || hipDeviceGetAttribute(&cus, hipDeviceAttributeMultiprocessorCount, dev) != hipSuccess) { grid = -1; return; }
        if (hipFuncSetAttribute((const void*)mk_fwd, hipFuncAttributeMaxDynamicSharedMemorySize, LDS_BYTES) != hipSuccess) { fprintf(stderr, "kernel_launch: hipFuncSetAttribute failed\n"); grid = -1; return; }
        if (hipOccupancyMaxActiveBlocksPerMultiprocessor(&per_cu, (const void*)mk_fwd, NWAVES * 64, LDS_BYTES) != hipSuccess || per_cu < 1) { fprintf(stderr, "kernel_launch: occupancy query reports %d workgroups per CU\n", per_cu); }
        (void)hipGetLastError();
        grid = cus;
    }
    if (grid < 0) return;
    if (hipMemsetAsync((char*)d_ws + WS_CTL, 0, CTL_ZERO_BYTES, stream) != hipSuccess) return;
    Args a{};
    for (int i = 0; i < 22; ++i) a.in[i] = (const float*)d_in[i];
    a.out = (float*)d_out; a.ws = (unsigned char*)d_ws;
    for (int li = 0; li < N_LAUNCHES; ++li) {
        a.ph_lo = (N_LAUNCHES == PER_PHASE) ? li : 0; a.ph_hi = (N_LAUNCHES == PER_PHASE) ? li + 1 : PER_PHASE; a.li = li; a.pad = 0;
        hipLaunchKernelGGL(mk_fwd, dim3(grid), dim3(NWAVES * 64), LDS_BYTES, stream, a);
    }
}
```

```cpp
#include <hip/hip_runtime.h>
#include <cstdio>
#include <cstdint>
__device__ __forceinline__ int hw_lane() { int l; asm volatile("v_mbcnt_lo_u32_b32 %0, -1, 0\n\tv_mbcnt_hi_u32_b32 %0, -1, %0" : "=v"(l)); return l; }
namespace pg8 {
#define PG8_LAS __attribute__((address_space(3)))
typedef unsigned short bf16_t;
typedef short bf16x8 __attribute__((ext_vector_type(8)));
typedef float f32x4 __attribute__((ext_vector_type(4)));
typedef unsigned u32x4 __attribute__((ext_vector_type(4)));
constexpr int BM = 256, BK = 64, HALF = 128, HTB = HALF * BK * 2  , STAGE_BYTES = 8 * HTB, NXCD = 8, WGM = 8;

__host__ __device__ __forceinline__ int lds_byte(int r, int c) { const int st = (r >> 4) * 2 + (c >> 5), rr = r & 15, cc = c & 31, ob = rr * 64 + cc * 2; return st * 1024 + (ob ^ (((ob >> 9) & 1) << 5)); }
__host__ __device__ __forceinline__ void stage_rc(int b, int& R, int& C) { const int st = b / 1024, sb = b % 1024, swz = sb ^ (((sb >> 9) & 1) << 5); R = (st >> 1) * 16 + swz / 64; C = (st & 1) * 32 + (swz % 64) / 2; }
__host__ __device__ __forceinline__ int perm32(int rho) { const int n = rho >> 4, i = rho & 15; return 8 * (i >> 2) + 4 * n + (i & 3); }

struct Unit { int pm, pn; };
struct Gemm { const bf16_t* A; const bf16_t* Bt; int M, N, K; };

struct StaticOrder {
    static constexpr bool GATHER = false;
    int nM, nN, nwg, G, c, i0, i1;
    __device__ __forceinline__ void init(int M, int N, int G_, int c_) { nM = M / BM; nN = N / BM; nwg = nM * nN; G = G_; c = c_; i0 = 0; i1 = 0x7fffffff; }
    __device__ __forceinline__ bool next(int i, Unit& u) const {
        if (i >= i1 - i0) return false;
        const long L = (long)(i + i0) * G + c; if (L >= nwg) return false;
        int wgid = (int)L; { const int q = nwg / NXCD, r = nwg % NXCD, xcd = wgid % NXCD, off = wgid / NXCD; wgid = (xcd < r ? xcd * (q + 1) : r * (q + 1) + (xcd - r) * q) + off; }
        const int nig = WGM * nN, gid = wgid / nig, fm = gid * WGM, gsz = (nM - fm) < WGM ? (nM - fm) : WGM;
        u.pm = fm + ((wgid % nig) % gsz); u.pn = (wgid % nig) / gsz; return true;
    }
    __device__ __forceinline__ unsigned a_off(int, const Unit& u, int rloc, int rowbytes) const { return (unsigned)(u.pm * BM + rloc) * (unsigned)rowbytes; }
};
struct PairOrder : StaticOrder {
    unsigned abase[2];
    __device__ __forceinline__ bool next(int i, Unit& u) const { if (!StaticOrder::next(i >> 1, u)) return false; u.pn += (i & 1) * nN; return true; }
    __device__ __forceinline__ unsigned a_off(int, const Unit& u, int rloc, int rowbytes) const { return abase[u.pn >= nN ? 1 : 0] + (unsigned)(u.pm * BM + rloc) * (unsigned)rowbytes; }
};
template <bool GATHER_> struct GroupedOrder {
    static constexpr bool GATHER = GATHER_;
    int nM, nN, nwg, G, c;
    const PG8_LAS unsigned char* tile_e; const PG8_LAS unsigned* rows;
    __device__ __forceinline__ void init(int TT, int nN_, int G_, int c_, const PG8_LAS unsigned char* te, const PG8_LAS unsigned* rw) { nM = TT; nN = nN_; nwg = nM * nN; G = G_; c = c_; tile_e = te; rows = rw; }
    __device__ __forceinline__ bool next(int i, Unit& u) const {
        const long L = (long)i * G + c; if (L >= nwg) return false;
        int wgid = (int)L; { const int q = nwg / NXCD, r = nwg % NXCD, xcd = wgid % NXCD, off = wgid / NXCD; wgid = (xcd < r ? xcd * (q + 1) : r * (q + 1) + (xcd - r) * q) + off; }
        const int nig = WGM * nN, gid = wgid / nig, fm = gid * WGM, gsz = (nM - fm) < WGM ? (nM - fm) : WGM;
        u.pm = fm + ((wgid % nig) % gsz); u.pn = (int)tile_e[u.pm] * nN + (wgid % nig) / gsz; return true;
    }
    __device__ __forceinline__ unsigned a_off(int i, const Unit& u, int rloc, int rowbytes) const {
        return GATHER ? rows[i * 256 + rloc] * (unsigned)rowbytes : (unsigned)(u.pm * BM + rloc) * (unsigned)rowbytes; }
};

__device__ __forceinline__ unsigned cvt_pk_bf16(float lo, float hi) { unsigned r; asm volatile("v_cvt_pk_bf16_f32 %0, %1, %2" : "=v"(r) : "v"(lo), "v"(hi)); return r; }
__device__ __forceinline__ float bf_lo(unsigned w) { return __uint_as_float(w << 16); }
__device__ __forceinline__ float bf_hi(unsigned w) { return __uint_as_float(w & 0xffff0000u); }
__device__ __forceinline__ float sigm(float x) { return __builtin_amdgcn_rcpf(1.0f + __builtin_amdgcn_exp2f(-1.4426950408889634f * x)); }

__device__ __forceinline__ unsigned q8lo(float x) { return __float_as_uint(__builtin_amdgcn_fmed3f(x, -127.0f, 127.0f) + 12582912.0f); }
__device__ __forceinline__ unsigned pk4_i8(float a, float b, float c, float d) {
    const unsigned ab = __builtin_amdgcn_perm(q8lo(b), q8lo(a), 0x0c0c0400u), cd = __builtin_amdgcn_perm(q8lo(d), q8lo(c), 0x0c0c0400u); return ab | (cd << 16); }
struct EpiSplit {
    static constexpr bool PERM = true, AFTER_DRAIN = false;
    bf16_t* O; int ldc; int split_cols; size_t split_stride; int scale_t; float scale; float accscale;
    __device__ __forceinline__ void operator()(const f32x4 (&acc)[2][2][4][2], const Unit& u, int wr, int wc, int fr, int fq) const {
        const int row0 = u.pm * BM + wr * 64 + fr; int colt = u.pn * BM; bf16_t* base = O;
        const int t = colt / split_cols; base += (size_t)t * split_stride; colt -= t * split_cols; const float sc = ((t == scale_t) ? scale : 1.f) * accscale;
        const int col0 = colt + wc * 32 + 8 * fq;
#pragma unroll
        for (int ai = 0; ai < 2; ++ai)
#pragma unroll
            for (int m = 0; m < 4; ++m) { bf16_t* rowp = base + (size_t)(row0 + ai * HALF + m * 16) * ldc + col0;
#pragma unroll
                for (int bj = 0; bj < 2; ++bj) { const f32x4 v0 = acc[ai][bj][m][0] * sc, v1 = acc[ai][bj][m][1] * sc;
                    u32x4 w; w.x = cvt_pk_bf16(v0[0], v0[1]); w.y = cvt_pk_bf16(v0[2], v0[3]); w.z = cvt_pk_bf16(v1[0], v1[1]); w.w = cvt_pk_bf16(v1[2], v1[3]);
                    *(u32x4*)(rowp + bj * HALF) = w; } }
    }
};
struct EpiNull {
    static constexpr bool PERM = true, AFTER_DRAIN = false;
    __device__ __forceinline__ void operator()(const f32x4 (&acc)[2][2][4][2], const Unit&, int, int, int, int) const {
#pragma unroll
        for (int ai = 0; ai < 2; ++ai)
#pragma unroll
            for (int bj = 0; bj < 2; ++bj)
#pragma unroll
                for (int m = 0; m < 4; ++m) asm volatile("" :: "v"(acc[ai][bj][m][0]), "v"(acc[ai][bj][m][1]));
    }
};
template <bool ADD> struct EpiGate {
    static constexpr bool PERM = true, AFTER_DRAIN = false;
    bf16_t* O; const bf16_t* G; const bf16_t* T; int ldc;
    __device__ __forceinline__ void operator()(const f32x4 (&acc)[2][2][4][2], const Unit& u, int wr, int wc, int fr, int fq) const {
        const int row0 = u.pm * BM + wr * 64 + fr, col0 = u.pn * BM + wc * 32 + 8 * fq;
#pragma unroll
        for (int ai = 0; ai < 2; ++ai)
#pragma unroll
            for (int m = 0; m < 4; ++m) { const size_t off = (size_t)(row0 + ai * HALF + m * 16) * ldc + col0;
#pragma unroll
                for (int bj = 0; bj < 2; ++bj) { const u32x4 g = *(const u32x4*)(G + off + bj * HALF); u32x4 tv = (u32x4){0u, 0u, 0u, 0u}; if (ADD) tv = *(const u32x4*)(T + off + bj * HALF);
                    const f32x4 v0 = acc[ai][bj][m][0], v1 = acc[ai][bj][m][1]; float r[8];
                    r[0] = sigm(bf_lo(g.x)) * v0[0]; r[1] = sigm(bf_hi(g.x)) * v0[1]; r[2] = sigm(bf_lo(g.y)) * v0[2]; r[3] = sigm(bf_hi(g.y)) * v0[3];
                    r[4] = sigm(bf_lo(g.z)) * v1[0]; r[5] = sigm(bf_hi(g.z)) * v1[1]; r[6] = sigm(bf_lo(g.w)) * v1[2]; r[7] = sigm(bf_hi(g.w)) * v1[3];
                    if (ADD) { r[0] += bf_lo(tv.x); r[1] += bf_hi(tv.x); r[2] += bf_lo(tv.y); r[3] += bf_hi(tv.y); r[4] += bf_lo(tv.z); r[5] += bf_hi(tv.z); r[6] += bf_lo(tv.w); r[7] += bf_hi(tv.w); }
                    u32x4 w; w.x = cvt_pk_bf16(r[0], r[1]); w.y = cvt_pk_bf16(r[2], r[3]); w.z = cvt_pk_bf16(r[4], r[5]); w.w = cvt_pk_bf16(r[6], r[7]);
                    *(u32x4*)(O + off + bj * HALF) = w; } }
    }
};
struct EpiGatePair {
    static constexpr bool PERM = true, AFTER_DRAIN = false;
    EpiGate<false> e0; EpiGate<true> e1; int nN;
    __device__ __forceinline__ void operator()(const f32x4 (&acc)[2][2][4][2], const Unit& u, int wr, int wc, int fr, int fq) const {
        if (u.pn < nN) e0(acc, u, wr, wc, fr, fq); else { Unit v = u; v.pn -= nN; e1(acc, v, wr, wc, fr, fq); } }
};
struct EpiPlainBf16 {
    static constexpr bool PERM = true, AFTER_DRAIN = false;
    bf16_t* O; int ldc;
    __device__ __forceinline__ void operator()(const f32x4 (&acc)[2][2][4][2], const Unit& u, int wr, int wc, int fr, int fq) const {
        const int row0 = u.pm * BM + wr * 64 + fr, col0 = u.pn * BM + wc * 32 + 8 * fq;
#pragma unroll
        for (int ai = 0; ai < 2; ++ai)
#pragma unroll
            for (int m = 0; m < 4; ++m) { bf16_t* rowp = O + (size_t)(row0 + ai * HALF + m * 16) * ldc + col0;
#pragma unroll
                for (int bj = 0; bj < 2; ++bj) { const f32x4 v0 = acc[ai][bj][m][0], v1 = acc[ai][bj][m][1];
                    u32x4 w; w.x = cvt_pk_bf16(v0[0], v0[1]); w.y = cvt_pk_bf16(v0[2], v0[3]); w.z = cvt_pk_bf16(v1[0], v1[1]); w.w = cvt_pk_bf16(v1[2], v1[3]);
                    *(u32x4*)(rowp + bj * HALF) = w; } }
    }
};
struct EpiResF32 {
    static constexpr bool PERM = false, AFTER_DRAIN = false;
    const float* base; float* out; int ldc;
    __device__ __forceinline__ void operator()(const f32x4 (&acc)[2][2][4][2], const Unit& u, int wr, int wc, int fr, int fq) const {
        const int row0 = u.pm * BM + wr * 64 + fr, col0 = u.pn * BM + wc * 32 + 4 * fq;
#pragma unroll
        for (int ai = 0; ai < 2; ++ai)
#pragma unroll
            for (int m = 0; m < 4; ++m) { const size_t off = (size_t)(row0 + ai * HALF + m * 16) * ldc + col0;
#pragma unroll
                for (int bj = 0; bj < 2; ++bj)
#pragma unroll
                    for (int n = 0; n < 2; ++n) *(f32x4*)(out + off + bj * HALF + n * 16) = *(const f32x4*)(base + off + bj * HALF + n * 16) + acc[ai][bj][m][n]; }
    }
};
struct EpiSwiglu {
    static constexpr bool PERM = true, AFTER_DRAIN = false;
    unsigned char* O; const float* bias; int nN; float accscale, outscale;
    typedef float f2 __attribute__((ext_vector_type(2)));
    __device__ __forceinline__ f2 act2(f2 ga, f2 ua, f2 bg, f2 bu) const {
        f2 g = __builtin_elementwise_fma(ga, (f2){accscale, accscale}, bg), u = __builtin_elementwise_fma(ua, (f2){accscale, accscale}, bu);
        g.x = fminf(g.x, 7.0f); g.y = fminf(g.y, 7.0f); u.x = __builtin_amdgcn_fmed3f(u.x, -7.0f, 7.0f); u.y = __builtin_amdgcn_fmed3f(u.y, -7.0f, 7.0f);
        const f2 t = g * (-1.702f * 1.4426950408889634f); f2 e; e.x = __builtin_amdgcn_exp2f(t.x); e.y = __builtin_amdgcn_exp2f(t.y);
        const f2 d = e + 1.0f; f2 r; r.x = __builtin_amdgcn_rcpf(d.x); r.y = __builtin_amdgcn_rcpf(d.y);
        return (u + 1.0f) * (g * outscale) * r; }
    __device__ __forceinline__ void operator()(const f32x4 (&acc)[2][2][4][2], const Unit& u, int wr, int wc, int fr, int fq) const {
        const int e = u.pn / nN, pnl = u.pn - e * nN; const int row0 = u.pm * BM + wr * 64 + fr, colg = pnl * HALF + wc * 32 + 8 * fq;
        f32x4 bg[2], bu[2];
#pragma unroll
        for (int n = 0; n < 2; ++n) { bg[n] = *(const f32x4*)(bias + (size_t)e * 2048 + colg + 4 * n); bu[n] = *(const f32x4*)(bias + (size_t)e * 2048 + 1024 + colg + 4 * n); }
#pragma unroll
        for (int ai = 0; ai < 2; ++ai)
#pragma unroll
            for (int m = 0; m < 4; ++m) { f2 r[4];
#pragma unroll
                for (int n = 0; n < 2; ++n) { const f32x4 ga = acc[ai][0][m][n], ua = acc[ai][1][m][n];
                    r[2 * n] = act2((f2){ga[0], ga[1]}, (f2){ua[0], ua[1]}, (f2){bg[n][0], bg[n][1]}, (f2){bu[n][0], bu[n][1]});
                    r[2 * n + 1] = act2((f2){ga[2], ga[3]}, (f2){ua[2], ua[3]}, (f2){bg[n][2], bg[n][3]}, (f2){bu[n][2], bu[n][3]}); }
                typedef unsigned u32x2_ __attribute__((ext_vector_type(2))); u32x2_ w; w.x = pk4_i8(r[0].x, r[0].y, r[1].x, r[1].y); w.y = pk4_i8(r[2].x, r[2].y, r[3].x, r[3].y);
                *(u32x2_*)(O + (size_t)(row0 + ai * HALF + m * 16) * 1024 + colg) = w; }
    }
};
struct EpiDown {
    static constexpr bool PERM = true, AFTER_DRAIN = false;
    unsigned char* O; const float* bias; int nN; float accscale, outscale;
    __device__ __forceinline__ void operator()(const f32x4 (&acc)[2][2][4][2], const Unit& u, int wr, int wc, int fr, int fq) const {
        const int e = u.pn / nN, pnl = u.pn - e * nN; const int row0 = u.pm * BM + wr * 64 + fr, col0 = pnl * BM + wc * 32 + 8 * fq;
        f32x4 bv[2][2];
#pragma unroll
        for (int bj = 0; bj < 2; ++bj)
#pragma unroll
            for (int n = 0; n < 2; ++n) bv[bj][n] = *(const f32x4*)(bias + (size_t)e * 1024 + col0 + bj * HALF + 4 * n);
#pragma unroll
        for (int ai = 0; ai < 2; ++ai)
#pragma unroll
            for (int m = 0; m < 4; ++m) { unsigned char* rowp = O + (size_t)(row0 + ai * HALF + m * 16) * 1024 + col0;
#pragma unroll
                for (int bj = 0; bj < 2; ++bj) { const f32x4 v0 = (acc[ai][bj][m][0] * accscale + bv[bj][0]) * outscale, v1 = (acc[ai][bj][m][1] * accscale + bv[bj][1]) * outscale;
                    typedef unsigned u32x2_ __attribute__((ext_vector_type(2))); u32x2_ w; w.x = pk4_i8(v0[0], v0[1], v0[2], v0[3]); w.y = pk4_i8(v1[0], v1[1], v1[2], v1[3]);
                    *(u32x2_*)(rowp + bj * HALF) = w; } }
    }
};

typedef int i32x4 __attribute__((ext_vector_type(4)));
template <class Epi, class Sched, bool ALIGN_EPI, bool I8 = false>
__device__ __forceinline__ void gemm_phase(PG8_LAS unsigned char* lds, const Gemm g, const Sched& S, const Epi& E, int wave_id) {
    const int wid = wave_id, lane = hw_lane(), tid = wid * 64 + lane, wr = wid >> 2, wc = wid & 3, fr = lane & 15, fq = lane >> 4;
    const int K = g.K, rowb = I8 ? K : K * 2, nt = rowb / (BK * 2);
    int RA[2], CA2[2]; unsigned voffB[2], voffA[2];
#pragma unroll
    for (int i = 0; i < 2; ++i) { int R, C; stage_rc(tid * 16 + i * 8192, R, C); const int Rb = Epi::PERM ? ((R & ~31) + perm32(R & 31)) : R;
        RA[i] = R; CA2[i] = C * 2; voffB[i] = (unsigned)(Rb * rowb + C * 2); voffA[i] = (unsigned)(R * rowb + C * 2); }
    const unsigned kstep = (unsigned)(BK * 2);
    const size_t hstep = (size_t)HALF * rowb;
    const size_t tstep = 2 * hstep;
    const unsigned ldsw = (unsigned)wid * 1024u;
    const int aoff = lds_byte(wr * 64 + fr, fq * 8), boff = lds_byte(wc * 32 + fr, fq * 8);
    const char* Abase = (const char*)g.A;
#define PG8_SA(b, h) (((b) * 2 + (h)) * HTB)
#define PG8_SB(b, h) ((4 + (b) * 2 + (h)) * HTB)
#define PG8_STAGE(bufoff, gbase, voff) do { _Pragma("unroll") for (int _i = 0; _i < 2; ++_i) \
        __builtin_amdgcn_global_load_lds((const unsigned*)((const char*)(gbase) + (voff)[_i]), (PG8_LAS unsigned*)(lds + (bufoff) + ldsw + _i * 8192), 16, 0, 0); } while (0)
#define PG8_STAGEA(bufoff, h, NX, kb) do { _Pragma("unroll") for (int _i = 0; _i < 2; ++_i) { \
        const unsigned _o = Sched::GATHER ? (((NX) ? offN[h][_i] : offC[h][_i]) + (kb)) : (voffA[_i] + (unsigned)((h) * (HALF * rowb)) + ((NX) ? uaN : uaC) + (kb)); \
        __builtin_amdgcn_global_load_lds((const unsigned*)(Abase + (size_t)_o), (PG8_LAS unsigned*)(lds + (bufoff) + ldsw + _i * 8192), 16, 0, 0); } } while (0)
#define PG8_LDA(dst, b, h) do { _Pragma("unroll") for (int m = 0; m < 4; ++m) _Pragma("unroll") for (int k = 0; k < 2; ++k) dst[m][k] = *(const PG8_LAS bf16x8*)(lds + PG8_SA(b, h) + aoff + m * 2048 + k * 1024); } while (0)
#define PG8_LDB(dst, b, h) do { _Pragma("unroll") for (int n = 0; n < 2; ++n) _Pragma("unroll") for (int k = 0; k < 2; ++k) dst[n][k] = *(const PG8_LAS bf16x8*)(lds + PG8_SB(b, h) + boff + n * 2048 + k * 1024); } while (0)
#define PG8_MMA(ai, bj, At, Bt) do { __builtin_amdgcn_s_setprio(1); _Pragma("unroll") for (int m = 0; m < 4; ++m) _Pragma("unroll") for (int n = 0; n < 2; ++n) _Pragma("unroll") for (int k = 0; k < 2; ++k) { \
        if constexpr (I8) acc[ai][bj][m][n] = __builtin_bit_cast(f32x4, __builtin_amdgcn_mfma_i32_16x16x64_i8(__builtin_bit_cast(i32x4, Bt[n][k]), __builtin_bit_cast(i32x4, At[m][k]), __builtin_bit_cast(i32x4, acc[ai][bj][m][n]), 0, 0, 0)); \
        else acc[ai][bj][m][n] = __builtin_amdgcn_mfma_f32_16x16x32_bf16(Bt[n][k], At[m][k], acc[ai][bj][m][n], 0, 0, 0); } __builtin_amdgcn_s_setprio(0); } while (0)
#define PG8_WAIT_V(n) asm volatile("s_waitcnt vmcnt(" #n ")" ::: "memory")
#define PG8_WAIT_L(n) asm volatile("s_waitcnt lgkmcnt(" #n ")" ::: "memory")
#define PG8_BAR __builtin_amdgcn_s_barrier()
#define PG8_SCHED __builtin_amdgcn_sched_barrier(0)
    Unit cur, nxt; int ui = 0;
    if (!S.next(0, cur)) return;
    f32x4 acc[2][2][4][2];
#pragma unroll
    for (int a = 0; a < 2; ++a)
#pragma unroll
        for (int b = 0; b < 2; ++b)
#pragma unroll
            for (int m = 0; m < 4; ++m)
#pragma unroll
                for (int n = 0; n < 2; ++n) acc[a][b][m][n] = (f32x4){0.f, 0.f, 0.f, 0.f};
    bf16x8 At[4][2], B0[2][2], B1[2][2];
    unsigned offC[2][2], offN[2][2];
    unsigned uaC = 0u, uaN = 0u;
    if constexpr (Sched::GATHER) {
#pragma unroll
        for (int h = 0; h < 2; ++h)
#pragma unroll
            for (int i = 0; i < 2; ++i) offC[h][i] = S.a_off(0, cur, h * HALF + RA[i], rowb) + (unsigned)CA2[i];
    } else uaC = S.a_off(0, cur, 0, rowb);
    const char* cB = (const char*)g.Bt + (size_t)cur.pn * tstep;
    PG8_STAGE(PG8_SB(0, 0), cB, voffB); PG8_STAGE(PG8_SB(0, 1), cB + hstep, voffB); PG8_STAGEA(PG8_SA(0, 0), 0, false, 0u); PG8_STAGEA(PG8_SA(0, 1), 1, false, 0u);
    if (wr == 1) PG8_BAR;
    PG8_WAIT_V(2); PG8_BAR;
    PG8_STAGE(PG8_SB(1, 0), cB + kstep, voffB); PG8_STAGEA(PG8_SA(1, 0), 0, false, kstep); PG8_STAGE(PG8_SB(1, 1), cB + hstep + kstep, voffB);
    PG8_WAIT_V(6); PG8_BAR;
    for (;;) {
        const bool has_next = S.next(ui + 1, nxt);
        const char* nB = has_next ? (const char*)g.Bt + (size_t)nxt.pn * tstep : cB;
        if constexpr (Sched::GATHER) {
#pragma unroll
            for (int h = 0; h < 2; ++h)
#pragma unroll
                for (int i = 0; i < 2; ++i) offN[h][i] = has_next ? S.a_off(ui + 1, nxt, h * HALF + RA[i], rowb) + (unsigned)CA2[i] : offC[h][i];
        } else uaN = has_next ? S.a_off(ui + 1, nxt, 0, rowb) : uaC;
#pragma unroll 1
        for (int t = 0; t < nt; t += 2) {
            const bool last = (t == nt - 2);
            const unsigned kb1 = (unsigned)(t + 1) * kstep, kb2 = last ? 0u : (unsigned)(t + 2) * kstep, kb3 = kb2 + kstep;
            const char* b2 = last ? nB : cB + (size_t)(t + 2) * kstep; const char* b3 = b2 + kstep;
            PG8_LDB(B0, 0, 0); PG8_LDB(B1, 0, 1); PG8_SCHED; PG8_LDA(At, 0, 0); PG8_STAGEA(PG8_SA(1, 1), 1, false, kb1);
            PG8_WAIT_V(8); PG8_WAIT_L(0); PG8_BAR; PG8_MMA(0, 0, At, B0); PG8_MMA(0, 1, At, B1); PG8_BAR; PG8_SCHED;
            PG8_LDA(At, 0, 1); PG8_STAGE(PG8_SB(0, 0), b2, voffB); PG8_STAGE(PG8_SB(0, 1), b2 + hstep, voffB); PG8_STAGEA(PG8_SA(0, 0), 0, last, kb2);
            PG8_WAIT_V(8); PG8_WAIT_L(0); PG8_BAR; PG8_MMA(1, 0, At, B0); PG8_MMA(1, 1, At, B1); PG8_BAR; PG8_SCHED;
            PG8_LDB(B0, 1, 0); PG8_LDB(B1, 1, 1); PG8_SCHED; PG8_LDA(At, 1, 0); PG8_STAGEA(PG8_SA(0, 1), 1, last, kb2);
            PG8_WAIT_V(8); PG8_WAIT_L(0); PG8_BAR; PG8_MMA(0, 0, At, B0); PG8_MMA(0, 1, At, B1); PG8_BAR; PG8_SCHED;
            PG8_LDA(At, 1, 1); PG8_STAGE(PG8_SB(1, 0), b3, voffB); PG8_STAGE(PG8_SB(1, 1), b3 + hstep, voffB); PG8_STAGEA(PG8_SA(1, 0), 0, last, kb3);
            PG8_WAIT_V(8); PG8_WAIT_L(0); PG8_BAR; PG8_MMA(1, 0, At, B0); PG8_MMA(1, 1, At, B1); PG8_BAR; PG8_SCHED;
        }
        if constexpr (ALIGN_EPI) { if (wr == 0) PG8_BAR; }
        if constexpr (I8) {
#pragma unroll
            for (int a = 0; a < 2; ++a)
#pragma unroll
                for (int b = 0; b < 2; ++b)
#pragma unroll
                    for (int m = 0; m < 4; ++m)
#pragma unroll
                        for (int n = 0; n < 2; ++n) { const i32x4 iv = __builtin_bit_cast(i32x4, acc[a][b][m][n]); acc[a][b][m][n] = (f32x4){(float)iv[0], (float)iv[1], (float)iv[2], (float)iv[3]}; } }
        E(acc, cur, wr, wc, fr, fq);
        if (!has_next) break;
#pragma unroll
        for (int a = 0; a < 2; ++a)
#pragma unroll
            for (int b = 0; b < 2; ++b)
#pragma unroll
                for (int m = 0; m < 4; ++m)
#pragma unroll
                    for (int n = 0; n < 2; ++n) acc[a][b][m][n] = (f32x4){0.f, 0.f, 0.f, 0.f};
        cur = nxt; cB = nB; ++ui; uaC = uaN;
        if constexpr (Sched::GATHER) {
#pragma unroll
            for (int h = 0; h < 2; ++h)
#pragma unroll
                for (int i = 0; i < 2; ++i) offC[h][i] = offN[h][i]; }
        if constexpr (ALIGN_EPI) { if (wr == 1) PG8_BAR; }
    }
    PG8_WAIT_V(0);
    if constexpr (!ALIGN_EPI) { if (wr == 0) PG8_BAR; }
    PG8_BAR;
#undef PG8_SA
#undef PG8_SB
#undef PG8_STAGE
#undef PG8_STAGEA
#undef PG8_LDA
#undef PG8_LDB
#undef PG8_MMA
#undef PG8_WAIT_V
#undef PG8_WAIT_L
#undef PG8_BAR
#undef PG8_SCHED
}
}
#include <hip/hip_bf16.h>
#include <cmath>
namespace attn_body {
using bf16=__hip_bfloat16;
using bf16x8=__attribute__((ext_vector_type(8)))short;
using s16x4=__attribute__((ext_vector_type(4)))short;
using f32x16=__attribute__((ext_vector_type(16)))float;
using u32x4=__attribute__((ext_vector_type(4)))unsigned;
constexpr int BATCH=4,NHEAD=16,SEQ=4096,D=64,DM=NHEAD*D;
constexpr int NW=8,QBLK=32,QB=QBLK*NW,KVBLK=64,NQB=SEQ/QB;
constexpr int ATTN_PITCH=DM, ATTN_UNIT_ROWS=QB;
__device__ __forceinline__ int crow(int r,int hi){return (r&3)+8*(r>>2)+4*hi;}
#define SBAR() __builtin_amdgcn_sched_barrier(0)
__device__ __forceinline__ void cmask(f32x16&p0,f32x16&p1,int jb,int qrel,int hi){
  const float NEG=-INFINITY; int kb=64*jb+4*hi;
  #pragma unroll
  for(int r=0;r<16;++r){int kv=kb+(r&3)+8*(r>>2); if(kv>qrel)p0[r]=NEG; if(kv+32>qrel)p1[r]=NEG;}
}

constexpr int NSLOT=3, SLOTB=8192;
constexpr int LDS_K=0, LDS_V=NSLOT*SLOTB, LDS_WS=2*NSLOT*SLOTB, LDS_OST=LDS_WS+NW*64*4, LDS_KB=LDS_OST+NW*4096, LDS_BYTES=LDS_KB+SEQ*4+256;
constexpr float C2=0.125f*1.4426950408889634f;
__device__ __forceinline__ void glds16(const void*gsrc,unsigned lds_dst){unsigned keep;
  asm volatile("s_mov_b32 %0, m0\n\ts_mov_b32 m0, %2\n\ts_nop 0\n\tglobal_load_lds_dwordx4 %1, off\n\ts_mov_b32 m0, %0":"=&s"(keep):"v"(gsrc),"s"(lds_dst):"memory");}
__device__ __forceinline__ float max3f(float a,float b,float c){float r;asm("v_max3_f32 %0, %1, %2, %3":"=v"(r):"v"(a),"v"(b),"v"(c));return r;}
__device__ __forceinline__ float max2f(float a,float b){float r;asm("v_max_f32_e32 %0, %1, %2":"=v"(r):"v"(a),"v"(b));return r;}
__device__ __forceinline__ float fadd_s(float a,float b){float r;asm("v_add_f32_e32 %0, %1, %2":"=v"(r):"v"(a),"v"(b));return r;}
__device__ __forceinline__ float fsub_s(float a,float b){float r;asm("v_sub_f32_e32 %0, %1, %2":"=v"(r):"v"(a),"v"(b));return r;}
typedef float f32x2_t __attribute__((ext_vector_type(2))); typedef __bf16 bf16x2_t __attribute__((ext_vector_type(2)));
__device__ __forceinline__ unsigned cvtpk_s(float lo,float hi){f32x2_t v={lo,hi};bf16x2_t b=__builtin_convertvector(v,bf16x2_t);return __builtin_bit_cast(unsigned,b);}
#define WAIT_BAR(N) asm volatile("s_waitcnt vmcnt(" #N ") lgkmcnt(0)\n\ts_barrier":::"memory")

__device__ __forceinline__ void qkt(f32x16&p0,f32x16&p1,const char*Kslot,const bf16x8*qr,int r32,int hi){
  const char*kb=Kslot+hi*1024+r32*16;
  #pragma unroll
  for(int d0=0;d0<4;++d0){
    const bf16x8 b0=*reinterpret_cast<const bf16x8*>(kb+d0*2048);
    const bf16x8 b1=*reinterpret_cast<const bf16x8*>(kb+d0*2048+512);
    p0=__builtin_amdgcn_mfma_f32_32x32x16_bf16(b0,qr[d0],p0,0,0,0);p1=__builtin_amdgcn_mfma_f32_32x32x16_bf16(b1,qr[d0],p1,0,0,0);}
}
typedef __attribute__((address_space(3))) const char* lds_cptr;
typedef short v4i16_t __attribute__((ext_vector_type(4)));
__device__ __forceinline__ void kload8(bf16x8*kf,lds_cptr kp){
  kf[0]=*(const __attribute__((address_space(3))) bf16x8*)(kp);      kf[1]=*(const __attribute__((address_space(3))) bf16x8*)(kp+512);
  kf[2]=*(const __attribute__((address_space(3))) bf16x8*)(kp+2048); kf[3]=*(const __attribute__((address_space(3))) bf16x8*)(kp+2560);
  kf[4]=*(const __attribute__((address_space(3))) bf16x8*)(kp+4096); kf[5]=*(const __attribute__((address_space(3))) bf16x8*)(kp+4608);
  kf[6]=*(const __attribute__((address_space(3))) bf16x8*)(kp+6144); kf[7]=*(const __attribute__((address_space(3))) bf16x8*)(kp+6656);
}
__device__ __forceinline__ void kload2(bf16x8*kf,lds_cptr kp,int j){ kf[2*j]=*(const __attribute__((address_space(3))) bf16x8*)(kp+j*2048); kf[2*j+1]=*(const __attribute__((address_space(3))) bf16x8*)(kp+j*2048+512); }
__device__ __forceinline__ s16x4 vtr(lds_cptr p){ return __builtin_bit_cast(s16x4,__builtin_amdgcn_ds_read_tr16_b64_v4i16((__attribute__((address_space(3))) v4i16_t*)p)); }
__device__ __forceinline__ float rowmax(const f32x16&p0,const f32x16&p1){
  float a=max3f(p0[0],p0[1],p1[0]),b=max3f(p0[2],p0[3],p1[1]);a=max3f(a,p1[2],p1[3]);
  #pragma unroll
  for(int r=4;r<16;r+=4){a=max3f(a,p0[r],p0[r+1]);b=max3f(b,p0[r+2],p0[r+3]);a=max3f(a,p1[r],p1[r+1]);b=max3f(b,p1[r+2],p1[r+3]);}
  const float m=max2f(a,b);
  auto rr=__builtin_amdgcn_permlane32_swap(__float_as_uint(m),__float_as_uint(m),false,false);
  return max2f(__uint_as_float(rr[0]),__uint_as_float(rr[1]));
}
__device__ __forceinline__ void pv(f32x16*o,int vb,bf16x8 pa0,bf16x8 pa1,bf16x8 pa2,bf16x8 pa3){
  #pragma unroll
  for(int d0=0;d0<2;++d0){s16x4 lo[4],hi[4];
    #pragma unroll
    for(int ks=0;ks<4;++ks){
      asm volatile("ds_read_b64_tr_b16 %0,%1 offset:%c2":"=&v"(lo[ks]):"v"(vb),"i"(d0*4096+ks*1024):"memory");
      asm volatile("ds_read_b64_tr_b16 %0,%1 offset:%c2":"=&v"(hi[ks]):"v"(vb),"i"(d0*4096+ks*1024+512):"memory");}
    asm volatile("s_waitcnt lgkmcnt(0)":::"memory");SBAR();
    #define PK(k) (bf16x8){lo[k][0],lo[k][1],lo[k][2],lo[k][3],hi[k][0],hi[k][1],hi[k][2],hi[k][3]}
    o[d0]=__builtin_amdgcn_mfma_f32_32x32x16_bf16(pa0,PK(0),o[d0],0,0,0);
    o[d0]=__builtin_amdgcn_mfma_f32_32x32x16_bf16(pa1,PK(1),o[d0],0,0,0);
    o[d0]=__builtin_amdgcn_mfma_f32_32x32x16_bf16(pa2,PK(2),o[d0],0,0,0);
    o[d0]=__builtin_amdgcn_mfma_f32_32x32x16_bf16(pa3,PK(3),o[d0],0,0,0);
    #undef PK
  }
}

#ifndef ATTN_STORE16
#define ATTN_STORE16(p,v) (*(u32x4*)(p)=(v))
#endif
typedef float f32x4v __attribute__((ext_vector_type(4)));
template<int THRL> __device__ __forceinline__ void attn_unit(int b,int h,int qb,const bf16*Q,const bf16*__restrict__ K,const bf16*__restrict__ V,bf16*O,const float*__restrict__ KBg,float qk2max,char*shm,int wave_id){
  const int wid=wave_id,lane=hw_lane(),tid=wid*64+lane,r32=lane&31,hi=lane>>5;
  const long rowbase=(long)b*SEQ; const int q0=qb*QB;
  const bf16*Qw=Q+(rowbase+q0+wid*QBLK)*DM+h*D;
  int ts=0;
  { const int NT0=(q0+QB)/KVBLK; const float lim=KBg[q0]-2.0f*__builtin_sqrtf(qk2max)-32.0f;
    const float kbl=(lane<NT0)?KBg[64*lane+63]:INFINITY; const unsigned long long bal=__ballot(kbl<lim);
    ts=(int)__builtin_popcountll(bal)&~1; if(ts>NT0-4)ts=NT0-4; ts=__builtin_amdgcn_readfirstlane(ts); }
  KBg+=ts*KVBLK;
  const bf16*Kh=K+(rowbase+(long)ts*KVBLK)*DM+h*D,*Vh=V+(rowbase+(long)ts*KVBLK)*DM+h*D;
  const unsigned lds0=(unsigned)(uintptr_t)shm;
  float*wsf=(float*)(shm+LDS_WS)+wid*64;
  const bf16*ksrc=Kh+(long)lane*DM+wid*8;
  const bf16*vsrc=Vh+(long)(16*(wid&3)+(lane>>2))*DM+(wid>>2)*32+(lane&3)*8;
  const unsigned kdst=lds0+LDS_K+wid*1024, vdst=lds0+LDS_V+wid*1024;
  #define DMA_K(t,slot) glds16(ksrc+(long)(t)*KVBLK*DM,(unsigned)__builtin_amdgcn_readfirstlane(kdst+(slot)))
  #define DMA_V(t,slot) glds16(vsrc+(long)(t)*KVBLK*DM,(unsigned)__builtin_amdgcn_readfirstlane(vdst+(slot)))
  const int vb0=(int)(lds0+LDS_V)+((lane>>4)&1)*32+(lane&3)*8+(4*hi+((lane&15)>>2))*64;
  const char*Kbase=shm+LDS_K; bf16x8 kf[8];
  const lds_cptr shm3=(lds_cptr)shm; const lds_cptr kp0=shm3+LDS_K+hi*1024+r32*16; const lds_cptr vp0=shm3+LDS_V+((lane>>4)&1)*32+(lane&3)*8+(4*hi+((lane&15)>>2))*64;
  const int NT=(q0+QB)/KVBLK-ts;
  const int nkb4=(q0+QB-ts*KVBLK)>>2; f32x4v kbt0=(f32x4v){0.f,0.f,0.f,0.f},kbt1=kbt0;
  { const f32x4v*src=(const f32x4v*)KBg; if(tid<nkb4)kbt0=src[tid]; if(tid+512<nkb4)kbt1=src[tid+512]; }
  DMA_K(0,0);DMA_V(0,0);DMA_K(1,SLOTB);
  bf16x8 qr[4];
  #pragma unroll
  for(int d0=0;d0<4;++d0)qr[d0]=*reinterpret_cast<const bf16x8*>(&Qw[(long)r32*DM+d0*16+hi*8]);
  { __attribute__((address_space(3))) f32x4v*kd=(__attribute__((address_space(3))) f32x4v*)((lds_cptr)shm+LDS_KB); if(tid<nkb4)kd[tid]=kbt0; if(tid+512<nkb4)kd[tid+512]=kbt1; }
  const lds_cptr kbp=(lds_cptr)shm+LDS_KB+hi*16;
  #define KBV(t,g8) (*(const __attribute__((address_space(3))) f32x4v*)(kbp+(t)*256+(g8)*32))
  float mhat=0.f,l_reg=0.f;f32x16 o[2];o[0]=f32x16{};o[1]=f32x16{};
  const int qrel=wid*QBLK+r32;
  #define CMASK(P0,P1,t) do{int jb_=(t)-(NT-4); if(jb_>=0)cmask(P0,P1,jb_,qrel,hi);}while(0)
  bool resc=false;
  #define START(P0,P1) do{ const float rm=rowmax(P0,P1); resc=false; \
    { const float dl=rm; mhat=fadd_s(mhat,dl); \
      _Pragma("unroll") for(int r=0;r<16;++r){P0[r]=fsub_s(P0[r],dl);P1[r]=fsub_s(P1[r],dl);} } \
    _Pragma("unroll") for(int r=0;r<16;++r)P0[r]=__builtin_amdgcn_exp2f(P0[r]); }while(0)
  #define RESC() do{ if(resc){ asm volatile("s_waitcnt lgkmcnt(0)":::"memory"); \
      _Pragma("unroll") for(int d_=0;d_<2;++d_) _Pragma("unroll") for(int r=0;r<16;++r)o[d_][r]*=wsf[crow(r,hi)]; } }while(0)
  f32x16 pA0,pA1,pB0,pB1;
  int sl_prev=0,sl_cur=0,sl_next=SLOTB;
  #define ROT() do{sl_prev=sl_cur;sl_cur=sl_next;sl_next=(sl_next==(NSLOT-1)*SLOTB)?0:sl_next+SLOTB;}while(0)
  DMA_K(2,2*SLOTB);
  WAIT_BAR(3);
  #define KBINIT(P0,P1,t) do{ _Pragma("unroll") for(int g_=0;g_<4;++g_){ const f32x4v a_=KBV(t,g_),b_=KBV(t,g_+4); \
      P0[4*g_]=a_[0]-mhat;P0[4*g_+1]=a_[1]-mhat;P0[4*g_+2]=a_[2]-mhat;P0[4*g_+3]=a_[3]-mhat; P1[4*g_]=b_[0]-mhat;P1[4*g_+1]=b_[1]-mhat;P1[4*g_+2]=b_[2]-mhat;P1[4*g_+3]=b_[3]-mhat; } }while(0)
  KBINIT(pA0,pA1,0);
  qkt(pA0,pA1,Kbase,qr,r32,hi);asm volatile("s_nop 15\n\ts_nop 7":"+v"(pA0),"+v"(pA1));CMASK(pA0,pA1,0);
  START(pA0,pA1);
  _Pragma("unroll") for(int r=0;r<16;++r)pA1[r]=__builtin_amdgcn_exp2f(pA1[r]);
  WAIT_BAR(0);
  DMA_K(3,0);DMA_V(1,SLOTB);
  ROT();
  kload8(kf,kp0+sl_cur);
  KBINIT(pB0,pB1,1);
  WAIT_BAR(2);
  s16x4 vlo[8],vhi[8]; u32x4 pw0,pw1,pw2,pw3;
  #define PKW(P,B) cvtpk_s(P[B],P[B+1])
  #define PAF(k) __builtin_bit_cast(bf16x8,pw##k)
  #define VFR(i) (bf16x8){vlo[i][0],vlo[i][1],vlo[i][2],vlo[i][3],vhi[i][0],vhi[i][1],vhi[i][2],vhi[i][3]}
  #define PIN(x) asm volatile("":"+v"(x))
  #define MX3(a,b,c) __builtin_fmaxf(__builtin_fmaxf((a),(b)),(c))
  #define GAPA(MF,A0,A1,A2,A3,W0,W1,PW) do{ MF; sacc+=A0; sacc+=A1; sacc+=A2; sacc+=A3; PIN(sacc); W0; W1; PIN(PW); SBAR(); }while(0)
  #define EX(v) __builtin_amdgcn_exp2f(v)
  #define GAPB(MF,X,B,Y,KU,KL,G8N,t) do{ if((G8N)>=0){KL=KBV((t)+1,(G8N)<0?0:(G8N));} MF; X[B]=EX(X[B]); X[B+1]=EX(X[B+1]); X[B+2]=EX(X[B+2]); X[B+3]=EX(X[B+3]); PIN(X); \
      Y[B]=KU[0]-mhat; Y[B+1]=KU[1]-mhat; Y[B+2]=KU[2]-mhat; Y[B+3]=KU[3]-mhat; PIN(Y); SBAR(); }while(0)
  #define VRD(i) do{ vlo[i]=vtr(vp_+(((i)>>2)*4096+((i)&3)*1024)); vhi[i]=vtr(vp_+(((i)>>2)*4096+((i)&3)*1024+512)); }while(0)
  #define KRD(G,j) do{ if(G){ kload2(kf,kp0+sl_next,j); SBAR(); } }while(0)
  #define STEP(C0,C1,P0,P1,t,GK,GV,GL) do{ SBAR(); \
    const lds_cptr vp_=vp0+sl_prev; \
    VRD(0); SBAR(); float sacc=(P0[0]+P0[1]); \
    GAPA(C0=__builtin_amdgcn_mfma_f32_32x32x16_bf16(kf[0],qr[0],C0,0,0,0), P0[2],P0[3],P0[4],P0[5],     pw0[0]=PKW(P0,0), pw0[1]=PKW(P0,2), pw0); \
    VRD(4); SBAR(); GAPA(C1=__builtin_amdgcn_mfma_f32_32x32x16_bf16(kf[1],qr[0],C1,0,0,0), P0[6],P0[7],P0[8],P0[9],     pw0[2]=PKW(P0,4), pw0[3]=PKW(P0,6), pw0); \
    VRD(1); SBAR(); GAPA(C0=__builtin_amdgcn_mfma_f32_32x32x16_bf16(kf[2],qr[1],C0,0,0,0),   P0[10],P0[11],P0[12],P0[13], pw1[0]=PKW(P0,8), pw1[1]=PKW(P0,10), pw1); \
    VRD(5); SBAR(); GAPA(C1=__builtin_amdgcn_mfma_f32_32x32x16_bf16(kf[3],qr[1],C1,0,0,0),   P0[14],P0[15],P1[0],P1[1],   pw1[2]=PKW(P0,12),pw1[3]=PKW(P0,14), pw1); \
    VRD(2); SBAR(); GAPA(C0=__builtin_amdgcn_mfma_f32_32x32x16_bf16(kf[4],qr[2],C0,0,0,0),   P1[2],P1[3],P1[4],P1[5],     pw2[0]=PKW(P1,0), pw2[1]=PKW(P1,2), pw2); \
    VRD(6); SBAR(); GAPA(C1=__builtin_amdgcn_mfma_f32_32x32x16_bf16(kf[5],qr[2],C1,0,0,0),   P1[6],P1[7],P1[8],P1[9],     pw2[2]=PKW(P1,4), pw2[3]=PKW(P1,6), pw2); \
    VRD(3); SBAR(); GAPA(C0=__builtin_amdgcn_mfma_f32_32x32x16_bf16(kf[6],qr[3],C0,0,0,0),   P1[10],P1[11],P1[12],P1[13], pw3[0]=PKW(P1,8), pw3[1]=PKW(P1,10), pw3); \
    VRD(7); SBAR(); GAPA(C1=__builtin_amdgcn_mfma_f32_32x32x16_bf16(kf[7],qr[3],C1,0,0,0),   P1[14],P1[15],0.f,0.f,       pw3[2]=PKW(P1,12),pw3[3]=PKW(P1,14), pw3); \
    l_reg+=sacc; \
    if(GK){DMA_K((t)+3,sl_cur);} if(GV){DMA_V((t)+1,sl_next);} \
    CMASK(C0,C1,t); \
    { float a=MX3(C0[0],C0[1],C1[0]),b=MX3(C0[2],C0[3],C1[1]); a=MX3(a,C1[2],C1[3]); \
      _Pragma("unroll") for(int r=4;r<16;r+=4){a=MX3(a,C0[r],C0[r+1]);b=MX3(b,C0[r+2],C0[r+3]);a=MX3(a,C1[r],C1[r+1]);b=MX3(b,C1[r+2],C1[r+3]);} \
      float rm=__builtin_fmaxf(a,b); { auto rr=__builtin_amdgcn_permlane32_swap(__float_as_uint(rm),__float_as_uint(rm),false,false); rm=__builtin_fmaxf(__uint_as_float(rr[0]),__uint_as_float(rr[1])); } \
      resc=false; \
      if(__builtin_expect(__any(rm>(float)THRL),0)){ const float dl=__builtin_fmaxf(rm,0.f); mhat+=dl; \
        _Pragma("unroll") for(int r=0;r<16;++r){C0[r]-=dl;C1[r]-=dl;} \
        const float f=__builtin_amdgcn_exp2f(-dl); l_reg*=f; if(hi==0)wsf[r32]=f; resc=true; } } \
    SBAR(); \
    f32x4v kq0_=KBV((t)+1,0),kq1_; \
    GAPB(o[0]=__builtin_amdgcn_mfma_f32_32x32x16_bf16(PAF(0),VFR(0),o[0],0,0,0), C0,0, P0,kq0_,kq1_,1,t); \
    GAPB(o[1]=__builtin_amdgcn_mfma_f32_32x32x16_bf16(PAF(0),VFR(4),o[1],0,0,0), C0,4, P0,kq1_,kq0_,2,t); \
    KRD(GL,0); GAPB(o[0]=__builtin_amdgcn_mfma_f32_32x32x16_bf16(PAF(1),VFR(1),o[0],0,0,0), C0,8, P0,kq0_,kq1_,3,t); \
    KRD(GL,1); GAPB(o[1]=__builtin_amdgcn_mfma_f32_32x32x16_bf16(PAF(1),VFR(5),o[1],0,0,0), C0,12, P0,kq1_,kq0_,4,t); \
    KRD(GL,2); GAPB(o[0]=__builtin_amdgcn_mfma_f32_32x32x16_bf16(PAF(2),VFR(2),o[0],0,0,0), C1,0, P1,kq0_,kq1_,5,t); \
    KRD(GL,3); GAPB(o[1]=__builtin_amdgcn_mfma_f32_32x32x16_bf16(PAF(2),VFR(6),o[1],0,0,0), C1,4, P1,kq1_,kq0_,6,t); \
    GAPB(o[0]=__builtin_amdgcn_mfma_f32_32x32x16_bf16(PAF(3),VFR(3),o[0],0,0,0), C1,8, P1,kq0_,kq1_,7,t); \
    GAPB(o[1]=__builtin_amdgcn_mfma_f32_32x32x16_bf16(PAF(3),VFR(7),o[1],0,0,0), C1,12, P1,kq1_,kq0_,-1,t); \
    }while(0)
  int t=1;
  #undef CMASK
  #define CMASK(P0,P1,t) do{}while(0)
  for(;t+5<NT;t+=2){
    STEP(pB0,pB1,pA0,pA1,t,true,true,true);     WAIT_BAR(2); RESC(); ROT();
    STEP(pA0,pA1,pB0,pB1,t+1,true,true,true);   WAIT_BAR(2); RESC(); ROT();
  }
  #undef CMASK
  #define CMASK(P0,P1,t) do{int jb_=(t)-(NT-4); if(jb_>=0)cmask(P0,P1,jb_,qrel,hi);}while(0)
  #define ENDW(tt) do{ if((tt)+3<NT){WAIT_BAR(2);} else if((tt)+2<NT){WAIT_BAR(1);} else {WAIT_BAR(0);} }while(0)
  for(;t+1<NT;t+=2){
    STEP(pB0,pB1,pA0,pA1,t,(t+3<NT),(t+1<NT),(t+1<NT));       ENDW(t);   RESC(); ROT();
    STEP(pA0,pA1,pB0,pB1,t+1,(t+4<NT),(t+2<NT),(t+2<NT));     ENDW(t+1); RESC(); ROT();
  }
  STEP(pB0,pB1,pA0,pA1,NT-1,false,false,false); RESC();
  { float sacc=pB0[0]+pB0[1]; _Pragma("unroll") for(int r=2;r<16;++r)sacc+=pB0[r]; _Pragma("unroll") for(int r=0;r<16;++r)sacc+=pB1[r]; l_reg+=sacc;
    pw0=(u32x4){PKW(pB0,0),PKW(pB0,2),PKW(pB0,4),PKW(pB0,6)};pw1=(u32x4){PKW(pB0,8),PKW(pB0,10),PKW(pB0,12),PKW(pB0,14)};pw2=(u32x4){PKW(pB1,0),PKW(pB1,2),PKW(pB1,4),PKW(pB1,6)};pw3=(u32x4){PKW(pB1,8),PKW(pB1,10),PKW(pB1,12),PKW(pB1,14)};
    SBAR(); pv(o,vb0+sl_cur,PAF(0),PAF(1),PAF(2),PAF(3)); }
  #undef PKW
  #undef PAF
  #undef VFR
  #undef PIN
  #undef MX3
  #undef GAPA
  #undef GAPB
  #undef EX
  #undef VRD
  #undef KRD
  #undef STEP
  #undef ENDW
  {auto rr=__builtin_amdgcn_permlane32_swap(__float_as_uint(l_reg),__float_as_uint(l_reg),false,false);l_reg=__uint_as_float(rr[0])+__uint_as_float(rr[1]);}
  if(hi==0)wsf[32+r32]=l_reg;asm volatile("s_waitcnt lgkmcnt(0)":::"memory");
  float rli[16];
  #pragma unroll
  for(int r=0;r<16;++r)rli[r]=__builtin_amdgcn_rcpf(wsf[32+crow(r,hi)]);
  bf16*Ow=O+(rowbase+q0+wid*QBLK)*DM+h*D;
  { bf16*stg=(bf16*)(shm+LDS_OST)+wid*2048;
    #pragma unroll
    for(int r=0;r<16;++r){const int orow=crow(r,hi);
      #pragma unroll
      for(int d0=0;d0<2;++d0)stg[orow*64+d0*32+r32]=__float2bfloat16(o[d0][r]*rli[r]);}
    asm volatile("s_waitcnt lgkmcnt(0)":::"memory");
    #pragma unroll
    for(int i=0;i<4;++i){const int row=i*8+(lane>>3),ch=lane&7; const u32x4 v=*(const u32x4*)(stg+row*64+ch*8); ATTN_STORE16(Ow+(long)row*DM+ch*8,v);} }
  asm volatile("s_waitcnt lgkmcnt(0)\n\ts_barrier":::"memory");
  #undef DMA_K
  #undef DMA_V
  #undef KBV
  #undef KBINIT
  #undef CMASK
  #undef START
  #undef RESC
  #undef ROT
}
constexpr int ATTN_LDS_BYTES=LDS_BYTES;
struct AttnTensors { const bf16* Q; const bf16* K; const bf16* V; bf16* O; const float* KB; const unsigned* QN2; const unsigned* KN2; };
struct AttnUnit { int bh; int qb; };
struct StaticOrder {
  int vcu, G, i0, i1;
  __device__ __forceinline__ explicit StaticOrder(int grid,int block):vcu((grid%8==0)?(block%8)*(grid/8)+block/8:block),G(grid),i0(0),i1(0x7fffffff){}
  __device__ __forceinline__ bool next(int i_,AttnUnit&u)const{ if(i_>=i1-i0)return false; const int i=i_+i0;
    if(G==256){ if(i>=4)return false; const int s=vcu&3; u.bh=vcu>>2; u.qb=(i==0)?s:(i==1)?7-s:(i==2)?8+s:15-s; return true; }
    const int L=i*G+vcu; if(L>=BATCH*NHEAD*NQB)return false; u.qb=NQB-1-L/(BATCH*NHEAD); u.bh=L%(BATCH*NHEAD); return true; }
  __device__ __forceinline__ void a_ready(const AttnUnit&)const{}
  __device__ __forceinline__ void done(const AttnUnit&)const{}
};
template<class Sched,int THRL=8> __device__ __forceinline__ void attn_phase(char*lds,const AttnTensors&T,const Sched&S,int wave_id){
  AttnUnit u;
  for(int i=0;S.next(i,u);++i){ S.a_ready(u); attn_unit<THRL>(u.bh/NHEAD,u.bh%NHEAD,u.qb,T.Q,T.K,T.V,T.O,T.KB+(size_t)u.bh*SEQ,__uint_as_float(T.QN2[u.bh*NQB+u.qb])*__uint_as_float(T.KN2[u.bh]),lds,wave_id); S.done(u); }
}
#undef SBAR
#undef WAIT_BAR
}
constexpr int NWAVES = 8;
#ifndef MK_N_LAUNCHES
#define MK_N_LAUNCHES 1
#endif
constexpr int PER_PHASE = 10;
constexpr int N_LAUNCHES = MK_N_LAUNCHES;

constexpr int BATCH = 4, SEQ = 4096, D = 1024, M = BATCH * SEQ;
constexpr int IN_COLS = 7184, NPROJ = 7168, FCOL0 = 5120;
constexpr int NE = 32, DFF = 1024, MAXTILES = 288, SLOTS = MAXTILES * 256;
constexpr int LRU_TS = 128, LRU_NSEG = SEQ / LRU_TS, LRU_UNITS = BATCH * 16 * LRU_NSEG;
constexpr float RMS_EPS = 1e-6f, LOG2E = 1.4426950408889634f;
constexpr float W8_SCALE = 127.0f * 32.0f / 4.0f, H8_SCALE = 127.0f / 4.0f, ACT8_SCALE = 127.0f / 8.0f, Y8_SCALE = 127.0f / 4.0f;

constexpr size_t MiB = 1u << 20;
constexpr size_t WS_CTL = 0, CTL_ZERO_BYTES = 128 * 1024;
constexpr size_t WS_WIN = 2 * MiB, WS_WLRU = 16 * MiB, WS_WFOX = 18 * MiB, WS_WO = 20 * MiB;
constexpr size_t WS_WG = 22 * MiB, WS_SP = 22 * MiB + 512 * 1024;
constexpr size_t WS_LOGF = 23 * MiB, WS_KB = 24 * MiB, WS_SEG = 25 * MiB, WS_ROUTE = 26 * MiB, WS_TOKMAP = 27 * MiB;
constexpr size_t WS_H2 = 960 * MiB;
constexpr size_t WS_H = 32 * MiB;
constexpr size_t WS_WGU = 64 * MiB, WS_WD = 192 * MiB;
constexpr size_t WS_PROJ = 256 * MiB, PROJ_STRIDE = 32 * MiB;
constexpr size_t WS_YLRU = 480 * MiB, WS_TMP = 512 * MiB, WS_MERGED = 544 * MiB, WS_X1 = 576 * MiB;
constexpr size_t WS_X1B = WS_MERGED;
constexpr size_t WS_ACT = 640 * MiB, WS_Y = 784 * MiB, WS_YFOX = 928 * MiB, WS_END = 976 * MiB;
static_assert(WS_Y + (size_t)SLOTS * 1024 * 2 <= WS_YFOX && WS_ACT + (size_t)SLOTS * 1024 * 2 <= WS_Y, "d_ws map");
constexpr int CW_TMO = 0, CW_CODE = 1;
constexpr int CW_BAR = 4096;
constexpr int CW_CNT = 16384;
constexpr int CW_KN = 20480, CW_QN = 20544;                          static_assert((20544 + 64 * 16) * 4 <= 128 * 1024, "control words inside the memset region");
constexpr int CW_END_ = 0;

constexpr int RING_OFF = 0, RING_BYTES = 131072;
constexpr int LDSCTL_OFF = RING_BYTES, MISC_OFF = LDSCTL_OFF + 320, EXTRA_OFF = LDSCTL_OFF + 512;
constexpr int LDS_BYTES = 147456;
constexpr int EX_TILE_E = 0, EX_NCNT = 320, EX_TPRE = 448, EX_ROWS = 1024, EX_MAXU = 14;
static_assert(EXTRA_OFF + EX_ROWS + EX_MAXU * 1024 <= LDS_BYTES, "LDS map");

#define GAS __attribute__((address_space(1)))
#define LAS __attribute__((address_space(3)))
typedef unsigned short bf16;
typedef unsigned v4u __attribute__((ext_vector_type(4)));
typedef unsigned v2u __attribute__((ext_vector_type(2)));
typedef float f32x4 __attribute__((ext_vector_type(4)));
typedef float f32x2 __attribute__((ext_vector_type(2)));
typedef short bf16x8 __attribute__((ext_vector_type(8)));
typedef GAS unsigned gu32;
typedef GAS unsigned long long gu64;
#define RLX_AGENT __ATOMIC_RELAXED, __HIP_MEMORY_SCOPE_AGENT
#define LDS_WAIT() asm volatile("s_waitcnt lgkmcnt(0)" ::: "memory")
#define VM_WAIT() asm volatile("s_waitcnt vmcnt(0)" ::: "memory")
__device__ __forceinline__ unsigned pk2(float lo, float hi) { return pg8::cvt_pk_bf16(lo, hi); }
__device__ __forceinline__ float bflo(unsigned w) { return __uint_as_float(w << 16); }
__device__ __forceinline__ float bfhi(unsigned w) { return __uint_as_float(w & 0xffff0000u); }
__device__ __forceinline__ float sigm(float x) { return __builtin_amdgcn_rcpf(1.0f + __builtin_amdgcn_exp2f(-LOG2E * x)); }
__device__ __forceinline__ float gelu_tanh(float x) { const float u = 0.7978845608028654f * (x + 0.044715f * x * x * x); return x * sigm(2.0f * u); }

#define XB_TMO      128
#define XB_XCNT(j)  (256  + 64 * (j))
#define XB_XSUB(j)  (1280 + 64 * (j))
#define XB_XGEN(j)  (2304 + 64 * (j))
#define XB_TOP      3328
#define XB_TOPGEN   3392
#define XCD_BAR_WORDS 3456
#define XB_SPIN_CAP (1u << 18)

__device__ __forceinline__ unsigned xb_ld(unsigned* p)              { return __hip_atomic_load(p, __ATOMIC_RELAXED, __HIP_MEMORY_SCOPE_AGENT); }
__device__ __forceinline__ unsigned xb_add(unsigned* p, unsigned v) { return __hip_atomic_fetch_add(p, v, __ATOMIC_RELAXED, __HIP_MEMORY_SCOPE_AGENT); }
__device__ __forceinline__ unsigned xb_xcc_id() { return (unsigned)__builtin_amdgcn_s_getreg((3 << 11) | 20) & 0xFu; }
#define XB_SPIN(cond, bar) do { unsigned _sp = 0; while (cond) { __builtin_amdgcn_s_sleep(1); \
    if ((++_sp & 255u) == 0u) { if (xb_ld(&(bar)[XB_TMO])) break; if (_sp > XB_SPIN_CAP) { atomicAdd(&(bar)[XB_TMO], 1u); break; } } } } while (0)

struct XcdBarrier {
    unsigned* bar; unsigned x;
    volatile LAS unsigned* st;
};
__device__ __forceinline__ XcdBarrier xcd_barrier_post(unsigned* bar, volatile LAS unsigned* st) {
    XcdBarrier b; b.bar = bar; b.x = xb_xcc_id(); b.st = st;
    if (threadIdx.x == 0) (void)xb_add(&bar[XB_XCNT(b.x)], 1u);
    return b;
}
__device__ __forceinline__ void xcd_barrier_complete(unsigned* bar, unsigned x, unsigned& nloc, unsigned& nx) {
    const unsigned G = gridDim.x * gridDim.y * gridDim.z;
    unsigned sum, cnt, mine, sp = 0u;
    for (;;) {
        sum = 0u; cnt = 0u; mine = 0u;
#pragma unroll
        for (unsigned j = 0; j < 16; ++j) { const unsigned c = xb_ld(&bar[XB_XCNT(j)]); sum += c; cnt += (c > 0u) ? 1u : 0u; mine = (j == x) ? c : mine; }
        if (sum == G) break;
        __builtin_amdgcn_s_sleep(1);
        if ((++sp & 255u) == 0u) { if (xb_ld(&bar[XB_TMO])) break; if (sp > XB_SPIN_CAP) { atomicAdd(&bar[XB_TMO], 1u); break; } }
    }
    nloc = mine > 0u ? mine : 1u; nx = cnt > 0u ? cnt : 1u;
}
__device__ __forceinline__ void xcd_barrier(const XcdBarrier& b) {
    asm volatile("s_waitcnt vmcnt(0)" ::: "memory");
    __syncthreads();
    if (threadIdx.x == 0) {
        unsigned* bar = b.bar;
        __builtin_amdgcn_s_waitcnt(0);
        unsigned nloc = b.st[0], nx = b.st[1];
        if (nloc == 0u) { xcd_barrier_complete(bar, b.x, nloc, nx); b.st[0] = nloc; b.st[1] = nx; }
        const unsigned old = xb_add(&bar[XB_XSUB(b.x)], 1u);
        const unsigned gen = old / nloc;
        if (old + 1u == (gen + 1u) * nloc) {
            __builtin_amdgcn_fence(__ATOMIC_RELEASE, "agent");
            asm volatile("s_waitcnt vmcnt(0)" ::: "memory");
            const unsigned og = xb_add(&bar[XB_TOP], 1u);
            const unsigned tg = og / nx;
            if (og + 1u == (tg + 1u) * nx) xb_add(&bar[XB_TOPGEN], 1u);
            else XB_SPIN(xb_ld(&bar[XB_TOPGEN]) == tg, bar);
            __builtin_amdgcn_fence(__ATOMIC_ACQUIRE, "agent");
            xb_add(&bar[XB_XGEN(b.x)], 1u);
            asm volatile("s_waitcnt vmcnt(0)" ::: "memory");
        } else {
            XB_SPIN(xb_ld(&bar[XB_XGEN(b.x)]) == gen, bar);
            __builtin_amdgcn_fence(__ATOMIC_ACQUIRE, "agent");
            asm volatile("s_waitcnt vmcnt(0)" ::: "memory");
        }
    }
    __syncthreads();
}

struct Frame {
    LAS unsigned char* lds;
    volatile LAS unsigned* MISC;
    gu32* ctl;
    int wave;
    int vcu, G;
    const float* in[22];
    float* out;
    unsigned char* ws;
};
#define IN_X 0
#define IN_GMIX 1
#define IN_WIN 2
#define IN_CONVW 3
#define IN_CONVB 4
#define IN_WRG 5
#define IN_BRG 6
#define IN_WIG 7
#define IN_BIG 8
#define IN_LAMBDA 9
#define IN_BF 10
#define IN_WLRU 11
#define IN_WFOX 12
#define IN_WO 13
#define IN_GFFN 14
#define IN_WROUTER 15
#define IN_BROUTER 16
#define IN_WGU 17
#define IN_BGU 18
#define IN_WD 19
#define IN_BD 20
#define IN_GFINAL 21

__device__ __forceinline__ float wave_sum(float v) {
#pragma unroll
    for (int o = 1; o < 64; o <<= 1) v += __shfl_xor(v, o);
    return v;
}
__device__ __forceinline__ float wave_max(float v) {
#pragma unroll
    for (int o = 1; o < 64; o <<= 1) v = fmaxf(v, __shfl_xor(v, o));
    return v;
}
__device__ __forceinline__ float lane_sel(float a, float b, unsigned long long m) { float r; asm("v_cndmask_b32_e64 %0, %1, %2, %3" : "=v"(r) : "v"(a), "v"(b), "s"(m)); return r; }
template <int N> __device__ __forceinline__ void xreduce(float (&f)[N], int lane) {
    (void)lane;
    constexpr unsigned long long MASKS[6] = {0xFFFFFFFF00000000ull, 0xFFFF0000FFFF0000ull, 0xFF00FF00FF00FF00ull, 0xF0F0F0F0F0F0F0F0ull, 0xCCCCCCCCCCCCCCCCull, 0xAAAAAAAAAAAAAAAAull};
    int s = 32, k = 0;
#pragma unroll
    for (int half = N / 2; half >= 1; half >>= 1, s >>= 1, ++k) {
        const unsigned long long m = MASKS[k];
#pragma unroll
        for (int i = 0; i < half; ++i) { const float keep = lane_sel(f[i], f[i + half], m), send = lane_sel(f[i + half], f[i], m); f[i] = keep + __shfl_xor(send, s); }
    }
#pragma unroll
    for (int q = 0; q < 6; ++q) if ((32 >> q) <= s && (32 >> q) >= 1 && (32 >> q) < (64 / N) ) f[0] += __shfl_xor(f[0], 32 >> q);
}
#ifndef CV_LG
#define CV_LG 4
#endif
constexpr int CV_NL = 1 << CV_LG, CV_IK = 8 * (64 >> CV_LG), CV_IN = 4 << CV_LG, CV_KB = 1024 / CV_IK;
struct CvtItem { const float* src; unsigned char* dst; int ldw, K, k0, i8; };
__device__ __forceinline__ void cvt_load(const CvtItem& c, int lane, f32x4 (&v)[8]) {
#pragma unroll
    for (int i = 0; i < 8; ++i) v[i] = __builtin_nontemporal_load((const GAS f32x4*)(c.src + (size_t)(c.k0 + 8 * (lane >> CV_LG) + i) * c.ldw + 4 * (lane & (CV_NL - 1))));
}
__device__ __forceinline__ unsigned q8_low(float x, float scale) {
    const float lim = 127.0f / scale; const float c = __builtin_amdgcn_fmed3f(x, -lim, lim); return __float_as_uint(__builtin_fmaf(c, scale, 12582912.0f)); }
__device__ __forceinline__ unsigned lo4(unsigned a, unsigned b, unsigned c, unsigned d) {
    const unsigned ab = __builtin_amdgcn_perm(b, a, 0x0c0c0400u), cd = __builtin_amdgcn_perm(d, c, 0x0c0c0400u); return ab | (cd << 16); }
__device__ __forceinline__ void cvt_store(const CvtItem& c, int lane, const f32x4 (&v)[8]) {
    const int kg = lane >> CV_LG, ng = lane & (CV_NL - 1);
    if (c.i8) {
#pragma unroll
        for (int j = 0; j < 4; ++j) { unsigned q[8];
#pragma unroll
            for (int i = 0; i < 8; ++i) q[i] = q8_low(v[i][j], W8_SCALE);
            v2u o; o.x = lo4(q[0], q[1], q[2], q[3]); o.y = lo4(q[4], q[5], q[6], q[7]);
            *(GAS v2u*)(c.dst + (size_t)(4 * ng + j) * c.K + c.k0 + 8 * kg) = o; }
    } else {
#pragma unroll
        for (int j = 0; j < 4; ++j) { v4u o; o.x = pk2(v[0][j], v[1][j]); o.y = pk2(v[2][j], v[3][j]); o.z = pk2(v[4][j], v[5][j]); o.w = pk2(v[6][j], v[7][j]);
            *(GAS v4u*)(c.dst + ((size_t)(4 * ng + j) * c.K + c.k0 + 8 * kg) * 2) = o; }
    }
}
#define LANE_TID() const int lane_ = hw_lane(); const int tid_ = F.wave * 64 + lane_
__device__ __forceinline__ void p0_prologue(Frame& F) {
    LANE_TID();
    unsigned char* ws = F.ws;
    const int gw = F.vcu * NWAVES + F.wave, NGW = F.G * NWAVES;
    {
        constexpr int I_IN = (NPROJ / CV_IN) * CV_KB;
        CvtItem c0, c1; f32x4 v0[8], v1[8];
#define P0_DEC(c, it) do { const int cb = (it) / CV_KB, kb = (it) % CV_KB, drow = CV_IN * cb, scol = drow < FCOL0 ? drow : drow + 16; \
            c.src = F.in[IN_WIN] + scol; c.ldw = IN_COLS; c.K = D; c.k0 = CV_IK * kb; c.i8 = 1; c.dst = ws + WS_WIN + (size_t)drow * D; } while (0)
        int it = gw;
        if (it < I_IN) { P0_DEC(c0, it); cvt_load(c0, lane_, v0); }
        if (it + NGW < I_IN) { P0_DEC(c1, it + NGW); cvt_load(c1, lane_, v1); }
#pragma unroll 1
        for (; it < I_IN; it += 2 * NGW) {
            cvt_store(c0, lane_, v0); if (it + 2 * NGW < I_IN) { P0_DEC(c0, it + 2 * NGW); cvt_load(c0, lane_, v0); }
            if (it + NGW < I_IN) { cvt_store(c1, lane_, v1); if (it + 3 * NGW < I_IN) { P0_DEC(c1, it + 3 * NGW); cvt_load(c1, lane_, v1); } }
        }
#undef P0_DEC
    }
    {
        const int gt = F.vcu * (NWAVES * 64) + tid_, NGT = F.G * NWAVES * 64;
        bf16* WG = (bf16*)(ws + WS_WG); const float* const w_ig_p = F.in[IN_WIG]; const float* const w_rg_p = F.in[IN_WRG];
        for (int idx = gt; idx < 2 * 16 * 64 * 64; idx += NGT) { const int i = idx & 63, j = (idx >> 6) & 63, gate = (idx >> 12) & 1, blk = idx >> 13;
            const float w = (gate ? w_ig_p : w_rg_p)[(blk * 64 + i) * 64 + j];
            WG[idx] = (bf16)(pk2(w, 0.f) & 0xffffu); }
        float* SP = (float*)(ws + WS_SP);
        for (int c = gt; c < D; c += NGT) { const float z = -F.in[IN_LAMBDA][c]; const float sp = fmaxf(z, 0.f) + log1pf(expf(-fabsf(z))); SP[c] = 8.0f * sp * LOG2E; }
    }
    __syncthreads();
    {
        constexpr int P0_WFB = 0, P0_AT = 65536;
        LAS unsigned char* L = F.lds + RING_OFF;
        LAS float* rstd_t = (LAS float*)(F.lds + EXTRA_OFF);
        {
            for (int it = tid_; it < 64 * 64; it += NWAVES * 64) if ((it & 31) >= 16) *(LAS v4u*)(L + P0_WFB + it * 16) = (v4u){0u, 0u, 0u, 0u};
            f32x4 wv[8]; float gv[8];
#pragma unroll
            for (int q = 0; q < 8; ++q) { const int i4 = tid_ + 512 * q, c = i4 >> 2; wv[q] = *(const GAS f32x4*)(F.in[IN_WIN] + (size_t)c * IN_COLS + FCOL0 + 4 * (i4 & 3)); gv[q] = F.in[IN_GMIX][c]; }
#pragma unroll
            for (int q = 0; q < 8; ++q) { const int i4 = tid_ + 512 * q, k = i4 >> 2, e0 = (i4 & 3) * 4, s = k >> 4, kh = (k >> 3) & 1, i = k & 7;
                LAS unsigned short* d = (LAS unsigned short*)(L + P0_WFB + (s * 64 + kh * 32 + e0) * 16 + i * 2);
                d[0] = (unsigned short)(pk2(wv[q].x * gv[q], 0.f) & 0xffffu); d[8] = (unsigned short)(pk2(wv[q].y * gv[q], 0.f) & 0xffffu);
                d[16] = (unsigned short)(pk2(wv[q].z * gv[q], 0.f) & 0xffffu); d[24] = (unsigned short)(pk2(wv[q].w * gv[q], 0.f) & 0xffffu); }
        }
        f32x4 gm[4];
#pragma unroll
        for (int j = 0; j < 4; ++j) gm[j] = *((const GAS f32x4*)F.in[IN_GMIX] + lane_ + 64 * j);
        unsigned char* H = (unsigned char*)(ws + WS_H); float* LOGF = (float*)(ws + WS_LOGF);
        typedef float f32x16 __attribute__((ext_vector_type(16)));
        for (int chunk = F.vcu; chunk < M / 64; chunk += F.G) {
            f32x4 v[4][4];
#pragma unroll
            for (int i = 0; i < 4; ++i)
#pragma unroll
                for (int j = 0; j < 4; ++j) v[i][j] = *((const GAS f32x4*)(F.in[IN_X] + (size_t)(chunk * 64 + 4 * F.wave + i) * D) + lane_ + 64 * j);
#pragma unroll 1
            for (int half = 0; half < 2; ++half) {
                __syncthreads();
#pragma unroll
                for (int i = 0; i < 4; ++i) { const int r = 4 * F.wave + i, m = chunk * 64 + half * 32 + r; float s = 0.f;
#pragma unroll
                    for (int j = 0; j < 4; ++j) s += (v[i][j].x * v[i][j].x + v[i][j].y * v[i][j].y) + (v[i][j].z * v[i][j].z + v[i][j].w * v[i][j].w);
                    const float rstd = 1.0f / sqrtf(wave_sum(s) * (1.f / D) + RMS_EPS);
                    if (lane_ == 0) rstd_t[half * 32 + r] = rstd;
                    GAS unsigned* o8 = (GAS unsigned*)(H + (size_t)m * D) + lane_;
#pragma unroll
                    for (int j = 0; j < 4; ++j) { const f32x4 y = v[i][j] * (rstd * H8_SCALE) * gm[j]; o8[64 * j] = pg8::pk4_i8(y.x, y.y, y.z, y.w);
                        const int c = (lane_ >> 1) + 32 * j, pc = (c & ~15) | ((c ^ r) & 15); v2u w; w.x = pk2(v[i][j].x, v[i][j].y); w.y = pk2(v[i][j].z, v[i][j].w);
                        *(LAS v2u*)(L + P0_AT + r * 2048 + pc * 16 + (lane_ & 1) * 8) = w; } }
                if (half == 0) {
#pragma unroll
                    for (int i = 0; i < 4; ++i)
#pragma unroll
                        for (int j = 0; j < 4; ++j) v[i][j] = *((const GAS f32x4*)(F.in[IN_X] + (size_t)(chunk * 64 + 32 + 4 * F.wave + i) * D) + lane_ + 64 * j); }
                __syncthreads();
                f32x16 acc = {};
                { const int r = lane_ & 31, kh = lane_ >> 5;
#pragma unroll
                  for (int q = 0; q < 8; ++q) { const int s = 8 * F.wave + q, c = 2 * s + kh, pc = (c & ~15) | ((c ^ r) & 15);
                      const bf16x8 a = *(const LAS bf16x8*)(L + P0_AT + r * 2048 + pc * 16), b = *(const LAS bf16x8*)(L + P0_WFB + (s * 64 + lane_) * 16);
                      acc = __builtin_amdgcn_mfma_f32_32x32x16_bf16(a, b, acc, 0, 0, 0); } }
                __syncthreads();
                { LAS float* P = (LAS float*)(L + P0_AT) + F.wave * 1024;
#pragma unroll
                  for (int rg = 0; rg < 16; ++rg) P[((rg & 3) + 8 * (rg >> 2) + 4 * (lane_ >> 5)) * 32 + (lane_ & 31)] = acc[rg]; }
                __syncthreads();
                { const LAS float* P = (const LAS float*)(L + P0_AT); const int i = tid_ >> 4, hd = tid_ & 15, idx = i * 32 + hd; float s = 0.f;
#pragma unroll
                  for (int w = 0; w < 8; ++w) s += P[w * 1024 + idx];
                  const float z = s * rstd_t[half * 32 + i] + F.in[IN_BF][hd];
                  const float lf = fminf(z, 0.f) - log1pf(expf(-fabsf(z)));
                  const int m = chunk * 64 + half * 32 + i, b = m / SEQ, t = m % SEQ; LOGF[((size_t)(b * 16 + hd)) * SEQ + t] = lf; }
            }
            __syncthreads();
        }
    }
}

__device__ __forceinline__ void lru_decode(int u, int& b, int& blk, int& seg) { seg = u >> 6; b = (u >> 4) & 3; blk = u & 15; }
struct LruConst { f32x4 brg[4], big[4], spv[4]; float cw[4][8], cb[8]; };
constexpr int LRU_XR = 0, LRU_XC = 16896, LRU_AA = 35328, LRU_BB = 70144, LRU_SM = 104960, LRU_WG = 109056;
__device__ __forceinline__ void lru_load_const(Frame& F, int blk, int tid, int lane, LruConst& C) {
    const int fr = lane & 15, fq = lane >> 4, c0 = blk * 64, ch = tid & 7;
    const bf16* WG = (const bf16*)(F.ws + WS_WG) + (size_t)blk * 2 * 64 * 64; const float* SP = (const float*)(F.ws + WS_SP);
#pragma unroll
    for (int k = 0; k < 2; ++k) { const int it = tid + 512 * k, l = it & 63, fg = it >> 6, kt = fg & 1, nt = (fg >> 1) & 3, gt = fg >> 3;
        *(LAS bf16x8*)(F.lds + RING_OFF + LRU_WG + it * 16) = *(const GAS bf16x8*)(WG + ((gt * 64 + 16 * nt + (l & 15)) * 64 + 32 * kt + 8 * (l >> 4))); }
    (void)fr; (void)fq;
#pragma unroll
    for (int nt = 0; nt < 4; ++nt) { const int j0 = 16 * nt + 4 * fq;
        C.brg[nt] = *(const GAS f32x4*)(F.in[IN_BRG] + c0 + j0); C.big[nt] = *(const GAS f32x4*)(F.in[IN_BIG] + c0 + j0); C.spv[nt] = *(const GAS f32x4*)(SP + c0 + j0); }
#pragma unroll
    for (int k = 0; k < 4; ++k) { const f32x4 a = *(const GAS f32x4*)(F.in[IN_CONVW] + k * D + c0 + ch * 8), bq = *(const GAS f32x4*)(F.in[IN_CONVW] + k * D + c0 + ch * 8 + 4);
        C.cw[k][0] = a.x; C.cw[k][1] = a.y; C.cw[k][2] = a.z; C.cw[k][3] = a.w; C.cw[k][4] = bq.x; C.cw[k][5] = bq.y; C.cw[k][6] = bq.z; C.cw[k][7] = bq.w; }
    { const f32x4 a = *(const GAS f32x4*)(F.in[IN_CONVB] + c0 + ch * 8), bq = *(const GAS f32x4*)(F.in[IN_CONVB] + c0 + ch * 8 + 4);
        C.cb[0] = a.x; C.cb[1] = a.y; C.cb[2] = a.z; C.cb[3] = a.w; C.cb[4] = bq.x; C.cb[5] = bq.y; C.cb[6] = bq.z; C.cb[7] = bq.w; }
}
__device__ __forceinline__ void lru_raw_load(Frame& F, int b, int blk, int seg, int tid, v4u (&raw)[3]) {
    const bf16* LX = (const bf16*)(F.ws + WS_PROJ); const long row0 = (long)b * SEQ + seg * LRU_TS; const int c0 = blk * 64;
#pragma unroll
    for (int k = 0; k < 3; ++k) { const int idx = tid + 512 * k, r = idx >> 3, ch = idx & 7; raw[k] = (v4u){0u, 0u, 0u, 0u};
        if (idx < 131 * 8 && (seg > 0 || r >= 3)) raw[k] = *(const GAS v4u*)(LX + (row0 + r - 3) * D + c0 + ch * 8); }
}
__device__ __forceinline__ void lru_raw_store(Frame& F, int tid, const v4u (&raw)[3]) {
    LAS unsigned char* L = F.lds + RING_OFF;
#pragma unroll
    for (int k = 0; k < 3; ++k) { const int idx = tid + 512 * k, r = idx >> 3, ch = idx & 7; if (idx < 131 * 8) *(LAS v4u*)(L + LRU_XR + r * 128 + ch * 16) = raw[k]; }
}
template <int PASS>
__device__ __forceinline__ void lru_run(Frame& F) {
    LAS unsigned char* L = F.lds + RING_OFF;
    const int lane = hw_lane(), w = F.wave, tid = w * 64 + lane, fr = lane & 15, fq = lane >> 4;
    const bf16* LG = (const bf16*)(F.ws + WS_PROJ + PROJ_STRIDE);
    LAS float* HIN = (LAS float*)(F.lds + EXTRA_OFF);
    int nun = 0; for (int u = F.vcu; u < LRU_UNITS; u += F.G) ++nun;
    if (nun == 0) return;
    if (nun > 56) nun = 56;
    if (PASS == 1) {
        const f32x2* SEGp = (const f32x2*)(F.ws + WS_SEG);
        for (int i = tid >> 6; i < nun; i += NWAVES) { const int u = i * F.G + F.vcu, c = tid & 63; int b, blk, seg; lru_decode(u, b, blk, seg); float Hc = 0.f;
            const GAS f32x2* sp = (const GAS f32x2*)SEGp + (size_t)(b * LRU_NSEG) * D + blk * 64 + c;
            for (int s0 = 0; s0 < seg; s0 += 8) { f32x2 v[8];
#pragma unroll
                for (int k = 0; k < 8; ++k) { const int s = s0 + k; v[k] = sp[(size_t)(s < seg ? s : 0) * D]; if (s >= seg) v[k] = (f32x2){1.f, 0.f}; }
#pragma unroll
                for (int k = 0; k < 8; ++k) Hc = v[k].x * Hc + v[k].y; }
            HIN[i * 64 + c] = Hc; }
    }
    LruConst C; int cur_blk = -1;
    { int b, blk, seg; lru_decode(F.vcu, b, blk, seg); v4u raw[3]; lru_raw_load(F, b, blk, seg, tid, raw); lru_raw_store(F, tid, raw); }
#pragma unroll 1
    for (int i = 0; i < nun; ++i) {
        const int u = i * F.G + F.vcu; int b, blk, seg; lru_decode(u, b, blk, seg);
        const long row0 = (long)b * SEQ + seg * LRU_TS; const int c0 = blk * 64;
        if (blk != cur_blk) { lru_load_const(F, blk, tid, lane, C); cur_blk = blk; }
        v4u nraw[3];
        if (i + 1 < nun) { int b2, blk2, seg2; lru_decode(u + F.G, b2, blk2, seg2); lru_raw_load(F, b2, blk2, seg2, tid, nraw); }
        v4u gate8[2];
        if (PASS == 1) {
#pragma unroll
            for (int k = 0; k < 2; ++k) { const int t = (tid >> 3) + 64 * k, ch = tid & 7; gate8[k] = *(const GAS v4u*)(LG + (row0 + t) * D + c0 + ch * 8); }
        }
        __syncthreads();
        { const int ch = tid & 7;
#pragma unroll
            for (int k2 = 0; k2 < 2; ++k2) { const int t = (tid >> 3) + 64 * k2; float a[8];
#pragma unroll
                for (int e = 0; e < 8; ++e) a[e] = C.cb[e];
#pragma unroll
                for (int k = 0; k < 4; ++k) { const v4u xv = *(const LAS v4u*)(L + LRU_XR + (t + k) * 128 + ch * 16);
                    a[0] += C.cw[k][0] * bflo(xv.x); a[1] += C.cw[k][1] * bfhi(xv.x); a[2] += C.cw[k][2] * bflo(xv.y); a[3] += C.cw[k][3] * bfhi(xv.y);
                    a[4] += C.cw[k][4] * bflo(xv.z); a[5] += C.cw[k][5] * bfhi(xv.z); a[6] += C.cw[k][6] * bflo(xv.w); a[7] += C.cw[k][7] * bfhi(xv.w); }
                v4u o; o.x = pk2(a[0], a[1]); o.y = pk2(a[2], a[3]); o.z = pk2(a[4], a[5]); o.w = pk2(a[6], a[7]);
                *(LAS v4u*)(L + LRU_XC + t * 144 + ch * 16) = o; }
        }
        __syncthreads();
        { bf16x8 af[2];
#pragma unroll
            for (int kt = 0; kt < 2; ++kt) af[kt] = *(const LAS bf16x8*)(L + LRU_XC + (16 * w + fr) * 144 + (32 * kt + 8 * fq) * 2);
#pragma unroll
            for (int nt = 0; nt < 4; ++nt) { f32x4 gr = (f32x4){0.f, 0.f, 0.f, 0.f}, gi = (f32x4){0.f, 0.f, 0.f, 0.f};
#pragma unroll
                for (int kt = 0; kt < 2; ++kt) { const bf16x8 wr_ = *(const LAS bf16x8*)(L + LRU_WG + ((nt * 2 + kt) * 64 + lane) * 16), wi_ = *(const LAS bf16x8*)(L + LRU_WG + (((4 + nt) * 2 + kt) * 64 + lane) * 16);
                    gr = __builtin_amdgcn_mfma_f32_16x16x32_bf16(wr_, af[kt], gr, 0, 0, 0); gi = __builtin_amdgcn_mfma_f32_16x16x32_bf16(wi_, af[kt], gi, 0, 0, 0); }
                const int j0 = 16 * nt + 4 * fq;
                const v2u xw = *(const LAS v2u*)(L + LRU_XC + (16 * w + fr) * 144 + j0 * 2);
                const float xs[4] = {bflo(xw.x), bfhi(xw.x), bflo(xw.y), bfhi(xw.y)};
                f32x4 av, bv;
#pragma unroll
                for (int e = 0; e < 4; ++e) { const float rt = sigm(gr[e] + C.brg[nt][e]), it = sigm(gi[e] + C.big[nt][e]);
                    const float a = __builtin_amdgcn_exp2f(-rt * C.spv[nt][e]); const float mult = __builtin_amdgcn_sqrtf(fmaxf(1.0f - a * a, 0.f));
                    av[e] = a; bv[e] = mult * it * xs[e]; }
                *(LAS f32x4*)(L + LRU_AA + ((16 * w + fr) * 68 + j0) * 4) = av; *(LAS f32x4*)(L + LRU_BB + ((16 * w + fr) * 68 + j0) * 4) = bv; }
        }
        __syncthreads();
        const LAS float* Af = (const LAS float*)(L + LRU_AA); LAS float* Bf = (LAS float*)(L + LRU_BB);
        { float Aw = 1.f, Bw = 0.f;
#pragma unroll
            for (int s = 0; s < 16; ++s) { const int t = 16 * w + s; const float a = Af[t * 68 + lane], bb = Bf[t * 68 + lane]; Bw = a * Bw + bb; Aw *= a; }
            *(LAS f32x2*)(L + LRU_SM + (w * 64 + lane) * 8) = (f32x2){Aw, Bw}; }
        __syncthreads();
        if (PASS == 0) {
            if (w == 0) { float A = 1.f, Bq = 0.f;
#pragma unroll
                for (int ww = 0; ww < 8; ++ww) { const f32x2 v = *(const LAS f32x2*)(L + LRU_SM + (ww * 64 + lane) * 8); Bq = v.x * Bq + v.y; A *= v.x; }
                *(GAS f32x2*)((float*)(F.ws + WS_SEG) + ((size_t)(b * LRU_NSEG + seg) * D + c0 + lane) * 2) = (f32x2){A, Bq}; }
        } else {
            float Hc = HIN[i * 64 + lane];
#pragma unroll
            for (int ww = 0; ww < 7; ++ww) if (ww < w) { const f32x2 v = *(const LAS f32x2*)(L + LRU_SM + (ww * 64 + lane) * 8); Hc = v.x * Hc + v.y; }
#pragma unroll
            for (int s = 0; s < 16; ++s) { const int t = 16 * w + s; const float a = Af[t * 68 + lane], bb = Bf[t * 68 + lane]; Hc = a * Hc + bb; Bf[t * 68 + lane] = Hc; }
            __syncthreads();
            bf16* YL = (bf16*)(F.ws + WS_YLRU);
#pragma unroll
            for (int k = 0; k < 2; ++k) { const int t = (tid >> 3) + 64 * k, ch = tid & 7;
                const f32x4 h0 = *(const LAS f32x4*)(L + LRU_BB + (t * 68 + ch * 8) * 4), h1 = *(const LAS f32x4*)(L + LRU_BB + (t * 68 + ch * 8 + 4) * 4); const v4u g = gate8[k];
                v4u o; o.x = pk2(h0.x * gelu_tanh(bflo(g.x)), h0.y * gelu_tanh(bfhi(g.x))); o.y = pk2(h0.z * gelu_tanh(bflo(g.y)), h0.w * gelu_tanh(bfhi(g.y)));
                o.z = pk2(h1.x * gelu_tanh(bflo(g.z)), h1.y * gelu_tanh(bfhi(g.z))); o.w = pk2(h1.z * gelu_tanh(bflo(g.w)), h1.w * gelu_tanh(bfhi(g.w)));
                *(GAS v4u*)(YL + (row0 + t) * D + c0 + ch * 8) = o; }
        }
        if (i + 1 < nun) lru_raw_store(F, tid, nraw);
    }
    __syncthreads();
}

__device__ __forceinline__ void p2_phase(Frame& F) {
    LANE_TID();
    const int gw = F.vcu * NWAVES + F.wave, NGW = F.G * NWAVES;
    for (int bh = gw; bh < BATCH * 16; bh += NGW) {
        const float* src = (const float*)(F.ws + WS_LOGF) + (size_t)bh * SEQ + 64 * lane_; float* dst = (float*)(F.ws + WS_KB) + (size_t)bh * SEQ + 64 * lane_;
        f32x4 v[16]; float tot = 0.f;
#pragma unroll
        for (int i = 0; i < 16; ++i) { v[i] = *((const GAS f32x4*)src + i); tot += (v[i].x + v[i].y) + (v[i].z + v[i].w); }
        float incl = tot;
#pragma unroll
        for (int o = 1; o < 64; o <<= 1) { const float t = __shfl_up(incl, o); if (lane_ >= o) incl += t; }
        float run = incl - tot;
#pragma unroll
        for (int i = 0; i < 16; ++i) { f32x4 o; run += v[i].x; o.x = -LOG2E * run; run += v[i].y; o.y = -LOG2E * run; run += v[i].z; o.z = -LOG2E * run; run += v[i].w; o.w = -LOG2E * run;
            *((GAS f32x4*)dst + i) = o; }
    }
    {
        LAS unsigned* nrm = (LAS unsigned*)(F.lds + EXTRA_OFF);
        const bf16* Qp = (const bf16*)(F.ws + WS_PROJ + 2 * PROJ_STRIDE); const bf16* Kp = (const bf16*)(F.ws + WS_PROJ + 3 * PROJ_STRIDE);
        for (int chunk = F.vcu; chunk < M / 64; chunk += F.G) {
            if (tid_ < 32) nrm[tid_] = 0u;
            __syncthreads();
            float qm[2] = {0.f, 0.f}, km[2] = {0.f, 0.f};
#pragma unroll
            for (int r0 = 0; r0 < 8; r0 += 4) { v4u qv[4][2], kv[4][2];
#pragma unroll
                for (int r = 0; r < 4; ++r)
#pragma unroll
                    for (int hf = 0; hf < 2; ++hf) { const size_t off = (size_t)(chunk * 64 + F.wave * 8 + r0 + r) * D + hf * 512 + lane_ * 8; qv[r][hf] = *(const GAS v4u*)(Qp + off); kv[r][hf] = *(const GAS v4u*)(Kp + off); }
#pragma unroll
                for (int r = 0; r < 4; ++r)
#pragma unroll
                    for (int hf = 0; hf < 2; ++hf) { float sq = 0.f, sk = 0.f;
#pragma unroll
                        for (int e = 0; e < 4; ++e) { const float a = bflo(qv[r][hf][e]), b2 = bfhi(qv[r][hf][e]), c = bflo(kv[r][hf][e]), d = bfhi(kv[r][hf][e]); sq += a * a + b2 * b2; sk += c * c + d * d; }
                        sq += __shfl_xor(sq, 1); sq += __shfl_xor(sq, 2); sq += __shfl_xor(sq, 4); sk += __shfl_xor(sk, 1); sk += __shfl_xor(sk, 2); sk += __shfl_xor(sk, 4);
                        qm[hf] = fmaxf(qm[hf], sq); km[hf] = fmaxf(km[hf], sk); } }
            if ((lane_ & 7) == 0) {
#pragma unroll
                for (int hf = 0; hf < 2; ++hf) { const int h = hf * 8 + (lane_ >> 3);
                    __hip_atomic_fetch_max(nrm + h, __float_as_uint(qm[hf]), __ATOMIC_RELAXED, __HIP_MEMORY_SCOPE_WORKGROUP); __hip_atomic_fetch_max(nrm + 16 + h, __float_as_uint(km[hf]), __ATOMIC_RELAXED, __HIP_MEMORY_SCOPE_WORKGROUP); } }
            __syncthreads();
            if (tid_ < 32) { const int b = chunk / (SEQ / 64), qb = (chunk % (SEQ / 64)) / 4, h = tid_ & 15; const unsigned v = nrm[tid_];
                if (tid_ < 16) __hip_atomic_fetch_max(F.ctl + CW_QN + (b * 16 + h) * 16 + qb, v, RLX_AGENT); else __hip_atomic_fetch_max(F.ctl + CW_KN + b * 16 + h, v, RLX_AGENT); }
            __syncthreads();
        }
    }
    lru_run<0>(F);
}
__device__ __forceinline__ void p3_lru(Frame& F) { lru_run<1>(F); }

constexpr int P6_WRB = 0, P6_AT = 65536, P6_LOG = 65536 + 32768;
__device__ __forceinline__ void p6_route(Frame& F) {
    LANE_TID();
    LAS unsigned char* L = F.lds + RING_OFF;
    LAS unsigned* lcnt = (LAS unsigned*)(F.lds + EXTRA_OFF);
    LAS unsigned* gbase = lcnt + 32;
    LAS unsigned* stash = lcnt + 64;
    LAS float* rstd_t = (LAS float*)(lcnt + 64 + 768);
    LAS f32x2* sel = (LAS f32x2*)(lcnt + 64 + 768 + 64);
    {
        f32x4 wv[16]; float gv[16];
#pragma unroll
        for (int q = 0; q < 16; ++q) { const int i4 = tid_ + 512 * q; wv[q] = *((const GAS f32x4*)F.in[IN_WROUTER] + i4); gv[q] = F.in[IN_GFFN][i4 >> 3]; }
#pragma unroll
        for (int q = 0; q < 16; ++q) { const int i4 = tid_ + 512 * q, k = i4 >> 3, e0 = (i4 & 7) * 4, s = k >> 4, kh = (k >> 3) & 1, i = k & 7;
            LAS unsigned short* d = (LAS unsigned short*)(L + P6_WRB + (s * 64 + kh * 32 + e0) * 16 + i * 2);
            d[0] = (unsigned short)(pk2(wv[q].x * gv[q], 0.f) & 0xffffu); d[8] = (unsigned short)(pk2(wv[q].y * gv[q], 0.f) & 0xffffu);
            d[16] = (unsigned short)(pk2(wv[q].z * gv[q], 0.f) & 0xffffu); d[24] = (unsigned short)(pk2(wv[q].w * gv[q], 0.f) & 0xffffu); }
    }
    f32x4 gm[4];
#pragma unroll
    for (int j = 0; j < 4; ++j) gm[j] = *((const GAS f32x4*)F.in[IN_GFFN] + lane_ + 64 * j);
    const float* X1 = F.in[IN_X]; const bf16* DX = (const bf16*)(F.ws + WS_X1); unsigned char* H2 = (unsigned char*)(F.ws + WS_H2);
    unsigned* TOKMAP = (unsigned*)(F.ws + WS_TOKMAP); v4u* ROUTE = (v4u*)(F.ws + WS_ROUTE);
    typedef float f32x16 __attribute__((ext_vector_type(16)));
    for (int chunk = F.vcu; chunk < M / 64; chunk += F.G) {
        if (tid_ < 32) lcnt[tid_] = 0u;
        f32x4 v[4][4];
#pragma unroll
        for (int i = 0; i < 4; ++i)
#pragma unroll
            for (int j = 0; j < 4; ++j) { const size_t ro = (size_t)(chunk * 64 + 4 * F.wave + i) * D; const v2u dw = *((const GAS v2u*)(DX + ro) + lane_ + 64 * j);
                v[i][j] = *((const GAS f32x4*)(X1 + ro) + lane_ + 64 * j) + (f32x4){bflo(dw.x), bfhi(dw.x), bflo(dw.y), bfhi(dw.y)}; }
#pragma unroll 1
        for (int half = 0; half < 2; ++half) {
            {
#pragma unroll
              for (int i = 0; i < 4; ++i) { const int r = 4 * F.wave + i, m = chunk * 64 + half * 32 + r; float s = 0.f;
#pragma unroll
                  for (int j = 0; j < 4; ++j) s += (v[i][j].x * v[i][j].x + v[i][j].y * v[i][j].y) + (v[i][j].z * v[i][j].z + v[i][j].w * v[i][j].w);
                  const float rstd = 1.0f / sqrtf(wave_sum(s) * (1.f / D) + RMS_EPS);
                  if (lane_ == 0) rstd_t[half * 32 + r] = rstd;
                  GAS unsigned* o8 = (GAS unsigned*)(H2 + (size_t)m * D) + lane_; GAS v2u* xb = (GAS v2u*)((bf16*)(F.ws + WS_X1B) + (size_t)m * D) + lane_;
#pragma unroll
                  for (int j = 0; j < 4; ++j) { const f32x4 y = v[i][j] * (rstd * H8_SCALE) * gm[j]; o8[64 * j] = pg8::pk4_i8(y.x, y.y, y.z, y.w);
                      { v2u xw; xw.x = pk2(v[i][j].x, v[i][j].y); xw.y = pk2(v[i][j].z, v[i][j].w); xb[64 * j] = xw; }
                      const int c = (lane_ >> 1) + 32 * j, pc = (c & ~15) | ((c ^ r) & 15); v2u w; w.x = pk2(v[i][j].x, v[i][j].y); w.y = pk2(v[i][j].z, v[i][j].w);
                      *(LAS v2u*)(L + P6_AT + r * 2048 + pc * 16 + (lane_ & 1) * 8) = w; } }
              if (half == 0) {
#pragma unroll
                  for (int i = 0; i < 4; ++i)
#pragma unroll
                      for (int j = 0; j < 4; ++j) { const size_t ro = (size_t)(chunk * 64 + 32 + 4 * F.wave + i) * D; const v2u dw = *((const GAS v2u*)(DX + ro) + lane_ + 64 * j);
                          v[i][j] = *((const GAS f32x4*)(X1 + ro) + lane_ + 64 * j) + (f32x4){bflo(dw.x), bfhi(dw.x), bflo(dw.y), bfhi(dw.y)}; } } }
            __syncthreads();
            f32x16 acc = {};
            { const int r = lane_ & 31, kh = lane_ >> 5;
#pragma unroll
              for (int q = 0; q < 8; ++q) { const int s = 8 * F.wave + q, c = 2 * s + kh, pc = (c & ~15) | ((c ^ r) & 15);
                  const bf16x8 a = *(const LAS bf16x8*)(L + P6_AT + r * 2048 + pc * 16), b = *(const LAS bf16x8*)(L + P6_WRB + (s * 64 + lane_) * 16);
                  acc = __builtin_amdgcn_mfma_f32_32x32x16_bf16(a, b, acc, 0, 0, 0); } }
            __syncthreads();
            { LAS float* P = (LAS float*)(L + P6_AT) + F.wave * 1024;
#pragma unroll
              for (int rg = 0; rg < 16; ++rg) P[((rg & 3) + 8 * (rg >> 2) + 4 * (lane_ >> 5)) * 32 + (lane_ & 31)] = acc[rg]; }
            __syncthreads();
            { const LAS float* P = (const LAS float*)(L + P6_AT); LAS float* LG = (LAS float*)(L + P6_LOG);
#pragma unroll
              for (int k = 0; k < 2; ++k) { const int idx = tid_ + 512 * k; float s = 0.f;
#pragma unroll
                  for (int w = 0; w < 8; ++w) s += P[w * 1024 + idx];
                  LG[idx] = s * rstd_t[half * 32 + (idx >> 5)] + F.in[IN_BROUTER][idx & 31]; } }
            __syncthreads();
            { const LAS float* LG = (const LAS float*)(L + P6_LOG);
#pragma unroll
              for (int k = 0; k < 2; ++k) { const int idx = tid_ + 512 * k, i = idx >> 5, j = idx & 31; const float v = LG[idx]; int rank = 0;
#pragma unroll
                  for (int q = 0; q < 8; ++q) { const f32x4 o = *(const LAS f32x4*)(LG + i * 32 + 4 * q);
                      rank += (o.x > v || (o.x == v && 4 * q + 0 < j)) ? 1 : 0; rank += (o.y > v || (o.y == v && 4 * q + 1 < j)) ? 1 : 0;
                      rank += (o.z > v || (o.z == v && 4 * q + 2 < j)) ? 1 : 0; rank += (o.w > v || (o.w == v && 4 * q + 3 < j)) ? 1 : 0; }
                  if (rank < 4) sel[(half * 32 + i) * 4 + rank] = (f32x2){__uint_as_float((unsigned)j), v}; } }
            __syncthreads();
            if (tid_ < 128) { const int rl = half * 32 + (tid_ >> 2), k = tid_ & 3; const f32x2 s0 = sel[rl * 4 + 0], s1 = sel[rl * 4 + 1], s2 = sel[rl * 4 + 2], s3 = sel[rl * 4 + 3];
                const float p1 = __expf(s1.y - s0.y), p2 = __expf(s2.y - s0.y), p3 = __expf(s3.y - s0.y), inv = 1.0f / (1.0f + p1 + p2 + p3);
                const unsigned e = __float_as_uint(k == 0 ? s0.x : k == 1 ? s1.x : k == 2 ? s2.x : s3.x) & 31u; const float wv = (k == 0 ? 1.0f : k == 1 ? p1 : k == 2 ? p2 : p3) * inv;
                const unsigned lp = __hip_atomic_fetch_add(lcnt + e, 1u, __ATOMIC_RELAXED, __HIP_MEMORY_SCOPE_WORKGROUP);
                LAS unsigned* st = stash + (rl * 4 + k) * 3; st[0] = e; st[1] = lp; st[2] = __float_as_uint(wv); }
            __syncthreads();
        }
        const int t2 = F.wave * 64 + hw_lane();
        if (t2 < 32) { const unsigned n = lcnt[t2]; gbase[t2] = n ? __hip_atomic_fetch_add(F.ctl + CW_CNT + 64 * t2, n, RLX_AGENT) : 0u; }
        __syncthreads();
        if (t2 < 256) { const LAS unsigned* st = stash + t2 * 3; const unsigned e = st[0], pos = gbase[e] + st[1]; const int m = chunk * 64 + (t2 >> 2);
            TOKMAP[(size_t)e * M + pos] = (unsigned)m; ROUTE[(size_t)m * 4 + (t2 & 3)] = (v4u){e, pos, st[2], 0u}; }
        __syncthreads();
    }
}
__device__ __forceinline__ int moe_tables(Frame& F) {
    LANE_TID();
    LAS unsigned char* EX = F.lds + EXTRA_OFF;
    LAS unsigned char* tile_e = EX + EX_TILE_E; LAS unsigned* ncnt = (LAS unsigned*)(EX + EX_NCNT); LAS unsigned* tpre = (LAS unsigned*)(EX + EX_TPRE);
    if (tid_ < 32) { unsigned n = __hip_atomic_load(F.ctl + CW_CNT + 64 * tid_, RLX_AGENT); if (n > (unsigned)M) n = (unsigned)M; ncnt[tid_] = n; }
    __syncthreads();
    if (tid_ == 0) { unsigned a = 0; for (int e = 0; e < 32; ++e) { tpre[e] = a; a += (ncnt[e] + 255u) >> 8; if (a > (unsigned)MAXTILES) a = (unsigned)MAXTILES; } tpre[32] = a; }
    __syncthreads();
    const int TT = (int)tpre[32];
    for (int t = tid_; t < TT; t += NWAVES * 64) { int e = 0;
#pragma unroll 1
        for (int k = 1; k < 32; ++k) if ((int)tpre[k] <= t) e = k;
        tile_e[t] = (unsigned char)e; }
    __syncthreads();
    return TT;
}

__device__ __forceinline__ void p9_final(Frame& F) {
    LANE_TID();
    const int gw = F.vcu * NWAVES + F.wave, NGW = F.G * NWAVES;
    unsigned tl = 0; if (lane_ < 32) { unsigned n = __hip_atomic_load(F.ctl + CW_CNT + 64 * lane_, RLX_AGENT); if (n > (unsigned)M) n = (unsigned)M; tl = (n + 255u) >> 8; }
    unsigned incl = tl;
#pragma unroll
    for (int o = 1; o < 32; o <<= 1) { const unsigned t = __shfl_up(incl, o); if (lane_ >= o) incl += t; }
    const unsigned excl = incl - tl;
    f32x4 gm[4];
#pragma unroll
    for (int j = 0; j < 4; ++j) gm[j] = *((const GAS f32x4*)F.in[IN_GFINAL] + lane_ + 64 * j);
    const bf16* DX = (const bf16*)(F.ws + WS_X1B); const signed char* Y = (const signed char*)(F.ws + WS_Y); const v4u* ROUTE = (const v4u*)(F.ws + WS_ROUTE);
#pragma unroll 1
    for (int m = gw; m < M; m += NGW) {
        f32x4 v[4];
#pragma unroll
        for (int j = 0; j < 4; ++j) { const v2u dw = *((const GAS v2u*)(DX + (size_t)m * D) + lane_ + 64 * j); v[j] = (f32x4){bflo(dw.x), bfhi(dw.x), bflo(dw.y), bfhi(dw.y)}; }
#pragma unroll
        for (int k = 0; k < 4; ++k) { const v4u rt = *((const GAS v4u*)ROUTE + (size_t)m * 4 + k); const unsigned e = rt.x & 31u; const float wv = __uint_as_float(rt.z) * (1.0f / Y8_SCALE);
            unsigned slot = (unsigned)__shfl((int)excl, (int)e) * 256u + rt.y; if (slot >= (unsigned)SLOTS) slot = 0u;
            const GAS unsigned* yr = (const GAS unsigned*)(Y + (size_t)slot * D) + lane_;
#pragma unroll
            for (int j = 0; j < 4; ++j) { const unsigned yw = yr[64 * j];
                v[j].x += wv * (float)((int)(yw << 24) >> 24); v[j].y += wv * (float)((int)(yw << 16) >> 24); v[j].z += wv * (float)((int)(yw << 8) >> 24); v[j].w += wv * (float)((int)yw >> 24); } }
        float s = 0.f;
#pragma unroll
        for (int j = 0; j < 4; ++j) s += (v[j].x * v[j].x + v[j].y * v[j].y) + (v[j].z * v[j].z + v[j].w * v[j].w);
        const float rstd = 1.0f / sqrtf(wave_sum(s) * (1.f / D) + RMS_EPS);
        GAS f32x4* o = (GAS f32x4*)(F.out + (size_t)m * D) + lane_;
#pragma unroll
        for (int j = 0; j < 4; ++j) o[64 * j] = v[j] * rstd * gm[j];
    }
}


constexpr int CV_SQ = (D / CV_IN) * CV_KB, CV_GU = NE * (2 * DFF / CV_IN) * CV_KB, CV_D = NE * (D / CV_IN) * CV_KB, CV_N = 3 * CV_SQ + CV_GU + CV_D, CV_P1 = 3 * CV_SQ + CV_GU;
__device__ __forceinline__ void cvt_decode(Frame& F, int it, CvtItem& c) {
    unsigned char* ws = F.ws; int r = it;
    const float* const w_lru_p = F.in[IN_WLRU]; const float* const w_fox_p = F.in[IN_WFOX]; const float* const w_o_p = F.in[IN_WO];
    if (r < 3 * CV_SQ) { const int which = r / CV_SQ, rr = r % CV_SQ, cb = rr / CV_KB, kb = rr % CV_KB;
        c.src = (which == 0 ? w_lru_p : which == 1 ? w_fox_p : w_o_p) + CV_IN * cb; c.ldw = D; c.K = D; c.k0 = CV_IK * kb; c.i8 = 0;
        c.dst = ws + (which == 0 ? WS_WLRU : which == 1 ? WS_WFOX : WS_WO) + (size_t)(CV_IN * cb) * D * 2; return; }
    r -= 3 * CV_SQ;
    if (r < CV_GU) { const int cb = r / CV_KB, kb = r % CV_KB, cpe = 2 * DFF / CV_IN, e = cb / cpe, nn0 = CV_IN * (cb % cpe), pn = nn0 >> 8, bj = (nn0 >> 7) & 1, cp = nn0 & 127, scol = bj * DFF + 128 * pn + cp;
        c.src = F.in[IN_WGU] + (size_t)e * D * 2 * DFF + scol; c.ldw = 2 * DFF; c.K = D; c.k0 = CV_IK * kb; c.i8 = 1; c.dst = ws + WS_WGU + ((size_t)e * 2 * DFF + nn0) * D; return; }
    r -= CV_GU;
    { const int cb = r / CV_KB, kb = r % CV_KB, cpe = D / CV_IN, e = cb / cpe, n0 = CV_IN * (cb % cpe);
        c.src = F.in[IN_WD] + (size_t)e * DFF * D + n0; c.ldw = D; c.K = DFF; c.k0 = CV_IK * kb; c.i8 = 1; c.dst = ws + WS_WD + ((size_t)e * D + n0) * DFF; }
}
__device__ __forceinline__ void cvt_slice(Frame& F, int k_lo, int k_hi, int item_lo = 0, int item_hi = CV_N) {
    const int lane = hw_lane(); const int NGW = F.G * NWAVES, gw0 = item_lo + F.vcu * NWAVES + F.wave, gw = gw0 + k_lo * NGW;
    const int CV_END = (k_hi >= (CV_N + NGW - 1) / NGW) ? item_hi : ((gw0 + k_hi * NGW) < item_hi ? (gw0 + k_hi * NGW) : item_hi);
    CvtItem c0, c1, c2, c3; f32x4 v0[8], v1[8], v2[8], v3[8];
    int it = gw;
#define CV_LOAD(c, v, idx) do { if ((idx) < CV_END) { cvt_decode(F, (idx), c); cvt_load(c, lane, v); } } while (0)
    CV_LOAD(c0, v0, it); CV_LOAD(c1, v1, it + NGW); CV_LOAD(c2, v2, it + 2 * NGW); CV_LOAD(c3, v3, it + 3 * NGW);
#pragma unroll 1
    for (; it < CV_END; it += 4 * NGW) {
        cvt_store(c0, lane, v0); CV_LOAD(c0, v0, it + 4 * NGW);
        if (it + NGW < CV_END) { cvt_store(c1, lane, v1); CV_LOAD(c1, v1, it + 5 * NGW); }
        if (it + 2 * NGW < CV_END) { cvt_store(c2, lane, v2); CV_LOAD(c2, v2, it + 6 * NGW); }
        if (it + 3 * NGW < CV_END) { cvt_store(c3, lane, v3); CV_LOAD(c3, v3, it + 7 * NGW); }
    }
#undef CV_LOAD
}
__device__ __forceinline__ void ph1(Frame& F) {
    unsigned char* ws = F.ws;
    pg8::Gemm g{(const bf16*)(ws + WS_H), (const bf16*)(ws + WS_WIN), M, NPROJ, D}; pg8::StaticOrder S; S.init(M, NPROJ, F.G, (int)blockIdx.x);
    pg8::EpiSplit E{(bf16*)(ws + WS_PROJ), D, D, (size_t)PROJ_STRIDE / 2, 2, attn_body::C2, 1.0f / (W8_SCALE * H8_SCALE)};
    const int rounds = (S.nwg + F.G - 1) / F.G, slot = F.vcu % (rounds + 1);
    const int pre = 2 * ((F.vcu / (rounds + 1)) % 8);
    cvt_slice(F, 0, pre, 0, CV_P1);
    __syncthreads();
    S.i0 = 0; S.i1 = slot;
    pg8::gemm_phase<pg8::EpiSplit, pg8::StaticOrder, true, true>(F.lds + RING_OFF, g, S, E, F.wave);
    cvt_slice(F, pre, 0x7fffffff, 0, CV_P1);
    __syncthreads();
    S.i0 = slot; S.i1 = rounds;
    pg8::gemm_phase<pg8::EpiSplit, pg8::StaticOrder, true, true>(F.lds + RING_OFF, g, S, E, F.wave);
}
__device__ __forceinline__ void ph3(Frame& F, unsigned char* lds_generic) {
    unsigned char* ws = F.ws;
    const attn_body::AttnTensors AT{(const attn_body::bf16*)(ws + WS_PROJ + 2 * PROJ_STRIDE), (const attn_body::bf16*)(ws + WS_PROJ + 3 * PROJ_STRIDE), (const attn_body::bf16*)(ws + WS_PROJ + 4 * PROJ_STRIDE),
                                    (attn_body::bf16*)(ws + WS_YFOX), (const float*)(ws + WS_KB), (const unsigned*)(F.ctl + CW_QN), (const unsigned*)(F.ctl + CW_KN)};
    attn_body::StaticOrder S((int)F.G, (int)blockIdx.x);
    const int pos = F.vcu % 5;
    S.i0 = 0; S.i1 = pos;
    attn_body::attn_phase<attn_body::StaticOrder>((char*)lds_generic + RING_OFF, AT, S, F.wave);
    cvt_slice(F, 0, 0x7fffffff, CV_P1, CV_N);
    S.i0 = pos; S.i1 = 0x7fffffff;
    attn_body::attn_phase<attn_body::StaticOrder>((char*)lds_generic + RING_OFF, AT, S, F.wave);
    __syncthreads();
    p3_lru(F);
}
__device__ __forceinline__ void ph4(Frame& F) {
    unsigned char* ws = F.ws;
    static_assert(WS_WFOX == WS_WLRU + (size_t)D * D * 2, "the two weight copies are contiguous");
    pg8::Gemm g{(const bf16*)ws, (const bf16*)(ws + WS_WLRU), M, D, D}; pg8::PairOrder S; S.init(M, D, F.G, (int)blockIdx.x); S.abase[0] = (unsigned)WS_YLRU; S.abase[1] = (unsigned)WS_YFOX;
    pg8::EpiGatePair E{{(bf16*)(ws + WS_TMP), (const bf16*)(ws + WS_PROJ + 5 * PROJ_STRIDE), nullptr, D}, {(bf16*)(ws + WS_MERGED), (const bf16*)(ws + WS_PROJ + 6 * PROJ_STRIDE), (const bf16*)(ws + WS_TMP), D}, D / 256};
    pg8::gemm_phase<pg8::EpiGatePair, pg8::PairOrder, true>(F.lds + RING_OFF, g, S, E, F.wave);
}
__device__ __forceinline__ void ph5(Frame& F) {
    unsigned char* ws = F.ws;
    pg8::Gemm g{(const bf16*)(ws + WS_MERGED), (const bf16*)(ws + WS_WO), M, D, D}; pg8::StaticOrder S; S.init(M, D, F.G, (int)blockIdx.x);
    pg8::EpiPlainBf16 E{(bf16*)(ws + WS_X1), D};
    pg8::gemm_phase<pg8::EpiPlainBf16, pg8::StaticOrder, true>(F.lds + RING_OFF, g, S, E, F.wave);
}
__device__ __forceinline__ void ph7(Frame& F) {
    unsigned char* ws = F.ws;
    const int TT = moe_tables(F);
    LAS unsigned char* EX = F.lds + EXTRA_OFF; LAS unsigned* rows = (LAS unsigned*)(EX + EX_ROWS);
    const LAS unsigned* ncnt = (const LAS unsigned*)(EX + EX_NCNT); const LAS unsigned* tpre = (const LAS unsigned*)(EX + EX_TPRE);
    pg8::GroupedOrder<true> S; S.init(TT, 8, F.G, (int)blockIdx.x, EX + EX_TILE_E, rows);
    { const unsigned* TOKMAP = (const unsigned*)(ws + WS_TOKMAP); pg8::Unit u;
      const int tid_ = F.wave * 64 + hw_lane();
      for (int i = 0; i < EX_MAXU && S.next(i, u); ++i) if (tid_ < 256) { const int e = u.pn >> 3; const unsigned pos = (unsigned)(u.pm - (int)tpre[e]) * 256u + (unsigned)tid_;
          rows[i * 256 + tid_] = TOKMAP[(size_t)e * M + (pos < ncnt[e] ? pos : 0u)] & (unsigned)(M - 1); } }
    __syncthreads();
    pg8::Gemm g{(const bf16*)(ws + WS_H2), (const bf16*)(ws + WS_WGU), SLOTS, 2 * DFF, D};
    pg8::EpiSwiglu E{(unsigned char*)(ws + WS_ACT), F.in[IN_BGU], 8, 1.0f / (W8_SCALE * H8_SCALE), ACT8_SCALE};
    pg8::gemm_phase<pg8::EpiSwiglu, pg8::GroupedOrder<true>, true, true>(F.lds + RING_OFF, g, S, E, F.wave);
}
__device__ __forceinline__ void ph8(Frame& F) {
    unsigned char* ws = F.ws;
    LAS unsigned char* EX = F.lds + EXTRA_OFF;
    const int TT = (N_LAUNCHES == PER_PHASE) ? moe_tables(F) : (int)((const LAS unsigned*)(EX + EX_TPRE))[32];
    pg8::GroupedOrder<false> S; S.init(TT, 4, F.G, (int)blockIdx.x, EX + EX_TILE_E, nullptr);
    pg8::Gemm g{(const bf16*)(ws + WS_ACT), (const bf16*)(ws + WS_WD), SLOTS, D, DFF};
    pg8::EpiDown E{(unsigned char*)(ws + WS_Y), F.in[IN_BD], 4, 1.0f / (W8_SCALE * ACT8_SCALE), Y8_SCALE};
    pg8::gemm_phase<pg8::EpiDown, pg8::GroupedOrder<false>, true, true>(F.lds + RING_OFF, g, S, E, F.wave);
}
struct Args { const float* in[22]; float* out; unsigned char* ws; int ph_lo, ph_hi, li, pad; };
__global__ void __launch_bounds__(NWAVES * 64, 2) mk_fwd(Args args) {
    extern __shared__ __attribute__((aligned(16))) unsigned char lds[];
    Frame F;
    F.lds = (LAS unsigned char*)lds;
    F.MISC = (volatile LAS unsigned*)(F.lds + MISC_OFF);
    F.wave = __builtin_amdgcn_readfirstlane((int)threadIdx.x >> 6);
    F.G = gridDim.x; { const int bx = blockIdx.x; F.vcu = (F.G % 8 == 0) ? (bx % 8) * (F.G / 8) + bx / 8 : bx; }
#pragma unroll
    for (int i = 0; i < 22; ++i) F.in[i] = args.in[i];
    F.out = args.out; F.ws = args.ws; F.ctl = (gu32*)(args.ws + WS_CTL);
    for (int u = threadIdx.x; u < (LDS_BYTES - LDSCTL_OFF) / 4; u += NWAVES * 64) ((LAS unsigned*)(F.lds + LDSCTL_OFF))[u] = 0u;
    __syncthreads();
    XcdBarrier bar; bar.bar = (unsigned*)(F.ctl + CW_BAR); bar.x = 0; bar.st = nullptr;
    if (N_LAUNCHES != PER_PHASE) bar = xcd_barrier_post((unsigned*)(F.ctl + CW_BAR), F.MISC + 8);
#define GRID_BAR(seam) do { if (N_LAUNCHES == PER_PHASE) { if (threadIdx.x == 0) __hip_atomic_store(F.ctl + CW_TMO, 0xBADBA0u | (unsigned)(seam), RLX_AGENT); } else { xcd_barrier(bar); } } while (0)
    const int lo = args.ph_lo, hi = args.ph_hi;
#define IN(k) (lo <= (k) && (k) < hi)
#define BOTH(k) (IN(k) && IN((k) + 1))

#ifndef PROBE_REPEAT
#define PROBE_REPEAT -1
#endif
#ifndef ONLY_PHASE
#define ONLY_PHASE -1
#endif
#define RUN(k, call) do { if ((ONLY_PHASE < 0 || ONLY_PHASE == (k)) && IN(k)) { call; if (PROBE_REPEAT == (k)) { GRID_BAR(k); call; } if (BOTH(k)) GRID_BAR(k); } } while (0)
    RUN(0, p0_prologue(F));
    RUN(1, ph1(F));
#if PROBE_REPEAT == 11
    if (IN(1)) { pg8::Gemm g{(const bf16*)(F.ws + WS_H), (const bf16*)(F.ws + WS_WIN), M, NPROJ, D}; pg8::StaticOrder S; S.init(M, NPROJ, F.G, (int)blockIdx.x); pg8::EpiNull E;
        pg8::gemm_phase<pg8::EpiNull, pg8::StaticOrder, true, true>(F.lds + RING_OFF, g, S, E, F.wave); GRID_BAR(1); }
#endif
#if PROBE_REPEAT == 12
    if (IN(1)) { pg8::Gemm g{(const bf16*)(F.ws + WS_H), (const bf16*)(F.ws + WS_WIN), M, NPROJ, D}; pg8::StaticOrder S; S.init(M, NPROJ, F.G, (int)blockIdx.x);
        pg8::EpiSplit E{(bf16*)(F.ws + WS_Y), 0, D, 0, 2, attn_body::C2, 1.0f / (W8_SCALE * H8_SCALE)};
        pg8::gemm_phase<pg8::EpiSplit, pg8::StaticOrder, true, true>(F.lds + RING_OFF, g, S, E, F.wave); GRID_BAR(1); }
#endif
    RUN(2, p2_phase(F));
    RUN(3, ph3(F, lds));
#if PROBE_REPEAT == 14
    if (IN(3)) { unsigned char* ws = F.ws; const attn_body::AttnTensors AT{(const attn_body::bf16*)(ws + WS_PROJ + 2 * PROJ_STRIDE), (const attn_body::bf16*)(ws + WS_PROJ + 3 * PROJ_STRIDE), (const attn_body::bf16*)(ws + WS_PROJ + 4 * PROJ_STRIDE),
                                    (attn_body::bf16*)(ws + WS_TMP), (const float*)(ws + WS_KB), (const unsigned*)(F.ctl + CW_QN), (const unsigned*)(F.ctl + CW_KN)};
        const attn_body::StaticOrder S((int)F.G, (int)blockIdx.x); attn_body::attn_phase<attn_body::StaticOrder>((char*)lds + RING_OFF, AT, S, F.wave, -1.0f); GRID_BAR(3); }
#endif
#if PROBE_REPEAT == 13
    if (IN(3)) { unsigned char* ws = F.ws; const attn_body::AttnTensors AT{(const attn_body::bf16*)(ws + WS_PROJ + 2 * PROJ_STRIDE), (const attn_body::bf16*)(ws + WS_PROJ + 3 * PROJ_STRIDE), (const attn_body::bf16*)(ws + WS_PROJ + 4 * PROJ_STRIDE),
                                    (attn_body::bf16*)(ws + WS_YFOX), (const float*)(ws + WS_KB), (const unsigned*)(F.ctl + CW_QN), (const unsigned*)(F.ctl + CW_KN)};
        const attn_body::StaticOrder S((int)F.G, (int)blockIdx.x); attn_body::attn_phase<attn_body::StaticOrder>((char*)lds + RING_OFF, AT, S, F.wave); GRID_BAR(3); }
#endif
    RUN(4, ph4(F));
    RUN(5, ph5(F));
    RUN(6, p6_route(F));
#if PROBE_REPEAT == 16
    if (IN(6)) { if (blockIdx.x == 0 && threadIdx.x < 32) __hip_atomic_store(F.ctl + CW_CNT + 64 * threadIdx.x, 0u, RLX_AGENT); GRID_BAR(6); p6_route(F); GRID_BAR(6); }
#endif
    RUN(7, ph7(F));
#if PROBE_REPEAT == 17
    if (IN(7)) { unsigned char* ws = F.ws; const int TT = moe_tables(F); LAS unsigned char* EX = F.lds + EXTRA_OFF; LAS unsigned* rows = (LAS unsigned*)(EX + EX_ROWS);
        pg8::GroupedOrder<true> S; S.init(TT, 8, F.G, (int)blockIdx.x, EX + EX_TILE_E, rows);
        pg8::Gemm g{(const bf16*)(ws + WS_H2), (const bf16*)(ws + WS_WGU), SLOTS, 2 * DFF, D}; pg8::EpiNull E;
        pg8::gemm_phase<pg8::EpiNull, pg8::GroupedOrder<true>, true, true>(F.lds + RING_OFF, g, S, E, F.wave); GRID_BAR(7); }
#endif
    RUN(8, ph8(F));
    RUN(9, p9_final(F));
#undef RUN
#undef IN
#undef BOTH
}

extern "C" void kernel_launch(void* const* d_in, const int* in_sizes, int n_in, void* d_out, int out_size, void* d_ws, size_t ws_size, hipStream_t stream) {
    static int grid = 0;
    if (grid == 0) {
        if (n_in != 22 || in_sizes[0] != M * D || out_size != M * D || ws_size < WS_END) { fprintf(stderr, "kernel_launch: unexpected problem: n_in %d in0 %d out %d ws %zu (need %zu)\n", n_in, n_in > 0 ? in_sizes[0] : -1, out_size, ws_size, (size_t)WS_END); grid = -1; return; }
        int dev = 0, cus = 0, per_cu = 0;
        if (hipGetDevice(&dev) != hipSuccess || hipDeviceGetAttribute(&cus, hipDeviceAttributeMultiprocessorCount, dev) != hipSuccess) { grid = -1; return; }
        if (hipFuncSetAttribute((const void*)mk_fwd, hipFuncAttributeMaxDynamicSharedMemorySize, LDS_BYTES) != hipSuccess) { fprintf(stderr, "kernel_launch: hipFuncSetAttribute failed\n"); grid = -1; return; }
        if (hipOccupancyMaxActiveBlocksPerMultiprocessor(&per_cu, (const void*)mk_fwd, NWAVES * 64, LDS_BYTES) != hipSuccess || per_cu < 1) { fprintf(stderr, "kernel_launch: occupancy query reports %d workgroups per CU\n", per_cu); }
        (void)hipGetLastError();
        grid = cus;
    }
    if (grid < 0) return;
    if (hipMemsetAsync((char*)d_ws + WS_CTL, 0, CTL_ZERO_BYTES, stream) != hipSuccess) return;
    Args a{};
    for (int i = 0; i < 22; ++i) a.in[i] = (const float*)d_in[i];
    a.out = (float*)d_out; a.ws = (unsigned char*)d_ws;
    for (int li = 0; li < N_LAUNCHES; ++li) {
        a.ph_lo = (N_LAUNCHES == PER_PHASE) ? li : 0; a.ph_hi = (N_LAUNCHES == PER_PHASE) ? li + 1 : PER_PHASE; a.li = li; a.pad = 0;
        hipLaunchKernelGGL(mk_fwd, dim3(grid), dim3(NWAVES * 64), LDS_BYTES, stream, a);
    }
}
```
